# Optimizing an MI355X kernel written in HIP

```python
import math
import jax, jax.numpy as jnp
from jax import lax
import numpy as np

D_MODEL = 1024
BATCH = 2
SEQ = 8192
DEPTH = 4

N_MIXERS = 3
HEAD_DIM = 64
PLE_DIM = 256
D_FF = 4 * D_MODEL
NORM_EPS = 1e-6
NEG_INF = -1e30
Q_BLOCK = 128

REL_BUCKETS = 32
REL_MAX_DIST = 128
REL_HEADS = D_MODEL // HEAD_DIM

DA_HEADS = D_MODEL // (2 * HEAD_DIM)
DA_IN = 3 * D_MODEL

NSA_HEADS = D_MODEL // HEAD_DIM
NSA_KV_GROUPS = 4
NSA_GROUP_SIZE = NSA_HEADS // NSA_KV_GROUPS
NSA_CMP_LEN = 32
NSA_CMP_STRIDE = 16
NSA_CMP_HIDDEN = 256
NSA_SEL_LEN = 64
NSA_TOP_N = 16
NSA_WINDOW = 512
NSA_Q_CHUNK = 64
NSA_FORCE_SCORE = 1e4
NSA_KV_DIM = NSA_KV_GROUPS * HEAD_DIM
NSA_IN = NSA_HEADS * HEAD_DIM + 6 * NSA_KV_DIM + 3 * NSA_HEADS

FOX_HEADS = D_MODEL // HEAD_DIM
FOX_IN = 3 * D_MODEL + FOX_HEADS

N_DA = (DEPTH + 2) // 3
N_NSA = (DEPTH + 1) // 3
N_FOX = DEPTH // 3

kernel_name = 'hybrid_diff_nsa_fox_trunk'


def rmsnorm(x, g):
    xf = x.astype(jnp.float32)
    y = xf * lax.rsqrt(jnp.mean(xf * xf, axis=-1, keepdims=True) + NORM_EPS)
    return (y * g.astype(jnp.float32)).astype(x.dtype)


def t5_bucket(dist):
    n = jnp.maximum(dist, 0)
    max_exact = REL_BUCKETS // 2
    nf = jnp.maximum(n, 1).astype(jnp.float32)
    large = max_exact + (jnp.log(nf / max_exact) / math.log(REL_MAX_DIST / max_exact)
                         * (REL_BUCKETS - max_exact)).astype(jnp.int32)
    large = jnp.minimum(large, REL_BUCKETS - 1)
    return jnp.where(n < max_exact, n, large)


def masked_softmax(s, mask):
    s = jnp.where(mask, s.astype(jnp.float32), NEG_INF)
    return jnp.where(mask, jax.nn.softmax(s, axis=-1), 0.0)


def query_blocks(a, blk):
    B, S = a.shape[:2]
    return jnp.moveaxis(a.reshape(B, S // blk, blk, *a.shape[2:]), 1, 0)


def merge_blocks(o):
    o = jnp.moveaxis(o, 0, 1)
    return o.reshape(o.shape[0], -1, *o.shape[3:])


def diff_attention(h, w_in, lam, subln_g, w_out, rel_bias, lam_init):
    B, S, _ = h.shape
    q, k, v = jnp.split(h @ w_in, 3, axis=-1)
    q = q.reshape(B, S, DA_HEADS, 2, HEAD_DIM)
    k = k.reshape(B, S, DA_HEADS, 2, HEAD_DIM)
    v = v.reshape(B, S, DA_HEADS, 2 * HEAD_DIM)
    lf = lam.astype(jnp.float32)
    lam_full = jnp.exp(jnp.sum(lf[0] * lf[1])) - jnp.exp(jnp.sum(lf[2] * lf[3])) + lam_init
    scale = HEAD_DIM ** -0.5
    key_pos = jnp.arange(S)

    def block(args):
        qb, q0 = args
        t = q0 + jnp.arange(Q_BLOCK)
        dist = t[:, None] - key_pos[None, :]
        mask = dist >= 0
        bias = rel_bias[t5_bucket(dist)].astype(jnp.float32)
        bias = jnp.moveaxis(bias, -1, 0).reshape(DA_HEADS, 2, Q_BLOCK, S)
        s = jnp.einsum('bqhcd,bkhcd->bhcqk', qb, k).astype(jnp.float32) * scale + bias[None]
        pr = masked_softmax(s, mask)
        a = pr[:, :, 0] - lam_full * pr[:, :, 1]
        return jnp.einsum('bhqk,bkhe->bqhe', a.astype(v.dtype), v)

    starts = jnp.arange(S // Q_BLOCK) * Q_BLOCK
    o = merge_blocks(lax.map(block, (query_blocks(q, Q_BLOCK), starts)))
    o = rmsnorm(o, subln_g) * (1.0 - lam_init)
    return o.reshape(B, S, D_MODEL) @ w_out


def nsa_attention(h, w_in, cmp_pe, cmp_w1, cmp_w2, w_out, rel_bias):
    B, S, _ = h.shape
    G, R, hd, Qc = NSA_KV_GROUPS, NSA_GROUP_SIZE, HEAD_DIM, NSA_Q_CHUNK
    proj = h @ w_in
    nq = NSA_HEADS * hd
    q = proj[..., :nq].reshape(B, S, G, R, hd)
    kv = proj[..., nq:nq + 6 * NSA_KV_DIM].reshape(B, S, 6, G, hd)
    k_cmp, v_cmp, k_sel, v_sel, k_win, v_win = [kv[:, :, i] for i in range(6)]
    gates = jax.nn.sigmoid(proj[..., nq + 6 * NSA_KV_DIM:].reshape(B, S, G, R, 3))
    scale = hd ** -0.5

    n_cmp = (S - NSA_CMP_LEN) // NSA_CMP_STRIDE + 1
    tok = jnp.arange(n_cmp)[:, None] * NSA_CMP_STRIDE + jnp.arange(NSA_CMP_LEN)[None, :]

    def compress(a, pe, w1, w2):
        blk = a[:, tok] + pe[None, None, :, None, :]
        blk = jnp.moveaxis(blk, 3, 2).reshape(B, n_cmp, G, NSA_CMP_LEN * hd)
        return jax.nn.gelu(blk @ w1) @ w2

    kc = compress(k_cmp, cmp_pe[0], cmp_w1[0], cmp_w2[0])
    vc = compress(v_cmp, cmp_pe[1], cmp_w1[1], cmp_w2[1])
    cmp_start = jnp.arange(n_cmp) * NSA_CMP_STRIDE
    cmp_end = cmp_start + NSA_CMP_LEN - 1

    n_sel_blk = S // NSA_SEL_LEN
    n_top = min(NSA_TOP_N, n_sel_blk)
    sel_start = jnp.arange(n_sel_blk) * NSA_SEL_LEN
    overlap = ((cmp_start[:, None] < sel_start[None, :] + NSA_SEL_LEN)
               & (cmp_end[:, None] >= sel_start[None, :])).astype(jnp.float32)
    ks_blk = jnp.moveaxis(k_sel.reshape(B, n_sel_blk, NSA_SEL_LEN, G, hd), 3, 1)
    vs_blk = jnp.moveaxis(v_sel.reshape(B, n_sel_blk, NSA_SEL_LEN, G, hd), 3, 1)

    pad = ((0, 0), (NSA_WINDOW, 0), (0, 0), (0, 0))
    kw_pad = jnp.pad(k_win, pad)
    vw_pad = jnp.pad(v_win, pad)

    rel = rel_bias.reshape(REL_BUCKETS, G, R)
    b_idx = jnp.arange(B)[:, None, None, None]
    g_idx = jnp.arange(G)[None, :, None, None]
    j_blk = jnp.arange(n_sel_blk)
    K_sel = n_top * NSA_SEL_LEN

    def chunk(args):
        qc, gc, q0 = args
        t = q0 + jnp.arange(Qc)
        d_c = t[:, None] - cmp_end[None, :]
        m_c = d_c >= 0
        b_c = jnp.moveaxis(rel[t5_bucket(d_c)], (2, 3), (0, 1)).astype(jnp.float32)
        s_c = jnp.einsum('bqgrd,bngd->bgrqn', qc, kc).astype(jnp.float32) * scale + b_c
        p_c = masked_softmax(s_c, m_c)
        o_c = jnp.einsum('bgrqn,bngd->bqgrd', p_c.astype(vc.dtype), vc)
        imp = jnp.einsum('bgrqn,nj->bgqj', p_c, overlap)
        cur = t // NSA_SEL_LEN
        forced = (j_blk[None, :] == 0) | (j_blk[None, :] == cur[:, None]) | (j_blk[None, :] == cur[:, None] - 1)
        valid = sel_start[None, :] <= t[:, None]
        imp = jnp.where(valid, jnp.where(forced, NSA_FORCE_SCORE, imp), -1.0)
        _, sel = lax.top_k(imp, n_top)
        k_g = ks_blk[b_idx, g_idx, sel].reshape(B, G, Qc, K_sel, hd)
        v_g = vs_blk[b_idx, g_idx, sel].reshape(B, G, Qc, K_sel, hd)
        pos = (sel[..., None] * NSA_SEL_LEN + jnp.arange(NSA_SEL_LEN)).reshape(B, G, Qc, K_sel)
        d_s = t[None, None, :, None] - pos
        m_s = (d_s >= 0)[:, :, None]
        b_s = jnp.moveaxis(rel[t5_bucket(d_s), g_idx], -1, 2).astype(jnp.float32)
        s_s = jnp.einsum('bqgrd,bgqkd->bgrqk', qc, k_g).astype(jnp.float32) * scale + b_s
        p_s = masked_softmax(s_s, m_s)
        o_s = jnp.einsum('bgrqk,bgqkd->bqgrd', p_s.astype(v_g.dtype), v_g)
        kw = lax.dynamic_slice_in_dim(kw_pad, q0, NSA_WINDOW + Qc, axis=1)
        vw = lax.dynamic_slice_in_dim(vw_pad, q0, NSA_WINDOW + Qc, axis=1)
        w_pos = q0 - NSA_WINDOW + jnp.arange(NSA_WINDOW + Qc)
        d_w = t[:, None] - w_pos[None, :]
        m_w = (d_w >= 0) & (d_w < NSA_WINDOW) & (w_pos[None, :] >= 0)
        b_w = jnp.moveaxis(rel[t5_bucket(d_w)], (2, 3), (0, 1)).astype(jnp.float32)
        s_w = jnp.einsum('bqgrd,bkgd->bgrqk', qc, kw).astype(jnp.float32) * scale + b_w
        p_w = masked_softmax(s_w, m_w)
        o_w = jnp.einsum('bgrqk,bkgd->bqgrd', p_w.astype(vw.dtype), vw)
        return gc[..., 0:1] * o_c + gc[..., 1:2] * o_s + gc[..., 2:3] * o_w

    starts = jnp.arange(S // Qc) * Qc
    o = merge_blocks(lax.map(chunk, (query_blocks(q, Qc), query_blocks(gates, Qc), starts)))
    return o.reshape(B, S, D_MODEL) @ w_out


def forgetting_attention(h, w_in, b_f, w_out):
    B, S, _ = h.shape
    proj = h @ w_in
    q = proj[..., :D_MODEL].reshape(B, S, FOX_HEADS, HEAD_DIM)
    k = proj[..., D_MODEL:2 * D_MODEL].reshape(B, S, FOX_HEADS, HEAD_DIM)
    v = proj[..., 2 * D_MODEL:3 * D_MODEL].reshape(B, S, FOX_HEADS, HEAD_DIM)
    log_f = jax.nn.log_sigmoid((proj[..., 3 * D_MODEL:] + b_f).astype(jnp.float32))
    c = jnp.cumsum(log_f, axis=1)
    c_k = jnp.moveaxis(c, 1, 2)
    scale = HEAD_DIM ** -0.5
    key_pos = jnp.arange(S)

    def block(args):
        qb, cq, q0 = args
        t = q0 + jnp.arange(Q_BLOCK)
        mask = t[:, None] >= key_pos[None, :]
        decay = jnp.moveaxis(cq, 1, 2)[..., None] - c_k[:, :, None, :]
        s = jnp.einsum('bqhd,bkhd->bhqk', qb, k).astype(jnp.float32) * scale + decay
        pr = masked_softmax(s, mask)
        return jnp.einsum('bhqk,bkhd->bqhd', pr.astype(v.dtype), v)

    starts = jnp.arange(S // Q_BLOCK) * Q_BLOCK
    o = merge_blocks(lax.map(block, (query_blocks(q, Q_BLOCK), query_blocks(c, Q_BLOCK), starts)))
    return o.reshape(B, S, D_MODEL) @ w_out


def sqrelu_mlp(h, w1, w2):
    return jnp.square(jax.nn.relu(h @ w1)) @ w2


def setup_inputs(seed: int = 0) -> dict:
    key = jax.random.key(seed)
    ks = list(jax.random.split(key, 24))

    def nrm(i, shape, scale):
        return jax.random.normal(ks[i], shape, jnp.float32) * scale

    D = D_MODEL
    return {
        'x': nrm(0, (BATCH, SEQ, D), 1.0),
        'p': nrm(1, (DEPTH, BATCH, SEQ, PLE_DIM), 1.0),
        'rel_bias': nrm(2, (REL_BUCKETS, REL_HEADS), 0.5),
        'norm_g': 1.0 + nrm(3, (DEPTH, 4, D), 0.02),
        'mlp_w1': nrm(4, (DEPTH, D, D_FF), D ** -0.5),
        'mlp_w2': nrm(5, (DEPTH, D_FF, D), D_FF ** -0.5),
        'ple_w': nrm(6, (DEPTH, PLE_DIM, D), PLE_DIM ** -0.5),
        'ple_gate_w': nrm(7, (DEPTH, D, D), D ** -0.5),
        'da_w_in': nrm(8, (N_DA, D, DA_IN), D ** -0.5),
        'da_lambda': nrm(9, (N_DA, 4, HEAD_DIM), 0.1),
        'da_subln': 1.0 + nrm(10, (N_DA, 2 * HEAD_DIM), 0.02),
        'da_w_out': nrm(11, (N_DA, D, D), D ** -0.5),
        'nsa_w_in': nrm(12, (N_NSA, D, NSA_IN), D ** -0.5),
        'nsa_cmp_pe': nrm(13, (N_NSA, 2, NSA_CMP_LEN, HEAD_DIM), 0.1),
        'nsa_cmp_w1': nrm(14, (N_NSA, 2, NSA_CMP_LEN * HEAD_DIM, NSA_CMP_HIDDEN), (NSA_CMP_LEN * HEAD_DIM) ** -0.5),
        'nsa_cmp_w2': nrm(15, (N_NSA, 2, NSA_CMP_HIDDEN, HEAD_DIM), NSA_CMP_HIDDEN ** -0.5),
        'nsa_w_out': nrm(16, (N_NSA, D, D), D ** -0.5),
        'fox_w_in': nrm(17, (N_FOX, D, FOX_IN), D ** -0.5),
        'fox_b_f': 3.0 + nrm(18, (N_FOX, FOX_HEADS), 1.0),
        'fox_w_out': nrm(19, (N_FOX, D, D), D ** -0.5),
    }


def reference(x, p, rel_bias, norm_g, mlp_w1, mlp_w2, ple_w, ple_gate_w,
              da_w_in, da_lambda, da_subln, da_w_out,
              nsa_w_in, nsa_cmp_pe, nsa_cmp_w1, nsa_cmp_w2, nsa_w_out,
              fox_w_in, fox_b_f, fox_w_out):
    ia, ib, ic = 0, 0, 0
    for i in range(DEPTH):
        g = norm_g[i]
        h = rmsnorm(x, g[0])
        kind = i % N_MIXERS
        if kind == 0:
            lam_init = 0.8 - 0.6 * math.exp(-0.3 * i)
            y = diff_attention(h, da_w_in[ia], da_lambda[ia], da_subln[ia], da_w_out[ia], rel_bias, lam_init)
            ia += 1
        elif kind == 1:
            y = nsa_attention(h, nsa_w_in[ib], nsa_cmp_pe[ib], nsa_cmp_w1[ib], nsa_cmp_w2[ib], nsa_w_out[ib], rel_bias)
            ib += 1
        else:
            y = forgetting_attention(h, fox_w_in[ic], fox_b_f[ic], fox_w_out[ic])
            ic += 1
        x = x + rmsnorm(y, g[1])
        y = sqrelu_mlp(rmsnorm(x, g[2]), mlp_w1[i], mlp_w2[i])
        x = x + rmsnorm(y, g[3])
        x = x + jax.nn.sigmoid(x @ ple_gate_w[i]) * (p[i] @ ple_w[i])
    return x
```

```cpp
#include <hip/hip_runtime.h>
#include <hip/hip_cooperative_groups.h>
#include <cstdio>
#include <cstdint>
namespace cg = cooperative_groups;
#ifndef REP_PK
#define REP_PK -1
#endif
#ifndef REP_LAYER
#define REP_LAYER -1
#endif
#ifndef EXTRA_SYNC
#define EXTRA_SYNC 0
#endif
#ifndef ONE_LAUNCH
#define ONE_LAUNCH 1
#endif
__device__ __forceinline__ int otid() { int t = (int)threadIdx.x; asm volatile("" : "+v"(t)); return t; }
template <class T> __device__ __forceinline__ T* oq(T* p) { asm volatile("" : "+s"(p)); return p; }
__device__ __forceinline__ int oqi(int v) { asm volatile("" : "+s"(v)); return v; }
namespace pg8 {
#define PG8_LAS __attribute__((address_space(3)))
typedef unsigned short bf16_t;
typedef short bf16x8 __attribute__((ext_vector_type(8)));
typedef float f32x4 __attribute__((ext_vector_type(4)));
typedef unsigned u32x4 __attribute__((ext_vector_type(4)));
constexpr int BM = 256, BK = 64, HALF = 128, HTB = HALF * BK * 2  , STAGE_BYTES = 8 * HTB, NXCD = 8, WGM = 8;

__host__ __device__ __forceinline__ int lds_byte(int r, int c) { const int st = (r >> 4) * 2 + (c >> 5), rr = r & 15, cc = c & 31, ob = rr * 64 + cc * 2; return st * 1024 + (ob ^ (((ob >> 9) & 1) << 5)); }
__host__ __device__ __forceinline__ void stage_rc(int b, int& R, int& C) { const int st = b / 1024, sb = b % 1024, swz = sb ^ (((sb >> 9) & 1) << 5); R = (st >> 1) * 16 + swz / 64; C = (st & 1) * 32 + (swz % 64) / 2; }
__host__ __device__ __forceinline__ int perm32(int rho) { const int n = rho >> 4, i = rho & 15; return 8 * (i >> 2) + 4 * n + (i & 3); }

struct Unit { int pm, pn; };
struct Gemm { const bf16_t* A; const bf16_t* Bt; int M, N, K; };

struct StaticOrder {
    int nM, nN, nwg, G, c;
    __host__ __device__ void init(int M, int N, int G_, int c_) { nM = M / BM; nN = N / BM; nwg = nM * nN; G = G_; c = c_; }
    __host__ __device__ bool next(int i, Unit& u) const {
        const long L = (long)i * G + c; if (L >= nwg) return false;
        int wgid = (int)L; { const int q = nwg / NXCD, r = nwg % NXCD, xcd = wgid % NXCD, off = wgid / NXCD; wgid = (xcd < r ? xcd * (q + 1) : r * (q + 1) + (xcd - r) * q) + off; }
        const int nig = WGM * nN, gid = wgid / nig, fm = gid * WGM, gsz = (nM - fm) < WGM ? (nM - fm) : WGM;
        u.pm = fm + ((wgid % nig) % gsz); u.pn = (wgid % nig) / gsz; return true;
    }
    __device__ __forceinline__ void a_ready(const Unit&) const {}
    __device__ __forceinline__ void done(const Unit&) const {}
};

__device__ __forceinline__ unsigned cvt_pk_bf16(float lo, float hi) { unsigned r; asm volatile("v_cvt_pk_bf16_f32 %0, %1, %2" : "=v"(r) : "v"(lo), "v"(hi)); return r; }
typedef float f32x2 __attribute__((ext_vector_type(2)));
template <class Epi, class Sched, bool ALIGN_EPI = false, bool SP2 = false>
__device__ __forceinline__ void gemm_phase(PG8_LAS unsigned char* lds, const Gemm g, const Sched& S, const Epi& E) {
    const int tid = otid(), wid = __builtin_amdgcn_readfirstlane(tid >> 6), lane = tid & 63, wr = wid >> 2, wc = wid & 3, fr = lane & 15, fq = lane >> 4;
    const int K = g.K, nt = K / BK;
    unsigned voffA[2], voffB[2];
#pragma unroll
    for (int i = 0; i < 2; ++i) { int R, C; stage_rc(tid * 16 + i * 8192, R, C); const int Rb = Epi::PERM ? ((R & ~31) + perm32(R & 31)) : R;
        voffA[i] = (unsigned)(R * K + C) * 2u; voffB[i] = (unsigned)(Rb * K + C) * 2u; }
    const size_t kstep = (size_t)(BK * 2);
    const size_t hstep = (size_t)HALF * K * 2;
    const size_t tstep = 2 * hstep;
    const unsigned ldsw = (unsigned)wid * 1024u;
    const int aoff = lds_byte(wr * 64 + fr, fq * 8), boff = lds_byte(wc * 32 + fr, fq * 8);
#define PG8_SA(b, h) (((b) * 2 + (h)) * HTB)
#define PG8_SB(b, h) ((4 + (b) * 2 + (h)) * HTB)
#define PG8_STAGE(bufoff, gbase, voff) do { _Pragma("unroll") for (int _i = 0; _i < 2; ++_i) \
        __builtin_amdgcn_global_load_lds((const unsigned*)((const char*)(gbase) + (voff)[_i]), (PG8_LAS unsigned*)(lds + (bufoff) + ldsw + _i * 8192), 16, 0, 0); } while (0)
#define PG8_LDA(dst, b, h) do { _Pragma("unroll") for (int m = 0; m < 4; ++m) _Pragma("unroll") for (int k = 0; k < 2; ++k) dst[m][k] = *(const PG8_LAS bf16x8*)(lds + PG8_SA(b, h) + aoff + m * 2048 + k * 1024); } while (0)
#define PG8_LDB(dst, b, h) do { _Pragma("unroll") for (int n = 0; n < 2; ++n) _Pragma("unroll") for (int k = 0; k < 2; ++k) dst[n][k] = *(const PG8_LAS bf16x8*)(lds + PG8_SB(b, h) + boff + n * 2048 + k * 1024); } while (0)
#define PG8_MMA(ai, bj, At, Bt) do { __builtin_amdgcn_s_setprio(1); _Pragma("unroll") for (int m = 0; m < 4; ++m) _Pragma("unroll") for (int n = 0; n < 2; ++n) _Pragma("unroll") for (int k = 0; k < 2; ++k) \
        acc[ai][bj][m][n] = __builtin_amdgcn_mfma_f32_16x16x32_bf16(Bt[n][k], At[m][k], acc[ai][bj][m][n], 0, 0, 0); __builtin_amdgcn_s_setprio(0); } while (0)
#define PG8_WAIT_V(n) asm volatile("s_waitcnt vmcnt(" #n ")" ::: "memory")
#define PG8_WAIT_L(n) asm volatile("s_waitcnt lgkmcnt(" #n ")" ::: "memory")
#define PG8_BAR __builtin_amdgcn_s_barrier()
#define PG8_SCHED __builtin_amdgcn_sched_barrier(0)
    Unit cur, nxt; int ui = 0;
    if (!S.next(0, cur)) return;
    f32x4 acc[2][2][4][2];
#pragma unroll
    for (int a = 0; a < 2; ++a)
#pragma unroll
        for (int b = 0; b < 2; ++b)
#pragma unroll
            for (int m = 0; m < 4; ++m)
#pragma unroll
                for (int n = 0; n < 2; ++n) acc[a][b][m][n] = (f32x4){0.f, 0.f, 0.f, 0.f};
    bf16x8 At[4][2], B0[2][2], B1[2][2];
    const char* cA = (const char*)g.A + (size_t)cur.pm * tstep; const char* cB = (const char*)g.Bt + (size_t)cur.pn * tstep;
    S.a_ready(cur);
    if constexpr (SP2) {
        PG8_STAGE(PG8_SB(0, 0), cB, voffB); PG8_STAGE(PG8_SB(0, 1), cB + hstep, voffB); PG8_STAGE(PG8_SA(0, 0), cA, voffA); PG8_STAGE(PG8_SA(0, 1), cA + hstep, voffA);
        if (wr == 1) PG8_BAR;
        PG8_WAIT_V(2); PG8_BAR;
        PG8_STAGE(PG8_SB(1, 0), cB + kstep, voffB); PG8_STAGE(PG8_SA(1, 0), cA + kstep, voffA); PG8_STAGE(PG8_SB(1, 1), cB + hstep + kstep, voffB);
        PG8_WAIT_V(6); PG8_BAR;
    } else {
        PG8_STAGE(PG8_SB(0, 0), cB, voffB); PG8_STAGE(PG8_SA(0, 0), cA, voffA); PG8_STAGE(PG8_SB(0, 1), cB + hstep, voffB); PG8_STAGE(PG8_SA(0, 1), cA + hstep, voffA);
        if (wr == 1) PG8_BAR;
        PG8_WAIT_V(4); PG8_BAR;
        PG8_STAGE(PG8_SB(1, 0), cB + kstep, voffB); PG8_STAGE(PG8_SA(1, 0), cA + kstep, voffA); PG8_STAGE(PG8_SB(1, 1), cB + hstep + kstep, voffB);
        PG8_WAIT_V(6); PG8_BAR;
    }
    for (;;) {
        const bool has_next = S.next(ui + 1, nxt);
        const char* nA = has_next ? (const char*)g.A + (size_t)nxt.pm * tstep : cA; const char* nB = has_next ? (const char*)g.Bt + (size_t)nxt.pn * tstep : cB;
        for (int t = 0; t < nt; t += 2) {
            const bool last = (t == nt - 2);
            const char* a1 = cA + (size_t)(t + 1) * kstep;
            const char* a2 = last ? nA : cA + (size_t)(t + 2) * kstep; const char* b2 = last ? nB : cB + (size_t)(t + 2) * kstep;
            const char* a3 = a2 + kstep; const char* b3 = b2 + kstep;
            if (last && has_next) S.a_ready(nxt);
            if constexpr (SP2) {
            PG8_LDB(B0, 0, 0); PG8_LDB(B1, 0, 1); PG8_SCHED; PG8_LDA(At, 0, 0); PG8_STAGE(PG8_SA(1, 1), a1 + hstep, voffA);
            PG8_WAIT_V(8); PG8_WAIT_L(0); PG8_BAR; PG8_MMA(0, 0, At, B0); PG8_MMA(0, 1, At, B1); PG8_BAR; PG8_SCHED;
            PG8_LDA(At, 0, 1); PG8_STAGE(PG8_SB(0, 0), b2, voffB); PG8_STAGE(PG8_SB(0, 1), b2 + hstep, voffB); PG8_STAGE(PG8_SA(0, 0), a2, voffA);
            PG8_WAIT_V(8); PG8_WAIT_L(0); PG8_BAR; PG8_MMA(1, 0, At, B0); PG8_MMA(1, 1, At, B1); PG8_BAR; PG8_SCHED;
            PG8_LDB(B0, 1, 0); PG8_LDB(B1, 1, 1); PG8_SCHED; PG8_LDA(At, 1, 0); PG8_STAGE(PG8_SA(0, 1), a2 + hstep, voffA);
            PG8_WAIT_V(8); PG8_WAIT_L(0); PG8_BAR; PG8_MMA(0, 0, At, B0); PG8_MMA(0, 1, At, B1); PG8_BAR; PG8_SCHED;
            PG8_LDA(At, 1, 1); PG8_STAGE(PG8_SB(1, 0), b3, voffB); PG8_STAGE(PG8_SB(1, 1), b3 + hstep, voffB); PG8_STAGE(PG8_SA(1, 0), a3, voffA);
            PG8_WAIT_V(8); PG8_WAIT_L(0); PG8_BAR; PG8_MMA(1, 0, At, B0); PG8_MMA(1, 1, At, B1); PG8_BAR; PG8_SCHED;
            } else {
            PG8_LDB(B0, 0, 0); PG8_SCHED; PG8_LDA(At, 0, 0); PG8_STAGE(PG8_SA(1, 1), a1 + hstep, voffA);
            PG8_WAIT_L(8); PG8_BAR; PG8_WAIT_L(0); PG8_MMA(0, 0, At, B0); PG8_BAR; PG8_SCHED;
            PG8_LDB(B1, 0, 1); PG8_STAGE(PG8_SB(0, 0), b2, voffB);
            PG8_BAR; PG8_WAIT_L(0); PG8_MMA(0, 1, At, B1); PG8_BAR;
            PG8_LDA(At, 0, 1); PG8_STAGE(PG8_SA(0, 0), a2, voffA);
            PG8_BAR; PG8_WAIT_L(0); PG8_MMA(1, 0, At, B0); PG8_BAR; PG8_SCHED;
            PG8_STAGE(PG8_SB(0, 1), b2 + hstep, voffB);
            PG8_WAIT_V(6); PG8_BAR; PG8_MMA(1, 1, At, B1); PG8_BAR;
            PG8_LDB(B0, 1, 0); PG8_SCHED; PG8_LDA(At, 1, 0); PG8_STAGE(PG8_SA(0, 1), a2 + hstep, voffA);
            PG8_WAIT_L(8); PG8_BAR; PG8_WAIT_L(0); PG8_MMA(0, 0, At, B0); PG8_BAR; PG8_SCHED;
            PG8_LDB(B1, 1, 1); PG8_STAGE(PG8_SB(1, 0), b3, voffB);
            PG8_BAR; PG8_WAIT_L(0); PG8_MMA(0, 1, At, B1); PG8_BAR;
            PG8_LDA(At, 1, 1); PG8_STAGE(PG8_SA(1, 0), a3, voffA);
            PG8_BAR; PG8_WAIT_L(0); PG8_MMA(1, 0, At, B0); PG8_BAR; PG8_SCHED;
            PG8_STAGE(PG8_SB(1, 1), b3 + hstep, voffB);
            PG8_WAIT_V(6); PG8_BAR; PG8_MMA(1, 1, At, B1); PG8_BAR;
            }
        }
        if constexpr (ALIGN_EPI) { if (wr == 0) PG8_BAR; }
        if constexpr (!Epi::AFTER_DRAIN) { E(acc, cur, wr, wc, fr, fq); S.done(cur); }
        if (!has_next) break;
#pragma unroll
        for (int a = 0; a < 2; ++a)
#pragma unroll
            for (int b = 0; b < 2; ++b)
#pragma unroll
                for (int m = 0; m < 4; ++m)
#pragma unroll
                    for (int n = 0; n < 2; ++n) acc[a][b][m][n] = (f32x4){0.f, 0.f, 0.f, 0.f};
        cur = nxt; cA = nA; cB = nB; ++ui;
        if constexpr (ALIGN_EPI) { if (wr == 1) PG8_BAR; }
    }
    PG8_WAIT_V(0);
    if constexpr (!ALIGN_EPI) { if (wr == 0) PG8_BAR; }
    PG8_BAR;
    if constexpr (Epi::AFTER_DRAIN) { E.fused(acc, cur, wr, wc, fr, fq, lds, wid, lane); S.done(cur); }
#undef PG8_SA
#undef PG8_SB
#undef PG8_STAGE
#undef PG8_LDA
#undef PG8_LDB
#undef PG8_MMA
#undef PG8_WAIT_V
#undef PG8_WAIT_L
#undef PG8_BAR
#undef PG8_SCHED
}
}
namespace pg8 {
typedef unsigned u32x2 __attribute__((ext_vector_type(2)));
__device__ __forceinline__ float bf2f(unsigned short h) { return __uint_as_float(((unsigned)h) << 16); }
__device__ __forceinline__ unsigned short f2bf_rne(float f) { unsigned u = __float_as_uint(f); return (unsigned short)((u + 0x7fffu + ((u >> 16) & 1u)) >> 16); }
__device__ __forceinline__ float sigmoidf_(float v) { return 1.0f / (1.0f + __expf(-v)); }
__device__ __forceinline__ float logsigf_(float z) { return fminf(z, 0.f) - log1pf(__expf(-fabsf(z))); }
__device__ __forceinline__ u32x4 pack8(const f32x4 a, const f32x4 b) { u32x4 w; w.x = cvt_pk_bf16(a[0], a[1]); w.y = cvt_pk_bf16(a[2], a[3]); w.z = cvt_pk_bf16(b[0], b[1]); w.w = cvt_pk_bf16(b[2], b[3]); return w; }
__device__ __forceinline__ void split8(const f32x4 a, const f32x4 b, u32x4& hi, u32x4& lo) {
    hi = pack8(a, b);
    f32x4 ra, rb;
    ra[0] = a[0] - __uint_as_float(hi.x << 16); ra[1] = a[1] - __uint_as_float(hi.x & 0xffff0000u);
    ra[2] = a[2] - __uint_as_float(hi.y << 16); ra[3] = a[3] - __uint_as_float(hi.y & 0xffff0000u);
    rb[0] = b[0] - __uint_as_float(hi.z << 16); rb[1] = b[1] - __uint_as_float(hi.z & 0xffff0000u);
    rb[2] = b[2] - __uint_as_float(hi.w << 16); rb[3] = b[3] - __uint_as_float(hi.w & 0xffff0000u);
    lo = pack8(ra, rb);
}
#define PG8_FOR8(...) \
  _Pragma("unroll") for (int ai = 0; ai < 2; ++ai) _Pragma("unroll") for (int m = 0; m < 4; ++m) { const int lrow = ai * HALF + wr * 64 + m * 16 + fr; \
    _Pragma("unroll") for (int bj = 0; bj < 2; ++bj) { const int lcol = bj * HALF + wc * 32 + 8 * fq; f32x4 v0 = acc[ai][bj][m][0], v1 = acc[ai][bj][m][1]; __VA_ARGS__ } asm volatile("" ::: "memory"); }

struct EpiQK {
    static constexpr bool PERM = true, AFTER_DRAIN = false;
    bf16_t* QK; float* LF; const float* bf; float qscale;
    __device__ __forceinline__ void operator()(const f32x4 (&acc)[2][2][4][2], const Unit& u, int wr, int wc, int fr, int fq) const {
        const int pn = u.pn;
        if (pn < 8) { const float sc = pn < 4 ? qscale : 1.f;
            PG8_FOR8({ const unsigned row = (unsigned)u.pm * BM + lrow; *(u32x4*)(QK + row * 2048 + pn * 256 + lcol) = pack8(v0 * sc, v1 * sc); })
        } else {
            PG8_FOR8({ if (lcol < 16) { const unsigned row = (unsigned)u.pm * BM + lrow; f32x4 o0, o1;
                _Pragma("unroll") for (int i = 0; i < 4; ++i) { o0[i] = logsigf_(v0[i] + bf[lcol + i]); o1[i] = logsigf_(v1[i] + bf[lcol + 4 + i]); }
                *(f32x4*)(LF + row * 16 + lcol) = o0; *(f32x4*)(LF + row * 16 + lcol + 4) = o1; } })
        }
    }
};
struct EpiVt {
    static constexpr bool PERM = false, AFTER_DRAIN = false;
    bf16_t* VT; int ld; int vf_rows;
    __device__ __forceinline__ void operator()(const f32x4 (&acc)[2][2][4][2], const Unit& u, int wr, int wc, int fr, int fq) const {
#pragma unroll
        for (int ai = 0; ai < 2; ++ai)
#pragma unroll
            for (int m = 0; m < 4; ++m) { const unsigned row = (unsigned)u.pm * BM + ai * HALF + wr * 64 + m * 16 + fr;
#pragma unroll
                for (int bj = 0; bj < 2; ++bj)
#pragma unroll
                    for (int n = 0; n < 2; ++n) { const unsigned tok0 = u.pn * BM + bj * HALF + wc * 32 + 16 * n; const f32x4 v = acc[ai][bj][m][n];
                        u32x2 w; w.x = cvt_pk_bf16(v[0], v[1]); w.y = cvt_pk_bf16(v[2], v[3]);
                        if ((int)row < vf_rows) { const unsigned g = row >> 6, d = row & 63, db = d >> 5, r = d & 31, b = tok0 >> 13, s0 = tok0 & 8191, blk = s0 >> 6, ks = (s0 >> 4) & 3;
                            *(u32x2*)(VT + (((((b * 4 + g) * 128 + blk) * 2 + db) * 4 + ks) * 512 + ((fq & 1) * 32 + r) * 8 + 4 * (fq >> 1))) = w; }
                        else *(u32x2*)(VT + row * ld + tok0 + 8 * (fq & 1) + 4 * (fq >> 1)) = w; } }
    }
};
struct EpiF32 {
    static constexpr bool PERM = true, AFTER_DRAIN = false;
    float* Y; int ld;
    __device__ __forceinline__ void operator()(const f32x4 (&acc)[2][2][4][2], const Unit& u, int wr, int wc, int fr, int fq) const {
        PG8_FOR8({ float* p = Y + (unsigned)(((unsigned)u.pm * BM + lrow) * ld + u.pn * BM + lcol); *(f32x4*)p = v0; *(f32x4*)(p + 4) = v1; })
    }
};
template <int ACT  > struct EpiAct {
    static constexpr bool PERM = true, AFTER_DRAIN = false;
    bf16_t* O; int ld;
    __device__ __forceinline__ void operator()(const f32x4 (&acc)[2][2][4][2], const Unit& u, int wr, int wc, int fr, int fq) const {
        PG8_FOR8({ if (ACT == 1) { _Pragma("unroll") for (int i = 0; i < 4; ++i) { const float a = fmaxf(v0[i], 0.f), b = fmaxf(v1[i], 0.f); v0[i] = a * a; v1[i] = b * b; } }
            *(u32x4*)(O + (unsigned)(((unsigned)u.pm * BM + lrow) * ld + u.pn * BM + lcol)) = pack8(v0, v1); })
    }
};
struct EpiGate {
    static constexpr bool PERM = true, AFTER_DRAIN = false;
    float* X; const bf16_t* PW;
    __device__ __forceinline__ void operator()(const f32x4 (&acc)[2][2][4][2], const Unit& u, int wr, int wc, int fr, int fq) const {
        PG8_FOR8({ const unsigned off = ((unsigned)u.pm * BM + lrow) * 1024 + u.pn * BM + lcol; float* xp = X + off;
            const u32x4 pw = *(const u32x4*)(PW + off); f32x4 x0 = *(const f32x4*)xp, x1 = *(const f32x4*)(xp + 4);
            x0[0] += sigmoidf_(v0[0]) * __uint_as_float(pw.x << 16); x0[1] += sigmoidf_(v0[1]) * __uint_as_float(pw.x & 0xffff0000u);
            x0[2] += sigmoidf_(v0[2]) * __uint_as_float(pw.y << 16); x0[3] += sigmoidf_(v0[3]) * __uint_as_float(pw.y & 0xffff0000u);
            x1[0] += sigmoidf_(v1[0]) * __uint_as_float(pw.z << 16); x1[1] += sigmoidf_(v1[1]) * __uint_as_float(pw.z & 0xffff0000u);
            x1[2] += sigmoidf_(v1[2]) * __uint_as_float(pw.w << 16); x1[3] += sigmoidf_(v1[3]) * __uint_as_float(pw.w & 0xffff0000u);
            *(f32x4*)xp = x0; *(f32x4*)(xp + 4) = x1; })
    }
};
struct EpiNsaA {
    static constexpr bool PERM = true, AFTER_DRAIN = false;
    bf16_t *QH, *QL, *KH, *KL; float qscale;
    __device__ __forceinline__ void operator()(const f32x4 (&acc)[2][2][4][2], const Unit& u, int wr, int wc, int fr, int fq) const {
        const int pn = u.pn;
        PG8_FOR8({ const unsigned row = (unsigned)u.pm * BM + lrow; u32x4 h, l;
            if (pn < 4) { split8(v0 * qscale, v1 * qscale, h, l); const unsigned off = row * 1024 + pn * 256 + lcol; *(u32x4*)(QH + off) = h; *(u32x4*)(QL + off) = l; }
            else { split8(v0, v1, h, l); const unsigned b = row >> 13, s = row & 8191; const int g = lcol >> 6, d = lcol & 63;
                const unsigned off = ((b * 4 + g) * 8192 + s) * 64 + d; *(u32x4*)(KH + off) = h; *(u32x4*)(KL + off) = l; } })
    }
};
struct EpiNsaB {
    static constexpr bool PERM = true, AFTER_DRAIN = false;
    bf16_t *VC, *KS, *KW; float* GATE;
    __device__ __forceinline__ void operator()(const f32x4 (&acc)[2][2][4][2], const Unit& u, int wr, int wc, int fr, int fq) const {
        const int pn = u.pn;
        PG8_FOR8({ const unsigned row = (unsigned)u.pm * BM + lrow;
            if (pn == 0) { const unsigned b = row >> 13, s = row & 8191; const int g = lcol >> 6, d = lcol & 63; *(u32x4*)(VC + ((b * 4 + g) * 8192 + s) * 64 + d) = pack8(v0, v1); }
            else if (pn == 1) { const unsigned b = row >> 13, s = row & 8191; const unsigned g = lcol >> 6, d = lcol & 63;
                *(u32x4*)(KS + (((((b * 4 + g) * 128 + (s >> 6)) * 2 + ((s >> 5) & 1)) * 4 + (d >> 4)) * 512 + ((((d >> 3) & 1) * 32 + (s & 31)) * 8))) = pack8(v0, v1); }
            else if (pn == 2) { *(u32x4*)(KW + row * 256 + lcol) = pack8(v0, v1); }
            else if (lcol < 48) { f32x4 o0, o1; _Pragma("unroll") for (int i = 0; i < 4; ++i) { o0[i] = sigmoidf_(v0[i]); o1[i] = sigmoidf_(v1[i]); }
                *(f32x4*)(GATE + row * 48 + lcol) = o0; *(f32x4*)(GATE + row * 48 + lcol + 4) = o1; } })
    }
};
}
namespace fa {
using pg8::bf16_t; using pg8::bf16x8; using pg8::f32x4; using pg8::u32x4; using pg8::u32x2;
typedef float f32x16 __attribute__((ext_vector_type(16)));
#define LAS __attribute__((address_space(3)))
constexpr int ROWB = 144;
constexpr int L_K0 = 0, L_K1 = 9216, L_V0 = 18432, L_V1 = 36864, L_B0 = 55296, L_B1 = 55552, L_TAB = 55808, L_END = 56320;
constexpr float NEGV = -1e30f;
__device__ __forceinline__ int crow(int r, int hi) { return (r & 3) + 8 * (r >> 2) + 4 * hi; }
__device__ __forceinline__ float ex2(float v) { return __builtin_amdgcn_exp2f(v); }
__device__ __forceinline__ bf16x8 packp(const f32x16& p, int s) {
    u32x4 w; w.x = pg8::cvt_pk_bf16(p[8 * s + 0], p[8 * s + 1]); w.y = pg8::cvt_pk_bf16(p[8 * s + 2], p[8 * s + 3]);
    w.z = pg8::cvt_pk_bf16(p[8 * s + 4], p[8 * s + 5]); w.w = pg8::cvt_pk_bf16(p[8 * s + 6], p[8 * s + 7]); return __builtin_bit_cast(bf16x8, w);
}
struct FlashArgs {
    const bf16_t* Q; int ldq;
    const bf16_t* K; int ldk;
    const bf16_t* Vt; int ldv;
    int q0, t_lo, t_hi, pa, pb, window;
    const float* kbias;
    const float* tab;
    bf16_t* O; int ldo;
    const float* gate; int ldg;
};
__device__ __forceinline__ float xhalf_max(float m) { auto rr = __builtin_amdgcn_permlane32_swap(__float_as_uint(m), __float_as_uint(m), false, false); return fmaxf(__uint_as_float(rr[0]), __uint_as_float(rr[1])); }
#define FA_GK(t) do { kreg = *(const u32x4*)(a.K + (size_t)(64 * (t) + srow) * a.ldk + sch * 8); } while (0)
#define FA_GV(t) do { _Pragma("unroll") for (int i_ = 0; i_ < NVB; ++i_) vreg[i_] = *(const u32x4*)(a.Vt + (size_t)(srow + 64 * i_) * a.ldv + 64 * (t) + sch * 8); \
    if (BIAS == 1) { if (tid < 16) breg = *(const f32x4*)(a.kbias + 64 * (t) + 4 * tid); } } while (0)
#define FA_SK(b_) do { *(LAS u32x4*)(lds + ((b_) ? L_K1 : L_K0) + srow * ROWB + sch * 16) = kreg; } while (0)
#define FA_SV(b_) do { _Pragma("unroll") for (int i_ = 0; i_ < NVB; ++i_) *(LAS u32x4*)(lds + ((b_) ? L_V1 : L_V0) + (srow + 64 * i_) * ROWB + sch * 16) = vreg[i_]; \
    if (BIAS == 1) { if (tid < 16) *(LAS f32x4*)(lds + ((b_) ? L_B1 : L_B0) + 16 * tid) = breg; } } while (0)
template <int DV, int BIAS, bool MAIN, int DIR>
__device__ __forceinline__ void fa_iter(LAS unsigned char* lds, const FlashArgs& a, const int t, const int tid, const int srow, const int sch, const int r32, const int hi, const int qw0, const int qpos,
                                        const bf16x8 (&qf)[4], f32x16 (&o)[DV / 32], f32x16& c0, f32x16& c1, float& m_run, float& l_run, bool& cur_needed, u32x4& kreg, u32x4 (&vreg)[DV / 64], f32x4& breg) {
    constexpr int NVB = DV / 64, NDB = DV / 32;
    const LAS float* tabL = (const LAS float*)(lds + L_TAB);
    const int t1 = t + DIR, t2 = t + 2 * DIR;
    const bool hk = MAIN || (t2 >= a.t_lo && t2 <= a.t_hi), hv = MAIN || (t1 >= a.t_lo && t1 <= a.t_hi);
    if (hk) FA_GK(t2);
    if (hv) FA_GV(t1);
    bool nn = MAIN;
    if (!MAIN) { if (hv) { const int minp = a.pa * (64 * t1) + a.pb, maxp = minp + a.pa * 63; nn = (minp <= qw0 + 31) && (maxp > qw0 - a.window); } }
    const bool cn = MAIN || cur_needed;
    bool skip_b2 = false;
    if (cn) {
        if (BIAS == 1) {
            const LAS unsigned char* bb = lds + ((t & 1) ? L_B1 : L_B0);
#pragma unroll
            for (int g = 0; g < 4; ++g) { const f32x4 b0 = *(const LAS f32x4*)(bb + (8 * g + 4 * hi) * 4), b1 = *(const LAS f32x4*)(bb + (32 + 8 * g + 4 * hi) * 4);
#pragma unroll
                for (int i = 0; i < 4; ++i) { c0[4 * g + i] += b0[i]; c1[4 * g + i] += b1[i]; } }
        }
        if (!MAIN) {
            const int minpos = a.pa * (64 * t) + a.pb, maxpos = minpos + a.pa * 63;
            const bool full = (maxpos <= qw0) && (minpos > qw0 + 31 - a.window);
            const bool nearb = (BIAS == 2) && (maxpos >= qw0 - 127);
            if (!full || nearb) {
#pragma unroll
                for (int r = 0; r < 16; ++r) { const int kv = crow(r, hi); const int d0_ = qpos - (minpos + a.pa * kv), d1_ = d0_ - 32 * a.pa;
                    if (BIAS == 2) { c0[r] += tabL[min(max(d0_, 0), 127)]; c1[r] += tabL[min(max(d1_, 0), 127)]; }
                    if (d0_ < 0 || d0_ >= a.window) c0[r] = NEGV;
                    if (d1_ < 0 || d1_ >= a.window) c1[r] = NEGV; }
            }
        }
        float mx = fmaxf(c0[0], c1[0]);
#pragma unroll
        for (int r = 1; r < 16; ++r) mx = fmaxf(mx, fmaxf(c0[r], c1[r]));
        mx = xhalf_max(mx);
        const bool real = m_run > -1e29f, seen = mx > -1e29f;
        if (DIR < 0) skip_b2 = !__any(!real || mx > -150.f);
        if (__any(real ? (mx > 8.f) : seen)) {
            const float dl = real ? fmaxf(mx, 0.f) : (seen ? mx : 0.f);
            const float al = real ? ex2(-dl) : 0.f;
            m_run = real ? (m_run + dl) : (seen ? mx : m_run);
            l_run *= al;
#pragma unroll
            for (int r = 0; r < 16; ++r) { c0[r] -= dl; c1[r] -= dl; }
#pragma unroll
            for (int i = 0; i < NDB; ++i)
#pragma unroll
                for (int r = 0; r < 16; ++r) o[i][r] *= al;
        }
    }
    f32x16 n0, n1;
    if (nn) {
        const float refn = (m_run > -1e29f) ? m_run : 0.f;
        const LAS unsigned char* kb = lds + (((t + 1) & 1) ? L_K1 : L_K0);
#pragma unroll
        for (int r = 0; r < 16; ++r) { n0[r] = -refn; n1[r] = -refn; }
        bf16x8 kf0[4], kf1[4];
#pragma unroll
        for (int d0 = 0; d0 < 4; ++d0) { kf0[d0] = *(const LAS bf16x8*)(kb + r32 * ROWB + (2 * d0 + hi) * 16); kf1[d0] = *(const LAS bf16x8*)(kb + (32 + r32) * ROWB + (2 * d0 + hi) * 16); }
        __builtin_amdgcn_sched_barrier(0);
#pragma unroll
        for (int d0 = 0; d0 < 4; ++d0) {
            n0 = __builtin_amdgcn_mfma_f32_32x32x16_bf16(kf0[d0], qf[d0], n0, 0, 0, 0);
            n1 = __builtin_amdgcn_mfma_f32_32x32x16_bf16(kf1[d0], qf[d0], n1, 0, 0, 0);
        }
    }
    if (cn && !skip_b2) {
        const LAS unsigned char* vb = lds + ((t & 1) ? L_V1 : L_V0);
        float rs = 0.f;
#pragma unroll
        for (int r = 0; r < 16; ++r) { c0[r] = ex2(c0[r]); c1[r] = ex2(c1[r]); rs += c0[r] + c1[r]; }
        l_run += rs;
        bf16x8 pf[4]; pf[0] = packp(c0, 0); pf[1] = packp(c0, 1); pf[2] = packp(c1, 0); pf[3] = packp(c1, 1);
#pragma unroll
        for (int dh = 0; dh < NDB / 2; ++dh) {
            bf16x8 vf[8];
#pragma unroll
            for (int i = 0; i < 8; ++i) vf[i] = *(const LAS bf16x8*)(vb + (32 * (2 * dh + (i >> 2)) + r32) * ROWB + (2 * (i & 3) + hi) * 16);
            __builtin_amdgcn_sched_barrier(0);
    #pragma unroll
            for (int i = 0; i < 8; ++i) o[2 * dh + (i >> 2)] = __builtin_amdgcn_mfma_f32_32x32x16_bf16(vf[i], pf[i & 3], o[2 * dh + (i >> 2)], 0, 0, 0);
                __builtin_amdgcn_sched_barrier(0);
        }
    }
    if (hk) FA_SK(t & 1);
    if (hv) FA_SV((t + 1) & 1);
    __syncthreads();
    if (nn) { c0 = n0; c1 = n1; }
    cur_needed = nn;
}
template <int DV, int BIAS, int OUT, int DIR = 1>
__device__ __forceinline__ void flash_unit_reg(LAS unsigned char* lds, const FlashArgs& a) {
    const int tid = otid(), lane = tid & 63, wid = __builtin_amdgcn_readfirstlane(tid >> 6), r32 = lane & 31, hi = lane >> 5;
    const int srow = tid >> 3, sch = tid & 7;
    constexpr int NVB = DV / 64, NDB = DV / 32;
    u32x4 kreg, vreg[NVB]; f32x4 breg = (f32x4){0.f, 0.f, 0.f, 0.f};
    const int tfirst = (DIR > 0) ? a.t_lo : a.t_hi;
    FA_GK(tfirst);
    if (BIAS == 2) { if (tid < 128) *(LAS float*)(lds + L_TAB + 4 * tid) = a.tab[tid]; }
    bf16x8 qf[4];
#pragma unroll
    for (int d0 = 0; d0 < 4; ++d0) qf[d0] = *(const bf16x8*)(a.Q + (size_t)(32 * wid + r32) * a.ldq + 16 * d0 + 8 * hi);
    FA_SK(tfirst & 1);
    __syncthreads();
    const int qw0 = a.q0 + 32 * wid, qpos = qw0 + r32;
    float m_run = NEGV, l_run = 0.f;
    f32x16 o[NDB], c0, c1;
#pragma unroll
    for (int i = 0; i < NDB; ++i)
#pragma unroll
        for (int r = 0; r < 16; ++r) o[i][r] = 0.f;
#pragma unroll
    for (int r = 0; r < 16; ++r) { c0[r] = 0.f; c1[r] = 0.f; }
    bool cur_needed = false;
    int tm0, tm1;
    { const int lim = (BIAS == 2) ? (a.q0 - 128) : a.q0;
      const int num = lim - a.pb - 63 * a.pa;
      int tl = (num >= 0) ? (num / (64 * a.pa)) - 1 : -1;
      tl = min(tl, a.t_hi - 2);
      int tf = a.t_lo;
      if (a.window < (1 << 29)) { const int x = a.q0 + 255 - a.window - a.pb; if (x >= 0) tf = max(tf, x / (64 * a.pa) + 1); }
      tm0 = tf + 1; tm1 = tl + 1;
      if (tm1 < tm0) { tm0 = a.t_hi + 1; tm1 = tm0; } }
    if (DIR > 0) {
        int t = a.t_lo - 1;
        for (; t < tm0 && t <= a.t_hi; ++t) fa_iter<DV, BIAS, false, 1>(lds, a, t, tid, srow, sch, r32, hi, qw0, qpos, qf, o, c0, c1, m_run, l_run, cur_needed, kreg, vreg, breg);
        for (; t < tm1; ++t) fa_iter<DV, BIAS, true, 1>(lds, a, t, tid, srow, sch, r32, hi, qw0, qpos, qf, o, c0, c1, m_run, l_run, cur_needed, kreg, vreg, breg);
        for (; t <= a.t_hi; ++t) fa_iter<DV, BIAS, false, 1>(lds, a, t, tid, srow, sch, r32, hi, qw0, qpos, qf, o, c0, c1, m_run, l_run, cur_needed, kreg, vreg, breg);
    } else {
        const int tfull = (a.q0 - a.pb - 63 * a.pa >= 0) ? (a.q0 - a.pb - 63 * a.pa) / (64 * a.pa) : -1;
        int t = a.t_hi + 1;
        for (; t > tfull && t >= a.t_lo; --t) fa_iter<DV, BIAS, false, -1>(lds, a, t, tid, srow, sch, r32, hi, qw0, qpos, qf, o, c0, c1, m_run, l_run, cur_needed, kreg, vreg, breg);
        for (; t >= a.t_lo + 2; --t) fa_iter<DV, BIAS, true, -1>(lds, a, t, tid, srow, sch, r32, hi, qw0, qpos, qf, o, c0, c1, m_run, l_run, cur_needed, kreg, vreg, breg);
        for (; t >= a.t_lo; --t) fa_iter<DV, BIAS, false, -1>(lds, a, t, tid, srow, sch, r32, hi, qw0, qpos, qf, o, c0, c1, m_run, l_run, cur_needed, kreg, vreg, breg);
    }
    const float l_tot = l_run + __shfl_xor(l_run, 32);
    float inv = (m_run > -1e29f) ? 1.0f / l_tot : 0.f;
    if (OUT == 1) inv *= a.gate[(size_t)(32 * wid + r32) * a.ldg];
    bf16_t* orow = a.O + (size_t)(32 * wid + r32) * a.ldo;
#pragma unroll
    for (int db = 0; db < NDB; ++db)
#pragma unroll
        for (int g = 0; g < 4; ++g) { u32x2 w; w.x = pg8::cvt_pk_bf16(o[db][4 * g] * inv, o[db][4 * g + 1] * inv); w.y = pg8::cvt_pk_bf16(o[db][4 * g + 2] * inv, o[db][4 * g + 3] * inv);
            *(u32x2*)(orow + 32 * db + 8 * g + 4 * hi) = w; }
}
#undef FA_GK
#undef FA_GV
#undef FA_SK
#undef FA_SV
__device__ __forceinline__ void glds16(const void* gsrc, unsigned lds_dst) { unsigned keep;
    asm volatile("s_mov_b32 %0, m0\n\ts_mov_b32 m0, %2\n\ts_nop 0\n\tglobal_load_lds_dwordx4 %1, off\n\ts_mov_b32 m0, %0" : "=&s"(keep) : "v"(gsrc), "s"(lds_dst) : "memory"); }
__device__ __forceinline__ void glds4(const void* gsrc, unsigned lds_dst) { unsigned keep;
    asm volatile("s_mov_b32 %0, m0\n\ts_mov_b32 m0, %2\n\ts_nop 0\n\tglobal_load_lds_dword %1, off\n\ts_mov_b32 m0, %0" : "=&s"(keep) : "v"(gsrc), "s"(lds_dst) : "memory"); }
constexpr int D_K = 0, D_V = 32768, D_B = 32768 + 4 * 16384, D_TAB = D_B + 4 * 256, D_END = D_TAB + 512;
template <int DV, int BIAS, int OUT>
__device__ __forceinline__ void flash_unit(LAS unsigned char* lds, const FlashArgs& a) {
    const int tid = otid(), lane = tid & 63, wid = __builtin_amdgcn_readfirstlane(tid >> 6), r32 = lane & 31, hi = lane >> 5;
    constexpr int NVB = DV / 64, NDB = DV / 32, VSLOT = DV * 128, NP = 1 + NVB + (BIAS == 1 ? 1 : 0);
    static_assert(NP == 2 || NP == 3, "counted waits are written for 2 or 3 DMA pieces per wave and tile");
    const int drow = lane >> 3, dchunk = (lane & 7) ^ (((8 * wid + drow) >> 1) & 7);
    const bf16_t* ksrc = a.K + (size_t)(8 * wid + drow) * a.ldk + dchunk * 8;
    const bf16_t* vsrc = a.Vt + (size_t)(8 * wid + drow) * a.ldv + dchunk * 8;
    const unsigned lds0 = (unsigned)(__UINTPTR_TYPE__)lds;
#define FA_ISSUE(t_, s_) do { const unsigned so_ = (unsigned)__builtin_amdgcn_readfirstlane(s_); \
        glds16(ksrc + (size_t)(64 * (t_)) * a.ldk, (unsigned)__builtin_amdgcn_readfirstlane((int)(lds0 + D_K + so_ * 8192 + wid * 1024))); \
        _Pragma("unroll") for (int i_ = 0; i_ < NVB; ++i_) glds16(vsrc + (size_t)(64 * i_) * a.ldv + 64 * (t_), (unsigned)__builtin_amdgcn_readfirstlane((int)(lds0 + D_V + so_ * VSLOT + (wid + 8 * i_) * 1024))); \
        if (BIAS == 1) glds4(a.kbias + 64 * (t_) + lane, (unsigned)__builtin_amdgcn_readfirstlane((int)(lds0 + D_B + so_ * 256))); } while (0)
    int s_cur = 0;
    FA_ISSUE(a.t_lo, 0);
    if (a.t_lo + 1 <= a.t_hi) FA_ISSUE(a.t_lo + 1, 1);
    if (a.t_lo + 2 <= a.t_hi) FA_ISSUE(a.t_lo + 2, 2);
    if (BIAS == 2) { if (tid < 128) *(LAS float*)(lds + D_TAB + 4 * tid) = a.tab[tid]; }
    bf16x8 qf[4];
#pragma unroll
    for (int d0 = 0; d0 < 4; ++d0) qf[d0] = *(const bf16x8*)(a.Q + (size_t)(32 * wid + r32) * a.ldq + 16 * d0 + 8 * hi);
    asm volatile("" : "+v"(qf[0]), "+v"(qf[1]), "+v"(qf[2]), "+v"(qf[3]));
    asm volatile("s_waitcnt vmcnt(0) lgkmcnt(0)" ::: "memory");
    __builtin_amdgcn_s_barrier();
    asm volatile("" ::: "memory");
    const int qw0 = a.q0 + 32 * wid, qpos = qw0 + r32;
    float m_run = NEGV, l_run = 0.f;
    f32x16 o[NDB];
#pragma unroll
    for (int i = 0; i < NDB; ++i)
#pragma unroll
        for (int r = 0; r < 16; ++r) o[i][r] = 0.f;
    const LAS float* tabL = (const LAS float*)(lds + D_TAB);
    const int sw0 = ((r32 >> 1) & 7), sw1 = (((32 + r32) >> 1) & 7);
    for (int t = a.t_lo; t <= a.t_hi; ++t) {
        if (t + 2 <= a.t_hi) { if (NP == 3) asm volatile("s_waitcnt vmcnt(3)" ::: "memory"); else asm volatile("s_waitcnt vmcnt(2)" ::: "memory"); }
        else asm volatile("s_waitcnt vmcnt(0)" ::: "memory");
        asm volatile("s_waitcnt lgkmcnt(0)" ::: "memory");
        __builtin_amdgcn_s_barrier();
        asm volatile("" ::: "memory");
        const int s_nn = (s_cur + 3) & 3;
        if (t + 3 <= a.t_hi) FA_ISSUE(t + 3, s_nn);
        const int minpos = a.pa * (64 * t) + a.pb, maxpos = minpos + a.pa * 63;
        const bool needed = (minpos <= qw0 + 31) && (maxpos > qw0 - a.window);
        if (needed) {
            const LAS unsigned char* kb = lds + D_K + s_cur * 8192; const LAS unsigned char* vb = lds + D_V + s_cur * VSLOT;
            f32x16 p0, p1;
#pragma unroll
            for (int r = 0; r < 16; ++r) { p0[r] = 0.f; p1[r] = 0.f; }
#pragma unroll
            for (int d0 = 0; d0 < 4; ++d0) {
                const bf16x8 k0 = *(const LAS bf16x8*)(kb + r32 * 128 + (((2 * d0 + hi) ^ sw0) * 16));
                const bf16x8 k1 = *(const LAS bf16x8*)(kb + (32 + r32) * 128 + (((2 * d0 + hi) ^ sw1) * 16));
                p0 = __builtin_amdgcn_mfma_f32_32x32x16_bf16(k0, qf[d0], p0, 0, 0, 0);
                p1 = __builtin_amdgcn_mfma_f32_32x32x16_bf16(k1, qf[d0], p1, 0, 0, 0);
            }
            if (BIAS == 1) {
                const LAS unsigned char* bb = lds + D_B + s_cur * 256;
#pragma unroll
                for (int g = 0; g < 4; ++g) { const f32x4 b0 = *(const LAS f32x4*)(bb + (8 * g + 4 * hi) * 4), b1 = *(const LAS f32x4*)(bb + (32 + 8 * g + 4 * hi) * 4);
#pragma unroll
                    for (int i = 0; i < 4; ++i) { p0[4 * g + i] += b0[i]; p1[4 * g + i] += b1[i]; } }
            }
            const bool full = (maxpos <= qw0) && (minpos > qw0 + 31 - a.window);
            const bool nearb = (BIAS == 2) && (maxpos >= qw0 - 127);
            if (!full || nearb) {
#pragma unroll
                for (int r = 0; r < 16; ++r) { const int kv = crow(r, hi); const int d0_ = qpos - (minpos + a.pa * kv), d1_ = d0_ - 32 * a.pa;
                    if (BIAS == 2) { p0[r] += tabL[min(max(d0_, 0), 127)]; p1[r] += tabL[min(max(d1_, 0), 127)]; }
                    if (d0_ < 0 || d0_ >= a.window) p0[r] = NEGV;
                    if (d1_ < 0 || d1_ >= a.window) p1[r] = NEGV; }
            }
            float mx = fmaxf(p0[0], p1[0]);
#pragma unroll
            for (int r = 1; r < 16; ++r) mx = fmaxf(mx, fmaxf(p0[r], p1[r]));
            mx = xhalf_max(mx);
            if (__any(mx > m_run + 8.f)) {
                const float mn = fmaxf(m_run, mx), al = ex2(m_run - mn); l_run *= al; m_run = mn;
#pragma unroll
                for (int i = 0; i < NDB; ++i)
#pragma unroll
                    for (int r = 0; r < 16; ++r) o[i][r] *= al;
            }
            float rs = 0.f;
#pragma unroll
            for (int r = 0; r < 16; ++r) { p0[r] = ex2(p0[r] - m_run); p1[r] = ex2(p1[r] - m_run); rs += p0[r] + p1[r]; }
            l_run += rs;
            bf16x8 pf[4]; pf[0] = packp(p0, 0); pf[1] = packp(p0, 1); pf[2] = packp(p1, 0); pf[3] = packp(p1, 1);
#pragma unroll
            for (int db = 0; db < NDB; ++db)
#pragma unroll
                for (int ks = 0; ks < 4; ++ks) { const bf16x8 vf = *(const LAS bf16x8*)(vb + (32 * db + r32) * 128 + (((2 * ks + hi) ^ sw0) * 16));
                    o[db] = __builtin_amdgcn_mfma_f32_32x32x16_bf16(vf, pf[ks], o[db], 0, 0, 0); }
        }
        s_cur = (s_cur + 1) & 3;
    }
    const float l_tot = l_run + __shfl_xor(l_run, 32);
    float inv = (m_run > -1e29f) ? 1.0f / l_tot : 0.f;
    if (OUT == 1) inv *= a.gate[(size_t)(32 * wid + r32) * a.ldg];
    bf16_t* orow = a.O + (size_t)(32 * wid + r32) * a.ldo;
#pragma unroll
    for (int db = 0; db < NDB; ++db)
#pragma unroll
        for (int g = 0; g < 4; ++g) { u32x2 w; w.x = pg8::cvt_pk_bf16(o[db][4 * g] * inv, o[db][4 * g + 1] * inv); w.y = pg8::cvt_pk_bf16(o[db][4 * g + 2] * inv, o[db][4 * g + 3] * inv);
            *(u32x2*)(orow + 32 * db + 8 * g + 4 * hi) = w; }
    asm volatile("s_waitcnt lgkmcnt(0)" ::: "memory");
    __builtin_amdgcn_s_barrier();
    asm volatile("" ::: "memory");
#undef FA_ISSUE
}
struct AttnOrder {
    int vcu, G;
    __device__ __forceinline__ bool next(int i, int& bh, int& qb) const {
        if (G == 256) { if (i >= 4) return false; const int s = vcu & 7; bh = vcu >> 3; qb = (i == 0) ? 31 - s : (i == 1) ? 16 + s : (i == 2) ? 15 - s : s; return true; }
        const int u = vcu + i * G; if (u >= 1024) return false; bh = u >> 5; qb = 31 - (u & 31); return true;
    }
};

__device__ __forceinline__ float gelu_tanh(float x) { const float u = 0.7978845608028654f * (x + 0.044715f * x * x * x); const float e = __expf(2.f * u); return 0.5f * x * (2.f - 2.f / (e + 1.f)); }
template <bool SPLIT>
__device__ __forceinline__ void nsa_compress_unit(LAS unsigned char* lds, int bg, int n0, const bf16_t* AH, const bf16_t* AL, const bf16_t* W1H, const bf16_t* W1L,
                                                  const bf16_t* W2H, const bf16_t* W2L, const float* C1P, bf16_t* KCH, bf16_t* KCL, bf16_t* VCT) {
    const int tid = otid(), lane = tid & 63, wid = __builtin_amdgcn_readfirstlane(tid >> 6), r32 = lane & 31, hi = lane >> 5;
    const size_t aoff = ((size_t)bg * 8192 + 16 * (size_t)(n0 + r32)) * 64 + 8 * hi;
    const bf16_t* ah = AH + aoff; const bf16_t* al = SPLIT ? AL + aoff : nullptr;
    const size_t boff = (size_t)(32 * wid + r32) * 2048 + 8 * hi;
    const bf16_t* bh = W1H + boff; const bf16_t* bl = SPLIT ? W1L + boff : nullptr;
    f32x16 acc;
#pragma unroll
    for (int r = 0; r < 16; ++r) acc[r] = 0.f;
#pragma unroll 1
    for (int k8 = 0; k8 < 16; ++k8) {
        bf16x8 fa_h[8], fb_h[8], fa_l[8], fb_l[8];
#pragma unroll
        for (int u = 0; u < 8; ++u) { const int kk = 8 * k8 + u; fa_h[u] = *(const bf16x8*)(ah + 16 * kk); fb_h[u] = *(const bf16x8*)(bh + 16 * kk);
            if (SPLIT) { fa_l[u] = *(const bf16x8*)(al + 16 * kk); fb_l[u] = *(const bf16x8*)(bl + 16 * kk); } }
#pragma unroll
        for (int u = 0; u < 8; ++u) { acc = __builtin_amdgcn_mfma_f32_32x32x16_bf16(fa_h[u], fb_h[u], acc, 0, 0, 0);
            if (SPLIT) { acc = __builtin_amdgcn_mfma_f32_32x32x16_bf16(fa_h[u], fb_l[u], acc, 0, 0, 0); acc = __builtin_amdgcn_mfma_f32_32x32x16_bf16(fa_l[u], fb_h[u], acc, 0, 0, 0); } }
    }
    const int col = 32 * wid + r32;
    float c1 = 0.f;
#pragma unroll 8
    for (int kc = 0; kc < 32; ++kc) c1 += C1P[kc * 256 + col];
    constexpr int GP = 528;
#pragma unroll
    for (int r = 0; r < 16; ++r) { const float gv = gelu_tanh(acc[r] + c1); const unsigned short h = pg8::f2bf_rne(gv); const int row = crow(r, hi);
        *(LAS unsigned short*)(lds + row * GP + col * 2) = h;
        if (SPLIT) *(LAS unsigned short*)(lds + 32 * GP + row * GP + col * 2) = pg8::f2bf_rne(gv - pg8::bf2f(h)); }
    __syncthreads();
    if (wid < 2) {
        f32x16 a2;
#pragma unroll
        for (int r = 0; r < 16; ++r) a2[r] = 0.f;
        const size_t woff = (size_t)(32 * wid + r32) * 256 + 8 * hi;
#pragma unroll
        for (int kk = 0; kk < 16; ++kk) {
            const bf16x8 g_h = *(const LAS bf16x8*)(lds + r32 * GP + (16 * kk + 8 * hi) * 2);
            const bf16x8 w_h = *(const bf16x8*)(W2H + woff + 16 * kk);
            a2 = __builtin_amdgcn_mfma_f32_32x32x16_bf16(g_h, w_h, a2, 0, 0, 0);
            if (SPLIT) { const bf16x8 g_l = *(const LAS bf16x8*)(lds + 32 * GP + r32 * GP + (16 * kk + 8 * hi) * 2); const bf16x8 w_l = *(const bf16x8*)(W2L + woff + 16 * kk);
                a2 = __builtin_amdgcn_mfma_f32_32x32x16_bf16(g_h, w_l, a2, 0, 0, 0);
                a2 = __builtin_amdgcn_mfma_f32_32x32x16_bf16(g_l, w_h, a2, 0, 0, 0); }
        }
        const int e = 32 * wid + r32;
#pragma unroll
        for (int r = 0; r < 16; ++r) { const int n = n0 + crow(r, hi); const float v = (n < 511) ? a2[r] : 0.f;
            if (SPLIT) { const unsigned short h = pg8::f2bf_rne(v); KCH[((size_t)bg * 512 + n) * 64 + e] = h; KCL[((size_t)bg * 512 + n) * 64 + e] = pg8::f2bf_rne(v - pg8::bf2f(h)); }
            else { const int pos = (n & ~12) | ((n & 4) << 1) | ((n & 8) >> 1); VCT[((size_t)bg * 64 + e) * 512 + pos] = pg8::f2bf_rne(v); } }
    }
    __syncthreads();
}

constexpr int IM_P = 0, IM_PPITCH = 516, IM_VAL = 66048, IM_RED = 82432, IM_RED2 = 86528, IM_TAB = 90624, IM_END = 92672;
__device__ __forceinline__ void nsa_importance_unit(LAS unsigned char* lds, int b, int g, int qblk, const bf16_t* QH, const bf16_t* QL, const bf16_t* KCH, const bf16_t* KCL,
                                                    const float* TAB, unsigned char* SEL) {
    const int tid = otid(), lane = tid & 63, wid = __builtin_amdgcn_readfirstlane(tid >> 6), r32 = lane & 31, hi = lane >> 5;
    const int t0 = 32 * qblk, qpos = t0 + r32; const size_t tok = (size_t)b * 8192 + qpos;
    LAS float* P = (LAS float*)(lds + IM_P); LAS float* VAL = (LAS float*)(lds + IM_VAL); LAS float* RED = (LAS float*)(lds + IM_RED); LAS float* RED2 = (LAS float*)(lds + IM_RED2); LAS float* TABL = (LAS float*)(lds + IM_TAB);
    TABL[tid] = TAB[(g * 4) * 128 + tid];
    __syncthreads();
    const int nmax = 2 * qblk;
    const bool act0 = 32 * wid <= nmax, act1 = 32 * (wid + 8) <= nmax;
    f32x16 sc[4][2];
#pragma unroll
    for (int r = 0; r < 4; ++r)
#pragma unroll
        for (int nt = 0; nt < 2; ++nt)
#pragma unroll
            for (int i = 0; i < 16; ++i) sc[r][nt][i] = 0.f;
    if (act0) {
        const size_t qoff = tok * 1024 + (size_t)(g * 4) * 64 + 8 * hi;
#pragma unroll
        for (int d0 = 0; d0 < 4; ++d0) {
            bf16x8 kh[2], kl[2];
#pragma unroll
            for (int nt = 0; nt < 2; ++nt) { const size_t koff = ((size_t)(b * 4 + g) * 512 + 32 * (wid + 8 * nt) + r32) * 64 + 8 * hi + 16 * d0; kh[nt] = *(const bf16x8*)(KCH + koff); kl[nt] = *(const bf16x8*)(KCL + koff); }
#pragma unroll
            for (int r = 0; r < 4; ++r) { const bf16x8 qh = *(const bf16x8*)(QH + qoff + r * 64 + 16 * d0), ql = *(const bf16x8*)(QL + qoff + r * 64 + 16 * d0);
                sc[r][0] = __builtin_amdgcn_mfma_f32_32x32x16_bf16(kh[0], qh, sc[r][0], 0, 0, 0);
                sc[r][0] = __builtin_amdgcn_mfma_f32_32x32x16_bf16(kh[0], ql, sc[r][0], 0, 0, 0);
                sc[r][0] = __builtin_amdgcn_mfma_f32_32x32x16_bf16(kl[0], qh, sc[r][0], 0, 0, 0);
                if (act1) { sc[r][1] = __builtin_amdgcn_mfma_f32_32x32x16_bf16(kh[1], qh, sc[r][1], 0, 0, 0);
                    sc[r][1] = __builtin_amdgcn_mfma_f32_32x32x16_bf16(kh[1], ql, sc[r][1], 0, 0, 0);
                    sc[r][1] = __builtin_amdgcn_mfma_f32_32x32x16_bf16(kl[1], qh, sc[r][1], 0, 0, 0); } }
        }
    }
#pragma unroll
    for (int nt = 0; nt < 2; ++nt)
#pragma unroll
        for (int i = 0; i < 16; ++i) { const int n = 32 * (wid + 8 * nt) + crow(i, hi); const int dist = qpos - (16 * n + 31); const int idx = min(max(dist, 0), 127);
#pragma unroll
            for (int r = 0; r < 4; ++r) sc[r][nt][i] = (dist >= 0) ? sc[r][nt][i] + TABL[r * 128 + idx] : NEGV; }
    float mrow[4];
#pragma unroll
    for (int r = 0; r < 4; ++r) { float mx = NEGV;
#pragma unroll
        for (int nt = 0; nt < 2; ++nt)
#pragma unroll
            for (int i = 0; i < 16; ++i) mx = fmaxf(mx, sc[r][nt][i]);
        mx = fmaxf(mx, __shfl_xor(mx, 32));
        if (hi == 0) RED[(wid * 4 + r) * 32 + r32] = mx; }
    __syncthreads();
#pragma unroll
    for (int r = 0; r < 4; ++r) { float mx = NEGV;
#pragma unroll
        for (int w = 0; w < 8; ++w) mx = fmaxf(mx, RED[(w * 4 + r) * 32 + r32]);
        mrow[r] = mx; }
#pragma unroll
    for (int r = 0; r < 4; ++r) { float sm = 0.f; const bool any = mrow[r] > -1e29f;
#pragma unroll
        for (int nt = 0; nt < 2; ++nt)
#pragma unroll
            for (int i = 0; i < 16; ++i) { const float p = any ? ex2(sc[r][nt][i] - mrow[r]) : 0.f; sc[r][nt][i] = p; sm += p; }
        sm += __shfl_xor(sm, 32);
        if (hi == 0) RED2[(wid * 4 + r) * 32 + r32] = sm; }
    __syncthreads();
    float inv[4];
#pragma unroll
    for (int r = 0; r < 4; ++r) { float sm = 0.f;
#pragma unroll
        for (int w = 0; w < 8; ++w) sm += RED2[(w * 4 + r) * 32 + r32];
        inv[r] = sm > 0.f ? 1.0f / sm : 0.f; }
#pragma unroll
    for (int nt = 0; nt < 2; ++nt)
#pragma unroll
        for (int gq = 0; gq < 4; ++gq) { f32x4 v;
#pragma unroll
            for (int i = 0; i < 4; ++i) v[i] = sc[0][nt][4 * gq + i] * inv[0] + sc[1][nt][4 * gq + i] * inv[1] + sc[2][nt][4 * gq + i] * inv[2] + sc[3][nt][4 * gq + i] * inv[3];
            *(LAS f32x4*)(P + r32 * IM_PPITCH + 32 * (wid + 8 * nt) + 8 * gq + 4 * hi) = v; }
    __syncthreads();
    const int q = tid >> 4, jc = tid & 15; const int tq = t0 + q, cur = tq >> 6;
    unsigned key[8];
#pragma unroll
    for (int jj = 0; jj < 8; ++jj) { const int j = 8 * jc + jj; const f32x4 v = *(const LAS f32x4*)(P + q * IM_PPITCH + 4 * j);
        float s = (v[0] + v[1]) + (v[2] + v[3]); if (j > 0) s += P[q * IM_PPITCH + 4 * j - 1];
        const bool valid = j <= cur, forced = (j == 0) || (j == cur) || (j == cur - 1);
        key[jj] = valid ? (__float_as_uint(forced ? 1e4f : s) + 1u) : 0u; }
#define ROW16_SUM(v_) do { v_ += __builtin_amdgcn_update_dpp(0, v_, 0xB1, 0xf, 0xf, false); v_ += __builtin_amdgcn_update_dpp(0, v_, 0x4E, 0xf, 0xf, false); \
        v_ += __builtin_amdgcn_update_dpp(0, v_, 0x141, 0xf, 0xf, false); v_ += __builtin_amdgcn_update_dpp(0, v_, 0x140, 0xf, 0xf, false); } while (0)
#define ROW16_SCAN(v_) do { v_ += __builtin_amdgcn_update_dpp(0, v_, 0x111, 0xf, 0xf, false); v_ += __builtin_amdgcn_update_dpp(0, v_, 0x112, 0xf, 0xf, false); \
        v_ += __builtin_amdgcn_update_dpp(0, v_, 0x114, 0xf, 0xf, false); v_ += __builtin_amdgcn_update_dpp(0, v_, 0x118, 0xf, 0xf, false); } while (0)
    unsigned T = 0u;
#pragma unroll
    for (int bit = 31; bit >= 0; --bit) { const unsigned cand = T | (1u << bit); int c = 0;
#pragma unroll
        for (int jj = 0; jj < 8; ++jj) c += (key[jj] >= cand) ? 1 : 0;
        ROW16_SUM(c);
        if (c >= 16) T = cand; }
    int gcnt = 0, ecnt = 0;
#pragma unroll
    for (int jj = 0; jj < 8; ++jj) { gcnt += (key[jj] > T) ? 1 : 0; ecnt += (key[jj] == T) ? 1 : 0; }
    int gtot = gcnt; ROW16_SUM(gtot);
    const int need = 16 - gtot;
    int eincl = ecnt; ROW16_SCAN(eincl);
    int erun = eincl - ecnt, scnt = 0; bool sel[8];
#pragma unroll
    for (int jj = 0; jj < 8; ++jj) { const bool eq = key[jj] == T; sel[jj] = (key[jj] > T) || (eq && erun < need); erun += eq ? 1 : 0; scnt += sel[jj] ? 1 : 0; }
    int sincl = scnt; ROW16_SCAN(sincl);
    int slot = sincl - scnt;
    unsigned char* selrow = SEL + (((size_t)b * 8192 + tq) * 4 + g) * 16;
#pragma unroll
    for (int jj = 0; jj < 8; ++jj) if (sel[jj]) { selrow[slot] = (unsigned char)(8 * jc + jj); ++slot; }
#undef ROW16_SUM
#undef ROW16_SCAN
    __syncthreads();
}

struct SelFr { bf16x8 k[8], v[8]; };
__device__ __forceinline__ float wave_max64(float v) {
#pragma unroll
    for (int o = 1; o < 64; o <<= 1) v = fmaxf(v, __shfl_xor(v, o));
    return v;
}
__device__ __forceinline__ float wave_sum64(float v) {
#pragma unroll
    for (int o = 1; o < 64; o <<= 1) v += __shfl_xor(v, o);
    return v;
}
__device__ __forceinline__ void nsa_selected_phase(LAS unsigned char* lds, int gw, int ngw, const bf16_t* QH, const bf16_t* KF, const bf16_t* VF, const unsigned char* SEL, const float* TAB, const float* GATE,
                                                   const bf16_t* OC, const bf16_t* OW, bf16_t* O) {
    const int tid = otid(), lane = tid & 63, wid = __builtin_amdgcn_readfirstlane(tid >> 6), r32 = lane & 31, hi = lane >> 5;
    LAS float* TABL = (LAS float*)lds;
    for (int i = tid; i < 2048; i += 512) TABL[i] = TAB[i];
    __syncthreads();
    LAS unsigned char* pt = lds + 8192 + wid * 1024;
    const int ppos = (lane & ~12) | ((lane & 4) << 1) | ((lane & 8) >> 1);
#define SEL_LOAD(S, j_) do { const bf16_t* kb_ = KF + ((size_t)(bg * 128 + (j_)) * 8) * 512 + lane * 8; const bf16_t* vb_ = VF + ((size_t)(bg * 128 + (j_)) * 8) * 512 + lane * 8; \
        _Pragma("unroll") for (int f_ = 0; f_ < 8; ++f_) { S.k[f_] = *(const bf16x8*)(kb_ + f_ * 512); S.v[f_] = *(const bf16x8*)(vb_ + f_ * 512); } } while (0)
#define SEL_COMPUTE(S, j_) do { f32x16 p0, p1; \
        _Pragma("unroll") for (int r_ = 0; r_ < 16; ++r_) { p0[r_] = 0.f; p1[r_] = 0.f; } \
        _Pragma("unroll") for (int d0 = 0; d0 < 4; ++d0) { p0 = __builtin_amdgcn_mfma_f32_32x32x16_bf16(qa[d0], S.k[d0], p0, 0, 0, 0); p1 = __builtin_amdgcn_mfma_f32_32x32x16_bf16(qa[d0], S.k[4 + d0], p1, 0, 0, 0); } \
        float s_[4]; _Pragma("unroll") for (int h = 0; h < 4; ++h) s_[h] = hi ? p1[h] : p0[h]; \
        if (64 * (j_) + 63 >= t - 127) { const int dist = t - (64 * (j_) + lane); const int idx = min(max(dist, 0), 127); \
            _Pragma("unroll") for (int h = 0; h < 4; ++h) s_[h] = (dist >= 0) ? s_[h] + TABL[(g * 4 + h) * 128 + idx] : NEGV; } \
        const bool ex_ = (s_[0] > m_run[0] + 8.f) || (s_[1] > m_run[1] + 8.f) || (s_[2] > m_run[2] + 8.f) || (s_[3] > m_run[3] + 8.f); \
        if (__any(ex_)) { float asel = 1.f; \
            _Pragma("unroll") for (int h = 0; h < 4; ++h) { const float mn = fmaxf(m_run[h], wave_max64(s_[h])); const float al = ex2(m_run[h] - mn); ll[h] *= al; m_run[h] = mn; if ((r32 & 3) == h) asel = al; } \
            _Pragma("unroll") for (int r_ = 0; r_ < 16; ++r_) { o[0][r_] *= asel; o[1][r_] *= asel; } } \
        _Pragma("unroll") for (int h = 0; h < 4; ++h) { const float p_ = ex2(s_[h] - m_run[h]); ll[h] += p_; *(LAS unsigned short*)(pt + h * 144 + ppos * 2) = (unsigned short)(pg8::cvt_pk_bf16(p_, 0.f) & 0xffffu); } \
        bf16x8 pf[4]; _Pragma("unroll") for (int ks = 0; ks < 4; ++ks) pf[ks] = *(const LAS bf16x8*)(pt + (r32 & 3) * 144 + (16 * ks + 8 * hi) * 2); \
        _Pragma("unroll") for (int db = 0; db < 2; ++db) _Pragma("unroll") for (int ks = 0; ks < 4; ++ks) o[db] = __builtin_amdgcn_mfma_f32_32x32x16_bf16(S.v[db * 4 + ks], pf[ks], o[db], 0, 0, 0); } while (0)
#define SEL_BYTE(i_) __builtin_amdgcn_readfirstlane((int)(((((i_) < 4) ? selw.x : ((i_) < 8) ? selw.y : ((i_) < 12) ? selw.z : selw.w) >> (8 * ((i_) & 3))) & 255u))
    const int nper = ngw >> 3;
    for (int it = gw % nper; it < 8192; it += nper) {
        const int bg = gw / nper, b = bg >> 2, g = bg & 3, t = it, tokI = b * 8192 + t; const size_t tok = (size_t)tokI;
        const int head = g * 4 + (r32 & 3);
        bf16x8 qa[4];
#pragma unroll
        for (int d0 = 0; d0 < 4; ++d0) qa[d0] = *(const bf16x8*)(QH + tok * 1024 + head * 64 + 16 * d0 + 8 * hi);
        const u32x4 selw = *(const u32x4*)(SEL + (tok * 4 + g) * 16);
        float m_run[4], ll[4]; f32x16 o[2];
#pragma unroll
        for (int h = 0; h < 4; ++h) { m_run[h] = NEGV; ll[h] = 0.f; }
#pragma unroll
        for (int r = 0; r < 16; ++r) { o[0][r] = 0.f; o[1][r] = 0.f; }
        SelFr A, B;
        int jn = SEL_BYTE(0); SEL_LOAD(A, jn);
#pragma unroll 1
        for (int i = 0; i < 16; i += 2) {
            const int j0 = jn; jn = SEL_BYTE(i + 1); SEL_LOAD(B, jn);
            if (64 * j0 <= t) SEL_COMPUTE(A, j0);
            const int j1 = jn; if (i + 2 < 16) { jn = SEL_BYTE(i + 2); SEL_LOAD(A, jn); }
            if (64 * j1 <= t) SEL_COMPUTE(B, j1);
        }
        float lsel = 1.f;
#pragma unroll
        for (int h = 0; h < 4; ++h) { const float lt = wave_sum64(ll[h]); if ((r32 & 3) == h) lsel = lt; }
        if (r32 < 4) {
            const float inv = GATE[tok * 48 + head * 3 + 1] / lsel;
#pragma unroll
            for (int db = 0; db < 2; ++db)
#pragma unroll
                for (int gq = 0; gq < 4; ++gq) { const size_t off = tok * 1024 + head * 64 + 32 * db + 8 * gq + 4 * hi;
                    const u32x2 c = *(const u32x2*)(OC + off), w = *(const u32x2*)(OW + off);
                    const float r0 = o[db][4 * gq] * inv + __uint_as_float(c.x << 16) + __uint_as_float(w.x << 16), r1 = o[db][4 * gq + 1] * inv + __uint_as_float(c.x & 0xffff0000u) + __uint_as_float(w.x & 0xffff0000u);
                    const float r2 = o[db][4 * gq + 2] * inv + __uint_as_float(c.y << 16) + __uint_as_float(w.y << 16), r3 = o[db][4 * gq + 3] * inv + __uint_as_float(c.y & 0xffff0000u) + __uint_as_float(w.y & 0xffff0000u);
                    u32x2 ov; ov.x = pg8::cvt_pk_bf16(r0, r1); ov.y = pg8::cvt_pk_bf16(r2, r3); *(u32x2*)(O + off) = ov; }
        }
    }
#undef SEL_LOAD
#undef SEL_COMPUTE
#undef SEL_BYTE
    __syncthreads();
}
}
typedef unsigned v4u __attribute__((ext_vector_type(4)));
#define XB_TMO      128
#define XB_XCNT(j)  (256  + 64 * (j))
#define XB_XSUB(j)  (1280 + 64 * (j))
#define XB_XGEN(j)  (2304 + 64 * (j))
#define XB_TOP      3328
#define XB_TOPGEN   3392
#define XCD_BAR_WORDS 3456
#define XB_SPIN_CAP (1u << 18)

__device__ __forceinline__ unsigned xb_ld(unsigned* p)              { return __hip_atomic_load(p, __ATOMIC_RELAXED, __HIP_MEMORY_SCOPE_AGENT); }
__device__ __forceinline__ unsigned xb_add(unsigned* p, unsigned v) { return __hip_atomic_fetch_add(p, v, __ATOMIC_RELAXED, __HIP_MEMORY_SCOPE_AGENT); }
__device__ __forceinline__ unsigned xb_xcc_id() { return (unsigned)__builtin_amdgcn_s_getreg((3 << 11) | 20) & 0xFu; }
#define XB_SPIN(cond, bar) do { unsigned _sp = 0; while (cond) { __builtin_amdgcn_s_sleep(1); \
    if ((++_sp & 255u) == 0u) { if (xb_ld(&(bar)[XB_TMO])) break; if (_sp > XB_SPIN_CAP) { atomicAdd(&(bar)[XB_TMO], 1u); break; } } } } while (0)

struct XcdBarrier {
    unsigned* bar; unsigned x;
    volatile LAS unsigned* st;
};

__device__ __forceinline__ XcdBarrier xcd_barrier_post(unsigned* bar, volatile LAS unsigned* st) {
    XcdBarrier b; b.bar = bar; b.x = xb_xcc_id(); b.st = st;
    if (threadIdx.x == 0) (void)xb_add(&bar[XB_XCNT(b.x)], 1u);
    return b;
}
__device__ __forceinline__ void xcd_barrier_complete(unsigned* bar, unsigned x, unsigned& nloc, unsigned& nx) {
    const unsigned G = gridDim.x * gridDim.y * gridDim.z;
    unsigned sum, cnt, mine, sp = 0u;
    for (;;) {
        sum = 0u; cnt = 0u; mine = 0u;
#pragma unroll
        for (unsigned j = 0; j < 16; ++j) { const unsigned c = xb_ld(&bar[XB_XCNT(j)]); sum += c; cnt += (c > 0u) ? 1u : 0u; mine = (j == x) ? c : mine; }
        if (sum == G) break;
        __builtin_amdgcn_s_sleep(1);
        if ((++sp & 255u) == 0u) { if (xb_ld(&bar[XB_TMO])) break; if (sp > XB_SPIN_CAP) { atomicAdd(&bar[XB_TMO], 1u); break; } }
    }
    nloc = mine > 0u ? mine : 1u; nx = cnt > 0u ? cnt : 1u;
}

__device__ __forceinline__ void xcd_barrier(const XcdBarrier& b) {
    asm volatile("s_waitcnt vmcnt(0)" ::: "memory");
    __syncthreads();
    if (threadIdx.x == 0) {
        unsigned* bar = b.bar;
        __builtin_amdgcn_s_waitcnt(0);
        unsigned nloc = b.st[0], nx = b.st[1];
        if (nloc == 0u) { xcd_barrier_complete(bar, b.x, nloc, nx); b.st[0] = nloc; b.st[1] = nx; }
        const unsigned old = xb_add(&bar[XB_XSUB(b.x)], 1u);
        const unsigned gen = old / nloc;
        if (old + 1u == (gen + 1u) * nloc) {
            __builtin_amdgcn_fence(__ATOMIC_RELEASE, "agent");
            asm volatile("s_waitcnt vmcnt(0)" ::: "memory");
            const unsigned og = xb_add(&bar[XB_TOP], 1u);
            const unsigned tg = og / nx;
            if (og + 1u == (tg + 1u) * nx) xb_add(&bar[XB_TOPGEN], 1u);
            else XB_SPIN(xb_ld(&bar[XB_TOPGEN]) == tg, bar);
            __builtin_amdgcn_fence(__ATOMIC_ACQUIRE, "agent");
            xb_add(&bar[XB_XGEN(b.x)], 1u);
            asm volatile("s_waitcnt vmcnt(0)" ::: "memory");
        } else {
            XB_SPIN(xb_ld(&bar[XB_XGEN(b.x)]) == gen, bar);
            __builtin_amdgcn_fence(__ATOMIC_ACQUIRE, "agent");
            asm volatile("s_waitcnt vmcnt(0)" ::: "memory");
        }
    }
    __syncthreads();
}
using pg8::bf16_t; using pg8::f32x4; using pg8::u32x4; using pg8::u32x2;
constexpr int NWAVES = 8, NTHREADS = 512;
constexpr int MTOK = 16384, DM = 1024, SEQ = 8192, DFF = 4096;
constexpr float NORM_EPS = 1e-6f, LOG2E = 1.4426950408889634f, QSCALE = 0.125f * 1.4426950408889634f;
constexpr size_t MiB = 1u << 20;
constexpr size_t WS_TAB = 0;
constexpr size_t WS_C1P = 64 * 1024;
constexpr size_t WS_CTL = 512 * 1024, CTL_BYTES = 16 * 1024;
constexpr size_t WS_W1T = 1 * MiB, WS_W2T = 9 * MiB, WS_WGT = 17 * MiB, WS_WPT = 19 * MiB, WS_WOT = 20 * MiB, WS_WIN = 22 * MiB, WS_WVT = 30 * MiB, WS_WB = 32 * MiB;
constexpr size_t WS_CW1 = 34 * MiB;
constexpr size_t WS_CW2 = 38 * MiB;
constexpr size_t WS_XH = 40 * MiB;
constexpr size_t WS_BIG = 72 * MiB;
constexpr size_t WS_Y = 200 * MiB;
constexpr size_t WS_AUX = 264 * MiB;
constexpr size_t WS_PB = 296 * MiB;
constexpr size_t WS_LF = 304 * MiB, WS_KBIAS = 305 * MiB, WS_SEL = 306 * MiB, WS_GATE = 307 * MiB;
constexpr size_t WS_KC = 310 * MiB;
constexpr size_t WS_END = 312 * MiB;
constexpr int LDS_BYTES = 147456, LDS_MISC = 131072 + 320;

__device__ const unsigned char kBucket[128] = {0, 1, 2, 3, 4, 5, 6, 7, 8, 9, 10, 11, 12, 13, 14, 15, 16, 16, 16, 17, 17, 18, 18, 18, 19, 19, 19, 20, 20, 20, 20, 21, 21, 21, 21, 22, 22, 22, 22, 22, 23, 23, 23, 23, 23, 23, 24, 24, 24, 24, 24, 24,
    25, 25, 25, 25, 25, 25, 25, 26, 26, 26, 26, 26, 26, 26, 26, 27, 27, 27, 27, 27, 27, 27, 27, 27, 27, 28, 28, 28, 28, 28, 28, 28, 28, 28, 28, 29, 29, 29, 29, 29, 29, 29, 29, 29, 29, 29, 29, 30, 30, 30, 30, 30, 30, 30, 30, 30, 30, 30, 30, 30, 30,
    31, 31, 31, 31, 31, 31, 31, 31, 31, 31, 31, 31, 31, 31, 31};

struct Args { const float* in[20]; float* out; unsigned char* ws; int ph_lo, ph_hi; };
enum { IN_X = 0, IN_P, IN_REL, IN_NG, IN_W1, IN_W2, IN_PLEW, IN_GATEW, IN_DAIN, IN_DALAM, IN_DASUB, IN_DAOUT, IN_NSAIN, IN_NSAPE, IN_NSAW1, IN_NSAW2, IN_NSAOUT, IN_FOXIN, IN_FOXB, IN_FOXOUT };

__device__ __forceinline__ float wave_sum(float v) {
#pragma unroll
    for (int o = 1; o < 64; o <<= 1) v += __shfl_xor(v, o);
    return v;
}
__device__ __forceinline__ unsigned pk2(float lo, float hi) { return pg8::cvt_pk_bf16(lo, hi); }

__device__ __forceinline__ void tr_item(const float* W, int ldn, int cbeg, int nvalid, bf16_t* dst, int ldd, int row0, int kofs, int lo, LAS float* scr, int kb, int nb, int lane) {
    const int k0 = 64 * kb, n0 = 32 * nb;
    float ld_[32]; const int nn = n0 + (lane & 31); const float* wp = W + (size_t)(k0 + (lane >> 5)) * ldn + cbeg + nn;
#pragma unroll
    for (int i = 0; i < 32; ++i) ld_[i] = (nn < nvalid) ? wp[(size_t)(2 * i) * ldn] : 0.f;
#pragma unroll
    for (int i = 0; i < 32; ++i) scr[(2 * i + (lane >> 5)) * 33 + (lane & 31)] = ld_[i];
    asm volatile("s_waitcnt lgkmcnt(0)" ::: "memory");
    const int c = lane & 7;
#pragma unroll
    for (int j = 0; j < 4; ++j) { const int n = (lane >> 3) + 8 * j; const LAS float* s = scr + (8 * c) * 33 + n; float v[8];
#pragma unroll
        for (int i = 0; i < 8; ++i) { v[i] = s[i * 33]; if (lo) v[i] = v[i] - pg8::bf2f(pg8::f2bf_rne(v[i])); }
        u32x4 o; o.x = pk2(v[0], v[1]); o.y = pk2(v[2], v[3]); o.z = pk2(v[4], v[5]); o.w = pk2(v[6], v[7]);
        *(u32x4*)(dst + (size_t)(row0 + n0 + n) * ldd + kofs + k0 + 8 * c) = o; }
    asm volatile("s_waitcnt lgkmcnt(0)" ::: "memory");
}
__device__ __forceinline__ void tr_job(const float* W, int K, int ldn, int cbeg, int nvalid, int npad, bf16_t* dst, int ldd, int row0, int kofs, int lo, LAS float* scr, int gw, int ngw, int lane) {
    const int nnb = npad / 32, nitems = (K / 64) * nnb;
    for (int it = gw; it < nitems; it += ngw) tr_item(W, ldn, cbeg, nvalid, dst, ldd, row0, kofs, lo, scr, it / nnb, it % nnb, lane);
}

template <int MODE  >
__device__ __forceinline__ void norm_rows(const float* xsrc, float* X, const float* Y, const float* ga, const float* gb, bf16_t* XH, bf16_t* H3, int gw, int ngw, int lane) {
    constexpr int R = 2;
    for (int m0 = gw * R; m0 < MTOK; m0 += ngw * R) {
        f32x4 v[R][4], y[R][4];
#pragma unroll
        for (int q = 0; q < R; ++q) { const f32x4* xr = (const f32x4*)(xsrc + (size_t)(m0 + q) * DM) + lane;
#pragma unroll
            for (int j = 0; j < 4; ++j) v[q][j] = xr[64 * j];
            if (MODE != 0) { const f32x4* yr = (const f32x4*)(Y + (size_t)(m0 + q) * DM) + lane;
#pragma unroll
                for (int j = 0; j < 4; ++j) y[q][j] = yr[64 * j]; } }
#pragma unroll
        for (int q = 0; q < R; ++q) { const int m = m0 + q;
            if (MODE != 0) { float s = 0.f;
#pragma unroll
                for (int j = 0; j < 4; ++j) s += (y[q][j][0] * y[q][j][0] + y[q][j][1] * y[q][j][1]) + (y[q][j][2] * y[q][j][2] + y[q][j][3] * y[q][j][3]);
                const float ry = rsqrtf(wave_sum(s) * (1.f / DM) + NORM_EPS);
#pragma unroll
                for (int j = 0; j < 4; ++j) { const f32x4 g = ((const f32x4*)ga)[lane + 64 * j]; v[q][j] = v[q][j] + y[q][j] * ry * g; } }
            if (MODE != 0 || xsrc != X) { f32x4* xo = (f32x4*)(X + (size_t)m * DM) + lane;
#pragma unroll
                for (int j = 0; j < 4; ++j) xo[64 * j] = v[q][j]; }
            if (MODE != 2) { float s = 0.f;
#pragma unroll
                for (int j = 0; j < 4; ++j) s += (v[q][j][0] * v[q][j][0] + v[q][j][1] * v[q][j][1]) + (v[q][j][2] * v[q][j][2] + v[q][j][3] * v[q][j][3]);
                const float rx = rsqrtf(wave_sum(s) * (1.f / DM) + NORM_EPS);
#pragma unroll
                for (int j = 0; j < 4; ++j) { const f32x4 g = ((const f32x4*)gb)[lane + 64 * j]; v[q][j] = v[q][j] * rx * g; } }
            u32x2* ho = (u32x2*)(XH + (size_t)m * DM) + lane;
#pragma unroll
            for (int j = 0; j < 4; ++j) { u32x2 h; h.x = pk2(v[q][j][0], v[q][j][1]); h.y = pk2(v[q][j][2], v[q][j][3]); ho[64 * j] = h;
                if (MODE == 0) { if (H3) { u32x2 l; l.x = pk2(v[q][j][0] - __uint_as_float(h.x << 16), v[q][j][1] - __uint_as_float(h.x & 0xffff0000u)); l.y = pk2(v[q][j][2] - __uint_as_float(h.y << 16), v[q][j][3] - __uint_as_float(h.y & 0xffff0000u));
                    u32x2* h3 = (u32x2*)(H3 + (size_t)m * 3072) + lane; h3[64 * j] = h; h3[256 + 64 * j] = h; h3[512 + 64 * j] = l; } } } }
    }
}

template <class Epi> __device__ __forceinline__ void run_gemm(LAS unsigned char* lds, const bf16_t* A, const bf16_t* Bt, int M, int N, int K, const Epi& E, int rot = 0) {
    pg8::Gemm g{A, Bt, M, N, oqi(K)}; pg8::StaticOrder S; const int G_ = oqi((int)gridDim.x); S.init(M, N, G_, (oqi((int)blockIdx.x) + rot) % G_);
    pg8::gemm_phase<Epi, pg8::StaticOrder, true, true>((PG8_LAS unsigned char*)lds, g, S, E);
}

#ifndef FLASH_DA
#define FLASH_DA fa::flash_unit_reg
#endif
#ifndef FLASH_FOX
#define FLASH_FOX fa::flash_unit_reg
#endif
#ifndef FLASH_NSA
#define FLASH_NSA fa::flash_unit_reg
#endif
#ifndef ONLY_PK
#define ONLY_PK -1
#endif
#ifndef ONLY_KIND
#define ONLY_KIND -1
#endif
#define PH_ON(k) (ONLY_PK < 0 || ONLY_PK == (k))
#define KIND_IS(kk) ((ONLY_KIND < 0 || ONLY_KIND == (kk)) && kind == (kk))
__device__ __forceinline__ int layer_kind(int layer) { return layer % 3; }
__device__ __forceinline__ int layer_nph(int layer) { return layer_kind(layer) == 1 ? 11 : 10; }
constexpr int N_PHASES = 10 + 11 + 10 + 10;
enum { PK_PRO = 0, PK_INPROJ, PK_MIX1, PK_MIX2, PK_MIX3, PK_OUTPROJ, PK_NORMB, PK_UP, PK_DOWN, PK_NORMC, PK_GATE };

__global__ void __launch_bounds__(NTHREADS, 2) trunk_fwd(Args args) {
    extern __shared__ __attribute__((aligned(16))) unsigned char lds_raw[];
    LAS unsigned char* lds = (LAS unsigned char*)lds_raw;
#define X (args.out)
#define TAB ((float*)(ws + WS_TAB))
#define C1P ((float*)(ws + WS_C1P))
#define W1T ((bf16_t*)(ws + WS_W1T))
#define W2T ((bf16_t*)(ws + WS_W2T))
#define WGT ((bf16_t*)(ws + WS_WGT))
#define WPT ((bf16_t*)(ws + WS_WPT))
#define WOT ((bf16_t*)(ws + WS_WOT))
#define WIN ((bf16_t*)(ws + WS_WIN))
#define WVT ((bf16_t*)(ws + WS_WVT))
#define WB ((bf16_t*)(ws + WS_WB))
#define CW1 ((bf16_t*)(ws + WS_CW1))
#define CW2 ((bf16_t*)(ws + WS_CW2))
#define XH ((bf16_t*)(ws + WS_XH))
#define BIG ((bf16_t*)(ws + WS_BIG))
#define Y ((float*)(ws + WS_Y))
#define PB ((bf16_t*)(ws + WS_PB))
#define AUX ((bf16_t*)(ws + WS_AUX))
#define LF ((float*)(ws + WS_LF))
#define KBIAS ((float*)(ws + WS_KBIAS))
#define SEL (ws + WS_SEL)
#define GATE ((float*)(ws + WS_GATE))
#define KCH ((bf16_t*)(ws + WS_KC))
#define KCL (KCH + 262144)
#define VCT (KCH + 524288)
#define QK BIG
#define VT (BIG + 32 * MiB)
#define O_DF (BIG + 48 * MiB)
#define OD ((bf16_t*)(ws + WS_Y))
#define H3 BIG
#define KSb (BIG + 48 * MiB)
#define KWb (BIG + 52 * MiB)
#define VTn (BIG + 56 * MiB)
#define OC BIG
#define OW (BIG + 16 * MiB)
#define O_N (BIG + 32 * MiB)
#define QH ((bf16_t*)(ws + WS_Y))
#define QL (QH + 16 * MiB)
#define KIH AUX
#define KIL (AUX + (9 * MiB) / 2)
#define VCI (AUX + 9 * MiB)
#define PW AUX
#define U BIG
    cg::grid_group grid = cg::this_grid();
    { volatile LAS unsigned* misc = (volatile LAS unsigned*)(lds + LDS_MISC); if (threadIdx.x < 32) misc[threadIdx.x] = 0u; }
    __syncthreads();
    XcdBarrier xbar = xcd_barrier_post((unsigned*)(args.ws + WS_CTL), (volatile LAS unsigned*)(lds + LDS_MISC + 32));

    int layer = 0, base = 0;
#if REP_PK >= 0
    int rep_done = 0;
#endif
    for (int ph = args.ph_lo; ph < args.ph_hi; ++ph) {
        const int wave = __builtin_amdgcn_readfirstlane(otid() >> 6);
#define TIDL const int tid = otid(), lane = tid & 63; (void)tid; (void)lane;
        const int G = oqi((int)gridDim.x), bx = oqi((int)blockIdx.x); const int vcu = (G % 8 == 0) ? (bx % 8) * (G / 8) + bx / 8 : bx;
        const int gw = vcu * NWAVES + wave, ngw = G * NWAVES;
        unsigned char* ws = oq(args.ws);
        while (ph - base >= layer_nph(layer)) { base += layer_nph(layer); ++layer; }
        const int kind = layer_kind(layer); int pk = ph - base; if (kind != 1 && pk >= PK_MIX3) pk += 1;
        const int mi = layer / 3;
        const float* ng = args.in[IN_NG] + (size_t)layer * 4 * DM;
        bf16_t* Omix = (kind == 1) ? O_N : O_DF;
        LAS float* scr = (LAS float*)(lds + wave * 16384);
        switch (pk) {
        case PK_PRO: if (PH_ON(PK_PRO)) { TIDL
            if (layer == 0 && bx == 0) { const float* rel = args.in[IN_REL]; for (int i = tid; i < 2048; i += NTHREADS) { const int head = i >> 7, d = i & 127; TAB[i] = (rel[kBucket[d] * 16 + head] - rel[31 * 16 + head]) * LOG2E; } }
            tr_job(args.in[IN_W1] + (size_t)layer * DM * DFF, DM, DFF, 0, DFF, DFF, W1T, DM, 0, 0, 0, scr, gw, ngw, lane);
            tr_job(args.in[IN_W2] + (size_t)layer * DFF * DM, DFF, DM, 0, DM, DM, W2T, DFF, 0, 0, 0, scr, gw, ngw, lane);
            tr_job(args.in[IN_GATEW] + (size_t)layer * DM * DM, DM, DM, 0, DM, DM, WGT, DM, 0, 0, 0, scr, gw, ngw, lane);
            tr_job(args.in[IN_PLEW] + (size_t)layer * 256 * DM, 256, DM, 0, DM, DM, WPT, 256, 0, 0, 0, scr, gw, ngw, lane);
            if (kind == 0) { const float* wi = args.in[IN_DAIN] + (size_t)mi * DM * 3072;
                tr_job(args.in[IN_DAOUT] + (size_t)mi * DM * DM, DM, DM, 0, DM, DM, WOT, DM, 0, 0, 0, scr, gw, ngw, lane);
                tr_job(wi, DM, 3072, 0, 2048, 2048, WIN, DM, 0, 0, 0, scr, gw, ngw, lane);
                tr_job(wi, DM, 3072, 2048, 1024, 1024, WVT, DM, 0, 0, 0, scr, gw, ngw, lane);
            } else if (kind == 2) { const float* wi = args.in[IN_FOXIN] + (size_t)mi * DM * 3088;
                tr_job(args.in[IN_FOXOUT] + (size_t)mi * DM * DM, DM, DM, 0, DM, DM, WOT, DM, 0, 0, 0, scr, gw, ngw, lane);
                tr_job(wi, DM, 3088, 0, 2048, 2048, WIN, DM, 0, 0, 0, scr, gw, ngw, lane);
                tr_job(wi, DM, 3088, 3072, 16, 256, WIN, DM, 2048, 0, 0, scr, gw, ngw, lane);
                tr_job(wi, DM, 3088, 2048, 1024, 1024, WVT, DM, 0, 0, 0, scr, gw, ngw, lane);
            } else { const float* wi = args.in[IN_NSAIN] + (size_t)mi * DM * 2608;
                tr_job(args.in[IN_NSAOUT] + (size_t)mi * DM * DM, DM, DM, 0, DM, DM, WOT, DM, 0, 0, 0, scr, gw, ngw, lane);
                tr_job(wi, DM, 2608, 0, 1280, 1280, WIN, 3072, 0, 0, 0, scr, gw, ngw, lane);
                tr_job(wi, DM, 2608, 0, 1280, 1280, WIN, 3072, 0, 1024, 1, scr, gw, ngw, lane);
                tr_job(wi, DM, 2608, 0, 1280, 1280, WIN, 3072, 0, 2048, 0, scr, gw, ngw, lane);
                tr_job(wi, DM, 2608, 1280, 256, 256, WB, DM, 0, 0, 0, scr, gw, ngw, lane);
                tr_job(wi, DM, 2608, 1536, 256, 256, WB, DM, 256, 0, 0, scr, gw, ngw, lane);
                tr_job(wi, DM, 2608, 2048, 256, 256, WB, DM, 512, 0, 0, scr, gw, ngw, lane);
                tr_job(wi, DM, 2608, 2560, 48, 256, WB, DM, 768, 0, 0, scr, gw, ngw, lane);
                tr_job(wi, DM, 2608, 1792, 256, 256, WVT, DM, 0, 0, 0, scr, gw, ngw, lane);
                tr_job(wi, DM, 2608, 2304, 256, 256, WVT, DM, 256, 0, 0, scr, gw, ngw, lane);
                const float* cw1 = args.in[IN_NSAW1] + (size_t)mi * 2 * 2048 * 256; const float* cw2 = args.in[IN_NSAW2] + (size_t)mi * 2 * 256 * 64;
                tr_job(cw1, 2048, 256, 0, 256, 256, CW1, 2048, 0, 0, 0, scr, gw, ngw, lane);
                tr_job(cw1, 2048, 256, 0, 256, 256, CW1 + 524288, 2048, 0, 0, 1, scr, gw, ngw, lane);
                tr_job(cw1 + 2048 * 256, 2048, 256, 0, 256, 256, CW1 + 2 * 524288, 2048, 0, 0, 0, scr, gw, ngw, lane);
                tr_job(cw2, 256, 64, 0, 64, 64, CW2, 256, 0, 0, 0, scr, gw, ngw, lane);
                tr_job(cw2, 256, 64, 0, 64, 64, CW2 + 16384, 256, 0, 0, 1, scr, gw, ngw, lane);
                tr_job(cw2 + 256 * 64, 256, 64, 0, 64, 64, CW2 + 2 * 16384, 256, 0, 0, 0, scr, gw, ngw, lane);
                const float* pe = args.in[IN_NSAPE] + (size_t)mi * 2 * 2048;
                for (int task = gw; task < 256; task += ngw) { const int which = task >> 7, kc = (task >> 2) & 31, cc = task & 3; const float* w = cw1 + (size_t)which * 2048 * 256 + (size_t)(64 * kc) * 256 + 64 * cc + lane;
                    const float* pp = pe + which * 2048 + 64 * kc; float s = 0.f;
                    for (int k = 0; k < 64; ++k) s += pp[k] * w[(size_t)k * 256];
                    C1P[(which * 32 + kc) * 256 + 64 * cc + lane] = s; }
            }
            { const f32x4* src = (const f32x4*)(args.in[IN_P] + (size_t)layer * MTOK * 256); u32x4* dstp = (u32x4*)PB;
              for (int i = bx * NTHREADS + tid; i < MTOK * 256 / 8; i += G * NTHREADS) { const f32x4 a = src[2 * i], b = src[2 * i + 1]; dstp[i] = pg8::pack8(a, b); } }
            norm_rows<0>(layer == 0 ? args.in[IN_X] : (const float*)X, X, nullptr, nullptr, ng, XH, kind == 1 ? H3 : (bf16_t*)nullptr, gw, ngw, lane);
        } break;
        case PK_INPROJ: if (PH_ON(PK_INPROJ)) {
            if (kind == 1) {
                pg8::EpiNsaA EA{QH, QL, KIH, KIL, QSCALE}; run_gemm(lds, H3, WIN, MTOK, 1280, 3072, EA);
                pg8::EpiNsaB EB{VCI, KSb, KWb, GATE}; run_gemm(lds, XH, WB, MTOK, 1024, DM, EB);
                pg8::EpiVt EV{VTn, MTOK, 256}; run_gemm(lds, WVT, XH, 512, MTOK, DM, EV, 128);
            } else {
                pg8::EpiQK EQ{QK, LF, args.in[IN_FOXB] + (size_t)mi * 16, QSCALE}; run_gemm(lds, XH, WIN, MTOK, kind == 2 ? 2304 : 2048, DM, EQ);
                pg8::EpiVt EV{VT, MTOK, 0}; run_gemm(lds, WVT, XH, 1024, MTOK, DM, EV);
            }
        } break;
        case PK_MIX1: if (PH_ON(PK_MIX1)) { TIDL
            if (kind == 0) {
                fa::AttnOrder ord{vcu, G}; int bh, qb;
                for (int i = 0; ord.next(i, bh, qb); ++i) { const int b = bh >> 4, sh = bh & 15; fa::FlashArgs a;
                    a.Q = QK + ((size_t)b * SEQ + 256 * qb) * 2048 + sh * 64; a.ldq = 2048; a.K = QK + (size_t)b * SEQ * 2048 + 1024 + sh * 64; a.ldk = 2048;
                    a.Vt = VT + (size_t)((sh >> 1) * 128) * MTOK + (size_t)b * SEQ; a.ldv = MTOK; a.q0 = 256 * qb; a.t_lo = 0; a.t_hi = 4 * qb + 3; a.pa = 1; a.pb = 0; a.window = 1 << 30;
                    a.kbias = nullptr; a.tab = TAB + sh * 128; a.O = OD + ((size_t)b * SEQ + 256 * qb) * 2048 + sh * 128; a.ldo = 2048; a.gate = nullptr; a.ldg = 0;
                    FLASH_DA<128, 2, 0>(lds, a); }
            } else if (kind == 2) {
                if (vcu < 32) { const int b = vcu >> 4, h = vcu & 15; const float* src = LF + ((size_t)b * SEQ + 16 * tid) * 16 + h; float v[16];
#pragma unroll
                    for (int i = 0; i < 16; ++i) v[i] = src[(size_t)i * 16];
#pragma unroll
                    for (int i = 1; i < 16; ++i) v[i] += v[i - 1];
                    float incl = v[15];
#pragma unroll
                    for (int o = 1; o < 64; o <<= 1) { const float tmp = __shfl_up(incl, o); if (lane >= o) incl += tmp; }
                    LAS float* wt = (LAS float*)lds;
                    if (lane == 63) wt[wave] = incl;
                    __syncthreads();
                    float off = incl - v[15];
                    for (int w = 0; w < wave; ++w) off += wt[w];
                    f32x4* dst = (f32x4*)(KBIAS + (size_t)(b * 16 + h) * SEQ + 16 * tid);
#pragma unroll
                    for (int q = 0; q < 4; ++q) { f32x4 ov; ov[0] = -(off + v[4 * q]) * LOG2E; ov[1] = -(off + v[4 * q + 1]) * LOG2E; ov[2] = -(off + v[4 * q + 2]) * LOG2E; ov[3] = -(off + v[4 * q + 3]) * LOG2E; dst[q] = ov; }
                    __syncthreads(); }
            } else {
                for (int u = vcu; u < 256; u += G) { const int which = u >> 7, bg = (u >> 4) & 7, n0 = 32 * (u & 15);
                    if (which == 0) fa::nsa_compress_unit<true>(lds, bg, n0, KIH, KIL, CW1, CW1 + 524288, CW2, CW2 + 16384, C1P, KCH, KCL, VCT);
                    else fa::nsa_compress_unit<false>(lds, bg, n0, VCI, nullptr, CW1 + 2 * 524288, nullptr, CW2 + 2 * 16384, nullptr, C1P + 32 * 256, KCH, KCL, VCT); }
            }
        } break;
        case PK_MIX2: if (PH_ON(PK_MIX2)) { TIDL
            if (kind == 0) {
                const float* lamp = args.in[IN_DALAM] + (size_t)mi * 256; const float lam_init = 0.8f - 0.6f * expf(-0.3f * (float)layer);
                const float lam = expf(wave_sum(lamp[lane] * lamp[64 + lane])) - expf(wave_sum(lamp[128 + lane] * lamp[192 + lane])) + lam_init;
                const float* sg = args.in[IN_DASUB] + (size_t)mi * 128; const int hd = lane >> 3, e0 = (lane & 7) * 16;
                float gsc[16];
#pragma unroll
                for (int i = 0; i < 16; ++i) gsc[i] = sg[e0 + i] * (1.f - lam_init);
                for (int m = gw; m < MTOK; m += ngw) { const bf16_t* p0 = OD + (size_t)m * 2048 + (2 * hd) * 128 + e0; const bf16_t* p1 = p0 + 128;
                    const u32x4 a0 = *(const u32x4*)p0, a1 = *(const u32x4*)(p0 + 8), b0 = *(const u32x4*)p1, b1 = *(const u32x4*)(p1 + 8);
                    const unsigned aw[8] = {a0.x, a0.y, a0.z, a0.w, a1.x, a1.y, a1.z, a1.w}, bw[8] = {b0.x, b0.y, b0.z, b0.w, b1.x, b1.y, b1.z, b1.w};
                    float v[16]; float s = 0.f;
#pragma unroll
                    for (int i = 0; i < 8; ++i) { v[2 * i] = __uint_as_float(aw[i] << 16) - lam * __uint_as_float(bw[i] << 16); v[2 * i + 1] = __uint_as_float(aw[i] & 0xffff0000u) - lam * __uint_as_float(bw[i] & 0xffff0000u);
                        s += v[2 * i] * v[2 * i] + v[2 * i + 1] * v[2 * i + 1]; }
                    s += __shfl_xor(s, 1); s += __shfl_xor(s, 2); s += __shfl_xor(s, 4);
                    const float r = rsqrtf(s * (1.f / 128.f) + NORM_EPS);
                    u32x4 o0, o1; o0.x = pk2(v[0] * r * gsc[0], v[1] * r * gsc[1]); o0.y = pk2(v[2] * r * gsc[2], v[3] * r * gsc[3]); o0.z = pk2(v[4] * r * gsc[4], v[5] * r * gsc[5]); o0.w = pk2(v[6] * r * gsc[6], v[7] * r * gsc[7]);
                    o1.x = pk2(v[8] * r * gsc[8], v[9] * r * gsc[9]); o1.y = pk2(v[10] * r * gsc[10], v[11] * r * gsc[11]); o1.z = pk2(v[12] * r * gsc[12], v[13] * r * gsc[13]); o1.w = pk2(v[14] * r * gsc[14], v[15] * r * gsc[15]);
                    bf16_t* op = O_DF + (size_t)m * DM + hd * 128 + e0; *(u32x4*)op = o0; *(u32x4*)(op + 8) = o1; }
            } else if (kind == 2) {
                fa::AttnOrder ord{vcu, G}; int bh, qb;
                for (int i = 0; ord.next(i, bh, qb); ++i) { const int b = bh >> 4, h = bh & 15; fa::FlashArgs a;
                    a.Q = QK + ((size_t)b * SEQ + 256 * qb) * 2048 + h * 64; a.ldq = 2048; a.K = QK + (size_t)b * SEQ * 2048 + 1024 + h * 64; a.ldk = 2048;
                    a.Vt = VT + (size_t)(h * 64) * MTOK + (size_t)b * SEQ; a.ldv = MTOK; a.q0 = 256 * qb; a.t_lo = 0; a.t_hi = 4 * qb + 3; a.pa = 1; a.pb = 0; a.window = 1 << 30;
                    a.kbias = KBIAS + (size_t)(b * 16 + h) * SEQ; a.tab = nullptr; a.O = O_DF + ((size_t)b * SEQ + 256 * qb) * DM + h * 64; a.ldo = DM; a.gate = nullptr; a.ldg = 0;
                    FLASH_FOX<64, 1, 0, -1>(lds, a); }
            } else {
                fa::AttnOrder ord{vcu, G}; int bh, qb;
                for (int br = 0; br < 2; ++br)
                    for (int i = 0; ord.next(i, bh, qb); ++i) { const int b = bh >> 4, h = bh & 15, g = h >> 2, q0 = 256 * qb; fa::FlashArgs a; const size_t tok0 = (size_t)b * SEQ + q0;
                        a.Q = QH + tok0 * DM + h * 64; a.ldq = DM; a.q0 = q0; a.tab = TAB + h * 128; a.kbias = nullptr; a.ldo = DM; a.ldg = 48;
                        if (br == 0) { a.K = KCH + (size_t)(b * 4 + g) * 512 * 64; a.ldk = 64; a.Vt = VCT + (size_t)(b * 4 + g) * 64 * 512; a.ldv = 512; a.t_lo = 0; a.t_hi = min(7, (q0 + 224) >> 10); a.pa = 16; a.pb = 31; a.window = 1 << 30;
                            a.O = OC + tok0 * DM + h * 64; a.gate = GATE + tok0 * 48 + h * 3 + 0; }
                        else { a.K = KWb + (size_t)b * SEQ * 256 + g * 64; a.ldk = 256; a.Vt = VTn + (size_t)(256 + g * 64) * MTOK + (size_t)b * SEQ; a.ldv = MTOK; a.t_lo = max(0, q0 - 511) >> 6; a.t_hi = (q0 + 255) >> 6; a.pa = 1; a.pb = 0; a.window = 512;
                            a.O = OW + tok0 * DM + h * 64; a.gate = GATE + tok0 * 48 + h * 3 + 2; }
                        FLASH_NSA<64, 2, 1>(lds, a); }
                for (int u = vcu; u < 2048; u += G) { const int b = u >> 10, g = (u >> 8) & 3, qblk = u & 255; fa::nsa_importance_unit(lds, b, g, qblk, QH, QL, KCH, KCL, TAB, SEL); }
            }
        } break;
        case PK_MIX3: if (PH_ON(PK_MIX3)) { fa::nsa_selected_phase(lds, gw, ngw, QH, KSb, VTn, SEL, TAB, GATE, OC, OW, O_N); } break;
        case PK_OUTPROJ: if (PH_ON(PK_OUTPROJ)) { pg8::EpiF32 E{Y, DM}; run_gemm(lds, Omix, WOT, MTOK, DM, DM, E); } break;
        case PK_NORMB: if (PH_ON(PK_NORMB)) { TIDL norm_rows<1>(X, X, Y, ng + DM, ng + 2 * DM, XH, nullptr, gw, ngw, lane); } break;
        case PK_UP: if (PH_ON(PK_UP)) { pg8::EpiAct<1> E{U, DFF}; run_gemm(lds, XH, W1T, MTOK, DFF, DM, E); } break;
        case PK_DOWN: if (PH_ON(PK_DOWN)) { pg8::EpiF32 E{Y, DM}; run_gemm(lds, U, W2T, MTOK, DM, DFF, E); } break;
        case PK_NORMC: if (PH_ON(PK_NORMC)) { TIDL norm_rows<2>(X, X, Y, ng + 3 * DM, nullptr, XH, nullptr, gw, ngw, lane);
                        pg8::EpiAct<0> E2{PW, DM}; run_gemm(lds, PB, WPT, MTOK, DM, 256, E2); } break;
        case PK_GATE: if (PH_ON(PK_GATE)) { pg8::EpiGate E{X, PW}; run_gemm(lds, XH, WGT, MTOK, DM, DM, E); } break;
        default: break;
        }
#if REP_PK >= 0
        if (pk == REP_PK && (REP_LAYER < 0 || layer == REP_LAYER) && rep_done == 0) { rep_done = 1; xcd_barrier(xbar); --ph; continue; }
        rep_done = 0;
#endif
        if (ph + 1 < args.ph_hi) {
            if (args.ph_lo < 0) { __syncthreads(); grid.sync(); }
            xcd_barrier(xbar);
#if EXTRA_SYNC > 0
            for (int es = 0; es < EXTRA_SYNC; ++es) xcd_barrier(xbar);
#endif
        }
    }
}

extern "C" void kernel_launch(void* const* d_in, const int* in_sizes, int n_in, void* d_out, int out_size, void* d_ws, size_t ws_size, hipStream_t stream) {
    static int grid = 0;
    if (grid == 0) {
        if (n_in != 20 || out_size != MTOK * DM || ws_size < WS_END) { fprintf(stderr, "kernel_launch: unexpected shapes (n_in %d, out %d, ws %zu)\n", n_in, out_size, ws_size); grid = -1; return; }
        int dev = 0, cus = 0, per_cu = 0;
        hipGetDevice(&dev); hipDeviceGetAttribute(&cus, hipDeviceAttributeMultiprocessorCount, dev);
        if (hipFuncSetAttribute((const void*)trunk_fwd, hipFuncAttributeMaxDynamicSharedMemorySize, LDS_BYTES) != hipSuccess) { fprintf(stderr, "kernel_launch: hipFuncSetAttribute failed\n"); grid = -1; return; }
        hipOccupancyMaxActiveBlocksPerMultiprocessor(&per_cu, (const void*)trunk_fwd, NTHREADS, LDS_BYTES);
        (void)hipGetLastError();
        if (per_cu < 1) { fprintf(stderr, "kernel_launch: occupancy query says %d blocks/CU\n", per_cu); per_cu = 1; }
        grid = cus;
    }
    if (grid < 0) return;
    if (hipMemsetAsync((char*)d_ws + WS_CTL, 0, CTL_BYTES, stream) != hipSuccess) { fprintf(stderr, "kernel_launch: memset of the barrier words failed\n"); return; }
    Args a{};
    for (int i = 0; i < 20; ++i) a.in[i] = (const float*)d_in[i];
    a.out = (float*)d_out; a.ws = (unsigned char*)d_ws;
#if ONE_LAUNCH
    a.ph_lo = 0; a.ph_hi = N_PHASES;
    void* kargs[] = {&a};
    hipError_t e = hipLaunchCooperativeKernel((const void*)trunk_fwd, dim3(grid), dim3(NTHREADS), kargs, LDS_BYTES, stream);
    if (e != hipSuccess) fprintf(stderr, "kernel_launch: cooperative launch failed: %s (grid %d)\n", hipGetErrorString(e), grid);
#else
    for (int ph = 0; ph < N_PHASES; ++ph) { a.ph_lo = ph; a.ph_hi = ph + 1; hipLaunchKernelGGL(trunk_fwd, dim3(grid), dim3(NTHREADS), LDS_BYTES, stream, a); }
#endif
}
```

```cpp
#include <hip/hip_runtime.h>
#include <hip/hip_cooperative_groups.h>
#include <cstdio>
#include <cstdint>
namespace cg = cooperative_groups;
#ifndef REP_PK
#define REP_PK -1
#endif
#ifndef REP_LAYER
#define REP_LAYER -1
#endif
#ifndef EXTRA_SYNC
#define EXTRA_SYNC 0
#endif
#ifndef ONE_LAUNCH
#define ONE_LAUNCH 1
#endif
__device__ __forceinline__ int otid() { int t = (int)threadIdx.x; asm volatile("" : "+v"(t)); return t; }
template <class T> __device__ __forceinline__ T* oq(T* p) { asm volatile("" : "+s"(p)); return p; }
__device__ __forceinline__ int oqi(int v) { asm volatile("" : "+s"(v)); return v; }
namespace pg8 {
#define PG8_LAS __attribute__((address_space(3)))
typedef unsigned short bf16_t;
typedef short bf16x8 __attribute__((ext_vector_type(8)));
typedef float f32x4 __attribute__((ext_vector_type(4)));
typedef unsigned u32x4 __attribute__((ext_vector_type(4)));
constexpr int BM = 256, BK = 64, HALF = 128, HTB = HALF * BK * 2  , STAGE_BYTES = 8 * HTB, NXCD = 8, WGM = 8;

__host__ __device__ __forceinline__ int lds_byte(int r, int c) { const int st = (r >> 4) * 2 + (c >> 5), rr = r & 15, cc = c & 31, ob = rr * 64 + cc * 2; return st * 1024 + (ob ^ (((ob >> 9) & 1) << 5)); }
__host__ __device__ __forceinline__ void stage_rc(int b, int& R, int& C) { const int st = b / 1024, sb = b % 1024, swz = sb ^ (((sb >> 9) & 1) << 5); R = (st >> 1) * 16 + swz / 64; C = (st & 1) * 32 + (swz % 64) / 2; }
__host__ __device__ __forceinline__ int perm32(int rho) { const int n = rho >> 4, i = rho & 15; return 8 * (i >> 2) + 4 * n + (i & 3); }

struct Unit { int pm, pn; };
struct Gemm { const bf16_t* A; const bf16_t* Bt; int M, N, K; };

struct StaticOrder {
    int nM, nN, nwg, G, c;
    __host__ __device__ void init(int M, int N, int G_, int c_) { nM = M / BM; nN = N / BM; nwg = nM * nN; G = G_; c = c_; }
    __host__ __device__ bool next(int i, Unit& u) const {
        const long L = (long)i * G + c; if (L >= nwg) return false;
        int wgid = (int)L; { const int q = nwg / NXCD, r = nwg % NXCD, xcd = wgid % NXCD, off = wgid / NXCD; wgid = (xcd < r ? xcd * (q + 1) : r * (q + 1) + (xcd - r) * q) + off; }
        const int nig = WGM * nN, gid = wgid / nig, fm = gid * WGM, gsz = (nM - fm) < WGM ? (nM - fm) : WGM;
        u.pm = fm + ((wgid % nig) % gsz); u.pn = (wgid % nig) / gsz; return true;
    }
    __device__ __forceinline__ void a_ready(const Unit&) const {}
    __device__ __forceinline__ void done(const Unit&) const {}
};

__device__ __forceinline__ unsigned cvt_pk_bf16(float lo, float hi) { unsigned r; asm volatile("v_cvt_pk_bf16_f32 %0, %1, %2" : "=v"(r) : "v"(lo), "v"(hi)); return r; }
typedef float f32x2 __attribute__((ext_vector_type(2)));
template <class Epi, class Sched, bool ALIGN_EPI = false, bool SP2 = false>
__device__ __forceinline__ void gemm_phase(PG8_LAS unsigned char* lds, const Gemm g, const Sched& S, const Epi& E) {
    const int tid = otid(), wid = __builtin_amdgcn_readfirstlane(tid >> 6), lane = tid & 63, wr = wid >> 2, wc = wid & 3, fr = lane & 15, fq = lane >> 4;
    const int K = g.K, nt = K / BK;
    unsigned voffA[2], voffB[2];
#pragma unroll
    for (int i = 0; i < 2; ++i) { int R, C; stage_rc(tid * 16 + i * 8192, R, C); const int Rb = Epi::PERM ? ((R & ~31) + perm32(R & 31)) : R;
        voffA[i] = (unsigned)(R * K + C) * 2u; voffB[i] = (unsigned)(Rb * K + C) * 2u; }
    const size_t kstep = (size_t)(BK * 2);
    const size_t hstep = (size_t)HALF * K * 2;
    const size_t tstep = 2 * hstep;
    const unsigned ldsw = (unsigned)wid * 1024u;
    const int aoff = lds_byte(wr * 64 + fr, fq * 8), boff = lds_byte(wc * 32 + fr, fq * 8);
#define PG8_SA(b, h) (((b) * 2 + (h)) * HTB)
#define PG8_SB(b, h) ((4 + (b) * 2 + (h)) * HTB)
#define PG8_STAGE(bufoff, gbase, voff) do { _Pragma("unroll") for (int _i = 0; _i < 2; ++_i) \
        __builtin_amdgcn_global_load_lds((const unsigned*)((const char*)(gbase) + (voff)[_i]), (PG8_LAS unsigned*)(lds + (bufoff) + ldsw + _i * 8192), 16, 0, 0); } while (0)
#define PG8_LDA(dst, b, h) do { _Pragma("unroll") for (int m = 0; m < 4; ++m) _Pragma("unroll") for (int k = 0; k < 2; ++k) dst[m][k] = *(const PG8_LAS bf16x8*)(lds + PG8_SA(b, h) + aoff + m * 2048 + k * 1024); } while (0)
#define PG8_LDB(dst, b, h) do { _Pragma("unroll") for (int n = 0; n < 2; ++n) _Pragma("unroll") for (int k = 0; k < 2; ++k) dst[n][k] = *(const PG8_LAS bf16x8*)(lds + PG8_SB(b, h) + boff + n * 2048 + k * 1024); } while (0)
#define PG8_MMA(ai, bj, At, Bt) do { __builtin_amdgcn_s_setprio(1); _Pragma("unroll") for (int m = 0; m < 4; ++m) _Pragma("unroll") for (int n = 0; n < 2; ++n) _Pragma("unroll") for (int k = 0; k < 2; ++k) \
        acc[ai][bj][m][n] = __builtin_amdgcn_mfma_f32_16x16x32_bf16(Bt[n][k], At[m][k], acc[ai][bj][m][n], 0, 0, 0); __builtin_amdgcn_s_setprio(0); } while (0)
#define PG8_WAIT_V(n) asm volatile("s_waitcnt vmcnt(" #n ")" ::: "memory")
#define PG8_WAIT_L(n) asm volatile("s_waitcnt lgkmcnt(" #n ")" ::: "memory")
#define PG8_BAR __builtin_amdgcn_s_barrier()
#define PG8_SCHED __builtin_amdgcn_sched_barrier(0)
    Unit cur, nxt; int ui = 0;
    if (!S.next(0, cur)) return;
    f32x4 acc[2][2][4][2];
#pragma unroll
    for (int a = 0; a < 2; ++a)
#pragma unroll
        for (int b = 0; b < 2; ++b)
#pragma unroll
            for (int m = 0; m < 4; ++m)
#pragma unroll
                for (int n = 0; n < 2; ++n) acc[a][b][m][n] = (f32x4){0.f, 0.f, 0.f, 0.f};
    bf16x8 At[4][2], B0[2][2], B1[2][2];
    const char* cA = (const char*)g.A + (size_t)cur.pm * tstep; const char* cB = (const char*)g.Bt + (size_t)cur.pn * tstep;
    S.a_ready(cur);
    if constexpr (SP2) {
        PG8_STAGE(PG8_SB(0, 0), cB, voffB); PG8_STAGE(PG8_SB(0, 1), cB + hstep, voffB); PG8_STAGE(PG8_SA(0, 0), cA, voffA); PG8_STAGE(PG8_SA(0, 1), cA + hstep, voffA);
        if (wr == 1) PG8_BAR;
        PG8_WAIT_V(2); PG8_BAR;
        PG8_STAGE(PG8_SB(1, 0), cB + kstep, voffB); PG8_STAGE(PG8_SA(1, 0), cA + kstep, voffA); PG8_STAGE(PG8_SB(1, 1), cB + hstep + kstep, voffB);
        PG8_WAIT_V(6); PG8_BAR;
    } else {
        PG8_STAGE(PG8_SB(0, 0), cB, voffB); PG8_STAGE(PG8_SA(0, 0), cA, voffA); PG8_STAGE(PG8_SB(0, 1), cB + hstep, voffB); PG8_STAGE(PG8_SA(0, 1), cA + hstep, voffA);
        if (wr == 1) PG8_BAR;
        PG8_WAIT_V(4); PG8_BAR;
        PG8_STAGE(PG8_SB(1, 0), cB + kstep, voffB); PG8_STAGE(PG8_SA(1, 0), cA + kstep, voffA); PG8_STAGE(PG8_SB(1, 1), cB + hstep + kstep, voffB);
        PG8_WAIT_V(6); PG8_BAR;
    }
    for (;;) {
        const bool has_next = S.next(ui + 1, nxt);
        const char* nA = has_next ? (const char*)g.A + (size_t)nxt.pm * tstep : cA; const char* nB = has_next ? (const char*)g.Bt + (size_t)nxt.pn * tstep : cB;
        for (int t = 0; t < nt; t += 2) {
            const bool last = (t == nt - 2);
            const char* a1 = cA + (size_t)(t + 1) * kstep;
            const char* a2 = last ? nA : cA + (size_t)(t + 2) * kstep; const char* b2 = last ? nB : cB + (size_t)(t + 2) * kstep;
            const char* a3 = a2 + kstep; const char* b3 = b2 + kstep;
            if (last && has_next) S.a_ready(nxt);
            if constexpr (SP2) {
            PG8_LDB(B0, 0, 0); PG8_LDB(B1, 0, 1); PG8_SCHED; PG8_LDA(At, 0, 0); PG8_STAGE(PG8_SA(1, 1), a1 + hstep, voffA);
            PG8_WAIT_V(8); PG8_WAIT_L(0); PG8_BAR; PG8_MMA(0, 0, At, B0); PG8_MMA(0, 1, At, B1); PG8_BAR; PG8_SCHED;
            PG8_LDA(At, 0, 1); PG8_STAGE(PG8_SB(0, 0), b2, voffB); PG8_STAGE(PG8_SB(0, 1), b2 + hstep, voffB); PG8_STAGE(PG8_SA(0, 0), a2, voffA);
            PG8_WAIT_V(8); PG8_WAIT_L(0); PG8_BAR; PG8_MMA(1, 0, At, B0); PG8_MMA(1, 1, At, B1); PG8_BAR; PG8_SCHED;
            PG8_LDB(B0, 1, 0); PG8_LDB(B1, 1, 1); PG8_SCHED; PG8_LDA(At, 1, 0); PG8_STAGE(PG8_SA(0, 1), a2 + hstep, voffA);
            PG8_WAIT_V(8); PG8_WAIT_L(0); PG8_BAR; PG8_MMA(0, 0, At, B0); PG8_MMA(0, 1, At, B1); PG8_BAR; PG8_SCHED;
            PG8_LDA(At, 1, 1); PG8_STAGE(PG8_SB(1, 0), b3, voffB); PG8_STAGE(PG8_SB(1, 1), b3 + hstep, voffB); PG8_STAGE(PG8_SA(1, 0), a3, voffA);
            PG8_WAIT_V(8); PG8_WAIT_L(0); PG8_BAR; PG8_MMA(1, 0, At, B0); PG8_MMA(1, 1, At, B1); PG8_BAR; PG8_SCHED;
            } else {
            PG8_LDB(B0, 0, 0); PG8_SCHED; PG8_LDA(At, 0, 0); PG8_STAGE(PG8_SA(1, 1), a1 + hstep, voffA);
            PG8_WAIT_L(8); PG8_BAR; PG8_WAIT_L(0); PG8_MMA(0, 0, At, B0); PG8_BAR; PG8_SCHED;
            PG8_LDB(B1, 0, 1); PG8_STAGE(PG8_SB(0, 0), b2, voffB);
            PG8_BAR; PG8_WAIT_L(0); PG8_MMA(0, 1, At, B1); PG8_BAR;
            PG8_LDA(At, 0, 1); PG8_STAGE(PG8_SA(0, 0), a2, voffA);
            PG8_BAR; PG8_WAIT_L(0); PG8_MMA(1, 0, At, B0); PG8_BAR; PG8_SCHED;
            PG8_STAGE(PG8_SB(0, 1), b2 + hstep, voffB);
            PG8_WAIT_V(6); PG8_BAR; PG8_MMA(1, 1, At, B1); PG8_BAR;
            PG8_LDB(B0, 1, 0); PG8_SCHED; PG8_LDA(At, 1, 0); PG8_STAGE(PG8_SA(0, 1), a2 + hstep, voffA);
            PG8_WAIT_L(8); PG8_BAR; PG8_WAIT_L(0); PG8_MMA(0, 0, At, B0); PG8_BAR; PG8_SCHED;
            PG8_LDB(B1, 1, 1); PG8_STAGE(PG8_SB(1, 0), b3, voffB);
            PG8_BAR; PG8_WAIT_L(0); PG8_MMA(0, 1, At, B1); PG8_BAR;
            PG8_LDA(At, 1, 1); PG8_STAGE(PG8_SA(1, 0), a3, voffA);
            PG8_BAR; PG8_WAIT_L(0); PG8_MMA(1, 0, At, B0); PG8_BAR; PG8_SCHED;
            PG8_STAGE(PG8_SB(1, 1), b3 + hstep, voffB);
            PG8_WAIT_V(6); PG8_BAR; PG8_MMA(1, 1, At, B1); PG8_BAR;
            }
        }
        if constexpr (ALIGN_EPI) { if (wr == 0) PG8_BAR; }
        if constexpr (!Epi::AFTER_DRAIN) { E(acc, cur, wr, wc, fr, fq); S.done(cur); }
        if (!has_next) break;
#pragma unroll
        for (int a = 0; a < 2; ++a)
#pragma unroll
            for (int b = 0; b < 2; ++b)
#pragma unroll
                for (int m = 0; m < 4; ++m)
#pragma unroll
                    for (int n = 0; n < 2; ++n) acc[a][b][m][n] = (f32x4){0.f, 0.f, 0.f, 0.f};
        cur = nxt; cA = nA; cB = nB; ++ui;
        if constexpr (ALIGN_EPI) { if (wr == 1) PG8_BAR; }
    }
    PG8_WAIT_V(0);
    if constexpr (!ALIGN_EPI) { if (wr == 0) PG8_BAR; }
    PG8_BAR;
    if constexpr (Epi::AFTER_DRAIN) { E.fused(acc, cur, wr, wc, fr, fq, lds, wid, lane); S.done(cur); }
#undef PG8_SA
#undef PG8_SB
#undef PG8_STAGE
#undef PG8_LDA
#undef PG8_LDB
#undef PG8_MMA
#undef PG8_WAIT_V
#undef PG8_WAIT_L
#undef PG8_BAR
#undef PG8_SCHED
}
}
namespace pg8 {
typedef unsigned u32x2 __attribute__((ext_vector_type(2)));
__device__ __forceinline__ float bf2f(unsigned short h) { return __uint_as_float(((unsigned)h) << 16); }
__device__ __forceinline__ unsigned short f2bf_rne(float f) { unsigned u = __float_as_uint(f); return (unsigned short)((u + 0x7fffu + ((u >> 16) & 1u)) >> 16); }
__device__ __forceinline__ float sigmoidf_(float v) { return 1.0f / (1.0f + __expf(-v)); }
__device__ __forceinline__ float logsigf_(float z) { return fminf(z, 0.f) - log1pf(__expf(-fabsf(z))); }
__device__ __forceinline__ u32x4 pack8(const f32x4 a, const f32x4 b) { u32x4 w; w.x = cvt_pk_bf16(a[0], a[1]); w.y = cvt_pk_bf16(a[2], a[3]); w.z = cvt_pk_bf16(b[0], b[1]); w.w = cvt_pk_bf16(b[2], b[3]); return w; }
__device__ __forceinline__ void split8(const f32x4 a, const f32x4 b, u32x4& hi, u32x4& lo) {
    hi = pack8(a, b);
    f32x4 ra, rb;
    ra[0] = a[0] - __uint_as_float(hi.x << 16); ra[1] = a[1] - __uint_as_float(hi.x & 0xffff0000u);
    ra[2] = a[2] - __uint_as_float(hi.y << 16); ra[3] = a[3] - __uint_as_float(hi.y & 0xffff0000u);
    rb[0] = b[0] - __uint_as_float(hi.z << 16); rb[1] = b[1] - __uint_as_float(hi.z & 0xffff0000u);
    rb[2] = b[2] - __uint_as_float(hi.w << 16); rb[3] = b[3] - __uint_as_float(hi.w & 0xffff0000u);
    lo = pack8(ra, rb);
}
#define PG8_FOR8(...) \
  _Pragma("unroll") for (int ai = 0; ai < 2; ++ai) _Pragma("unroll") for (int m = 0; m < 4; ++m) { const int lrow = ai * HALF + wr * 64 + m * 16 + fr; \
    _Pragma("unroll") for (int bj = 0; bj < 2; ++bj) { const int lcol = bj * HALF + wc * 32 + 8 * fq; f32x4 v0 = acc[ai][bj][m][0], v1 = acc[ai][bj][m][1]; __VA_ARGS__ } asm volatile("" ::: "memory"); }

struct EpiQK {
    static constexpr bool PERM = true, AFTER_DRAIN = false;
    bf16_t* QK; float* LF; const float* bf; float qscale;
    __device__ __forceinline__ void operator()(const f32x4 (&acc)[2][2][4][2], const Unit& u, int wr, int wc, int fr, int fq) const {
        const int pn = u.pn;
        if (pn < 8) { const float sc = pn < 4 ? qscale : 1.f;
            PG8_FOR8({ const unsigned row = (unsigned)u.pm * BM + lrow; *(u32x4*)(QK + row * 2048 + pn * 256 + lcol) = pack8(v0 * sc, v1 * sc); })
        } else {
            PG8_FOR8({ if (lcol < 16) { const unsigned row = (unsigned)u.pm * BM + lrow; f32x4 o0, o1;
                _Pragma("unroll") for (int i = 0; i < 4; ++i) { o0[i] = logsigf_(v0[i] + bf[lcol + i]); o1[i] = logsigf_(v1[i] + bf[lcol + 4 + i]); }
                *(f32x4*)(LF + row * 16 + lcol) = o0; *(f32x4*)(LF + row * 16 + lcol + 4) = o1; } })
        }
    }
};
struct EpiVt {
    static constexpr bool PERM = false, AFTER_DRAIN = false;
    bf16_t* VT; int ld; int vf_rows;
    __device__ __forceinline__ void operator()(const f32x4 (&acc)[2][2][4][2], const Unit& u, int wr, int wc, int fr, int fq) const {
#pragma unroll
        for (int ai = 0; ai < 2; ++ai)
#pragma unroll
            for (int m = 0; m < 4; ++m) { const unsigned row = (unsigned)u.pm * BM + ai * HALF + wr * 64 + m * 16 + fr;
#pragma unroll
                for (int bj = 0; bj < 2; ++bj)
#pragma unroll
                    for (int n = 0; n < 2; ++n) { const unsigned tok0 = u.pn * BM + bj * HALF + wc * 32 + 16 * n; const f32x4 v = acc[ai][bj][m][n];
                        u32x2 w; w.x = cvt_pk_bf16(v[0], v[1]); w.y = cvt_pk_bf16(v[2], v[3]);
                        if ((int)row < vf_rows) { const unsigned g = row >> 6, d = row & 63, db = d >> 5, r = d & 31, b = tok0 >> 13, s0 = tok0 & 8191, blk = s0 >> 6, ks = (s0 >> 4) & 3;
                            *(u32x2*)(VT + (((((b * 4 + g) * 128 + blk) * 2 + db) * 4 + ks) * 512 + ((fq & 1) * 32 + r) * 8 + 4 * (fq >> 1))) = w; }
                        else *(u32x2*)(VT + row * ld + tok0 + 8 * (fq & 1) + 4 * (fq >> 1)) = w; } }
    }
};
struct EpiF32 {
    static constexpr bool PERM = true, AFTER_DRAIN = false;
    float* Y; int ld;
    __device__ __forceinline__ void operator()(const f32x4 (&acc)[2][2][4][2], const Unit& u, int wr, int wc, int fr, int fq) const {
        PG8_FOR8({ float* p = Y + (unsigned)(((unsigned)u.pm * BM + lrow) * ld + u.pn * BM + lcol); *(f32x4*)p = v0; *(f32x4*)(p + 4) = v1; })
    }
};
template <int ACT  > struct EpiAct {
    static constexpr bool PERM = true, AFTER_DRAIN = false;
    bf16_t* O; int ld;
    __device__ __forceinline__ void operator()(const f32x4 (&acc)[2][2][4][2], const Unit& u, int wr, int wc, int fr, int fq) const {
        PG8_FOR8({ if (ACT == 1) { _Pragma("unroll") for (int i = 0; i < 4; ++i) { const float a = fmaxf(v0[i], 0.f), b = fmaxf(v1[i], 0.f); v0[i] = a * a; v1[i] = b * b; } }
            *(u32x4*)(O + (unsigned)(((unsigned)u.pm * BM + lrow) * ld + u.pn * BM + lcol)) = pack8(v0, v1); })
    }
};
struct EpiGate {
    static constexpr bool PERM = true, AFTER_DRAIN = false;
    float* X; const bf16_t* PW;
    __device__ __forceinline__ void operator()(const f32x4 (&acc)[2][2][4][2], const Unit& u, int wr, int wc, int fr, int fq) const {
        PG8_FOR8({ const unsigned off = ((unsigned)u.pm * BM + lrow) * 1024 + u.pn * BM + lcol; float* xp = X + off;
            const u32x4 pw = *(const u32x4*)(PW + off); f32x4 x0 = *(const f32x4*)xp, x1 = *(const f32x4*)(xp + 4);
            x0[0] += sigmoidf_(v0[0]) * __uint_as_float(pw.x << 16); x0[1] += sigmoidf_(v0[1]) * __uint_as_float(pw.x & 0xffff0000u);
            x0[2] += sigmoidf_(v0[2]) * __uint_as_float(pw.y << 16); x0[3] += sigmoidf_(v0[3]) * __uint_as_float(pw.y & 0xffff0000u);
            x1[0] += sigmoidf_(v1[0]) * __uint_as_float(pw.z << 16); x1[1] += sigmoidf_(v1[1]) * __uint_as_float(pw.z & 0xffff0000u);
            x1[2] += sigmoidf_(v1[2]) * __uint_as_float(pw.w << 16); x1[3] += sigmoidf_(v1[3]) * __uint_as_float(pw.w & 0xffff0000u);
            *(f32x4*)xp = x0; *(f32x4*)(xp + 4) = x1; })
    }
};
struct EpiNsaA {
    static constexpr bool PERM = true, AFTER_DRAIN = false;
    bf16_t *QH, *QL, *KH, *KL; float qscale;
    __device__ __forceinline__ void operator()(const f32x4 (&acc)[2][2][4][2], const Unit& u, int wr, int wc, int fr, int fq) const {
        const int pn = u.pn;
        PG8_FOR8({ const unsigned row = (unsigned)u.pm * BM + lrow; u32x4 h, l;
            if (pn < 4) { split8(v0 * qscale, v1 * qscale, h, l); const unsigned off = row * 1024 + pn * 256 + lcol; *(u32x4*)(QH + off) = h; *(u32x4*)(QL + off) = l; }
            else { split8(v0, v1, h, l); const unsigned b = row >> 13, s = row & 8191; const int g = lcol >> 6, d = lcol & 63;
                const unsigned off = ((b * 4 + g) * 8192 + s) * 64 + d; *(u32x4*)(KH + off) = h; *(u32x4*)(KL + off) = l; } })
    }
};
struct EpiNsaB {
    static constexpr bool PERM = true, AFTER_DRAIN = false;
    bf16_t *VC, *KS, *KW; float* GATE;
    __device__ __forceinline__ void operator()(const f32x4 (&acc)[2][2][4][2], const Unit& u, int wr, int wc, int fr, int fq) const {
        const int pn = u.pn;
        PG8_FOR8({ const unsigned row = (unsigned)u.pm * BM + lrow;
            if (pn == 0) { const unsigned b = row >> 13, s = row & 8191; const int g = lcol >> 6, d = lcol & 63; *(u32x4*)(VC + ((b * 4 + g) * 8192 + s) * 64 + d) = pack8(v0, v1); }
            else if (pn == 1) { const unsigned b = row >> 13, s = row & 8191; const unsigned g = lcol >> 6, d = lcol & 63;
                *(u32x4*)(KS + (((((b * 4 + g) * 128 + (s >> 6)) * 2 + ((s >> 5) & 1)) * 4 + (d >> 4)) * 512 + ((((d >> 3) & 1) * 32 + (s & 31)) * 8))) = pack8(v0, v1); }
            else if (pn == 2) { *(u32x4*)(KW + row * 256 + lcol) = pack8(v0, v1); }
            else if (lcol < 48) { f32x4 o0, o1; _Pragma("unroll") for (int i = 0; i < 4; ++i) { o0[i] = sigmoidf_(v0[i]); o1[i] = sigmoidf_(v1[i]); }
                *(f32x4*)(GATE + row * 48 + lcol) = o0; *(f32x4*)(GATE + row * 48 + lcol + 4) = o1; } })
    }
};
}
namespace fa {
using pg8::bf16_t; using pg8::bf16x8; using pg8::f32x4; using pg8::u32x4; using pg8::u32x2;
typedef float f32x16 __attribute__((ext_vector_type(16)));
#define LAS __attribute__((address_space(3)))
constexpr int ROWB = 144;
constexpr int L_K0 = 0, L_K1 = 9216, L_V0 = 18432, L_V1 = 36864, L_B0 = 55296, L_B1 = 55552, L_TAB = 55808, L_END = 56320;
constexpr float NEGV = -1e30f;
__device__ __forceinline__ int crow(int r, int hi) { return (r & 3) + 8 * (r >> 2) + 4 * hi; }
__device__ __forceinline__ float ex2(float v) { return __builtin_amdgcn_exp2f(v); }
__device__ __forceinline__ bf16x8 packp(const f32x16& p, int s) {
    u32x4 w; w.x = pg8::cvt_pk_bf16(p[8 * s + 0], p[8 * s + 1]); w.y = pg8::cvt_pk_bf16(p[8 * s + 2], p[8 * s + 3]);
    w.z = pg8::cvt_pk_bf16(p[8 * s + 4], p[8 * s + 5]); w.w = pg8::cvt_pk_bf16(p[8 * s + 6], p[8 * s + 7]); return __builtin_bit_cast(bf16x8, w);
}
struct FlashArgs {
    const bf16_t* Q; int ldq;
    const bf16_t* K; int ldk;
    const bf16_t* Vt; int ldv;
    int q0, t_lo, t_hi, pa, pb, window;
    const float* kbias;
    const float* tab;
    bf16_t* O; int ldo;
    const float* gate; int ldg;
};
__device__ __forceinline__ float xhalf_max(float m) { auto rr = __builtin_amdgcn_permlane32_swap(__float_as_uint(m), __float_as_uint(m), false, false); return fmaxf(__uint_as_float(rr[0]), __uint_as_float(rr[1])); }
#define FA_GK(t) do { kreg = *(const u32x4*)(a.K + (size_t)(64 * (t) + srow) * a.ldk + sch * 8); } while (0)
#define FA_GV(t) do { _Pragma("unroll") for (int i_ = 0; i_ < NVB; ++i_) vreg[i_] = *(const u32x4*)(a.Vt + (size_t)(srow + 64 * i_) * a.ldv + 64 * (t) + sch * 8); \
    if (BIAS == 1) { if (tid < 16) breg = *(const f32x4*)(a.kbias + 64 * (t) + 4 * tid); } } while (0)
#define FA_SK(b_) do { *(LAS u32x4*)(lds + ((b_) ? L_K1 : L_K0) + srow * ROWB + sch * 16) = kreg; } while (0)
#define FA_SV(b_) do { _Pragma("unroll") for (int i_ = 0; i_ < NVB; ++i_) *(LAS u32x4*)(lds + ((b_) ? L_V1 : L_V0) + (srow + 64 * i_) * ROWB + sch * 16) = vreg[i_]; \
    if (BIAS == 1) { if (tid < 16) *(LAS f32x4*)(lds + ((b_) ? L_B1 : L_B0) + 16 * tid) = breg; } } while (0)
template <int DV, int BIAS, bool MAIN, int DIR>
__device__ __forceinline__ void fa_iter(LAS unsigned char* lds, const FlashArgs& a, const int t, const int tid, const int srow, const int sch, const int r32, const int hi, const int qw0, const int qpos,
                                        const bf16x8 (&qf)[4], f32x16 (&o)[DV / 32], f32x16& c0, f32x16& c1, float& m_run, float& l_run, bool& cur_needed, u32x4& kreg, u32x4 (&vreg)[DV / 64], f32x4& breg) {
    constexpr int NVB = DV / 64, NDB = DV / 32;
    const LAS float* tabL = (const LAS float*)(lds + L_TAB);
    const int t1 = t + DIR, t2 = t + 2 * DIR;
    const bool hk = MAIN || (t2 >= a.t_lo && t2 <= a.t_hi), hv = MAIN || (t1 >= a.t_lo && t1 <= a.t_hi);
    if (hk) FA_GK(t2);
    if (hv) FA_GV(t1);
    bool nn = MAIN;
    if (!MAIN) { if (hv) { const int minp = a.pa * (64 * t1) + a.pb, maxp = minp + a.pa * 63; nn = (minp <= qw0 + 31) && (maxp > qw0 - a.window); } }
    const bool cn = MAIN || cur_needed;
    bool skip_b2 = false;
    if (cn) {
        if (BIAS == 1) {
            const LAS unsigned char* bb = lds + ((t & 1) ? L_B1 : L_B0);
#pragma unroll
            for (int g = 0; g < 4; ++g) { const f32x4 b0 = *(const LAS f32x4*)(bb + (8 * g + 4 * hi) * 4), b1 = *(const LAS f32x4*)(bb + (32 + 8 * g + 4 * hi) * 4);
#pragma unroll
                for (int i = 0; i < 4; ++i) { c0[4 * g + i] += b0[i]; c1[4 * g + i] += b1[i]; } }
        }
        if (!MAIN) {
            const int minpos = a.pa * (64 * t) + a.pb, maxpos = minpos + a.pa * 63;
            const bool full = (maxpos <= qw0) && (minpos > qw0 + 31 - a.window);
            const bool nearb = (BIAS == 2) && (maxpos >= qw0 - 127);
            if (!full || nearb) {
#pragma unroll
                for (int r = 0; r < 16; ++r) { const int kv = crow(r, hi); const int d0_ = qpos - (minpos + a.pa * kv), d1_ = d0_ - 32 * a.pa;
                    if (BIAS == 2) { c0[r] += tabL[min(max(d0_, 0), 127)]; c1[r] += tabL[min(max(d1_, 0), 127)]; }
                    if (d0_ < 0 || d0_ >= a.window) c0[r] = NEGV;
                    if (d1_ < 0 || d1_ >= a.window) c1[r] = NEGV; }
            }
        }
        float mx = fmaxf(c0[0], c1[0]);
#pragma unroll
        for (int r = 1; r < 16; ++r) mx = fmaxf(mx, fmaxf(c0[r], c1[r]));
        mx = xhalf_max(mx);
        const bool real = m_run > -1e29f, seen = mx > -1e29f;
        if (DIR < 0) skip_b2 = !__any(!real || mx > -150.f);
        if (__any(real ? (mx > 8.f) : seen)) {
            const float dl = real ? fmaxf(mx, 0.f) : (seen ? mx : 0.f);
            const float al = real ? ex2(-dl) : 0.f;
            m_run = real ? (m_run + dl) : (seen ? mx : m_run);
            l_run *= al;
#pragma unroll
            for (int r = 0; r < 16; ++r) { c0[r] -= dl; c1[r] -= dl; }
#pragma unroll
            for (int i = 0; i < NDB; ++i)
#pragma unroll
                for (int r = 0; r < 16; ++r) o[i][r] *= al;
        }
    }
    f32x16 n0, n1;
    if (nn) {
        const float refn = (m_run > -1e29f) ? m_run : 0.f;
        const LAS unsigned char* kb = lds + (((t + 1) & 1) ? L_K1 : L_K0);
#pragma unroll
        for (int r = 0; r < 16; ++r) { n0[r] = -refn; n1[r] = -refn; }
        bf16x8 kf0[4], kf1[4];
#pragma unroll
        for (int d0 = 0; d0 < 4; ++d0) { kf0[d0] = *(const LAS bf16x8*)(kb + r32 * ROWB + (2 * d0 + hi) * 16); kf1[d0] = *(const LAS bf16x8*)(kb + (32 + r32) * ROWB + (2 * d0 + hi) * 16); }
        __builtin_amdgcn_sched_barrier(0);
#pragma unroll
        for (int d0 = 0; d0 < 4; ++d0) {
            n0 = __builtin_amdgcn_mfma_f32_32x32x16_bf16(kf0[d0], qf[d0], n0, 0, 0, 0);
            n1 = __builtin_amdgcn_mfma_f32_32x32x16_bf16(kf1[d0], qf[d0], n1, 0, 0, 0);
        }
    }
    if (cn && !skip_b2) {
        const LAS unsigned char* vb = lds + ((t & 1) ? L_V1 : L_V0);
        float rs = 0.f;
#pragma unroll
        for (int r = 0; r < 16; ++r) { c0[r] = ex2(c0[r]); c1[r] = ex2(c1[r]); rs += c0[r] + c1[r]; }
        l_run += rs;
        bf16x8 pf[4]; pf[0] = packp(c0, 0); pf[1] = packp(c0, 1); pf[2] = packp(c1, 0); pf[3] = packp(c1, 1);
#pragma unroll
        for (int dh = 0; dh < NDB / 2; ++dh) {
            bf16x8 vf[8];
#pragma unroll
            for (int i = 0; i < 8; ++i) vf[i] = *(const LAS bf16x8*)(vb + (32 * (2 * dh + (i >> 2)) + r32) * ROWB + (2 * (i & 3) + hi) * 16);
            __builtin_amdgcn_sched_barrier(0);
    #pragma unroll
            for (int i = 0; i < 8; ++i) o[2 * dh + (i >> 2)] = __builtin_amdgcn_mfma_f32_32x32x16_bf16(vf[i], pf[i & 3], o[2 * dh + (i >> 2)], 0, 0, 0);
                __builtin_amdgcn_sched_barrier(0);
        }
    }
    if (hk) FA_SK(t & 1);
    if (hv) FA_SV((t + 1) & 1);
    __syncthreads();
    if (nn) { c0 = n0; c1 = n1; }
    cur_needed = nn;
}
template <int DV, int BIAS, int OUT, int DIR = 1>
__device__ __forceinline__ void flash_unit_reg(LAS unsigned char* lds, const FlashArgs& a) {
    const int tid = otid(), lane = tid & 63, wid = __builtin_amdgcn_readfirstlane(tid >> 6), r32 = lane & 31, hi = lane >> 5;
    const int srow = tid >> 3, sch = tid & 7;
    constexpr int NVB = DV / 64, NDB = DV / 32;
    u32x4 kreg, vreg[NVB]; f32x4 breg = (f32x4){0.f, 0.f, 0.f, 0.f};
    const int tfirst = (DIR > 0) ? a.t_lo : a.t_hi;
    FA_GK(tfirst);
    if (BIAS == 2) { if (tid < 128) *(LAS float*)(lds + L_TAB + 4 * tid) = a.tab[tid]; }
    bf16x8 qf[4];
#pragma unroll
    for (int d0 = 0; d0 < 4; ++d0) qf[d0] = *(const bf16x8*)(a.Q + (size_t)(32 * wid + r32) * a.ldq + 16 * d0 + 8 * hi);
    FA_SK(tfirst & 1);
    __syncthreads();
    const int qw0 = a.q0 + 32 * wid, qpos = qw0 + r32;
    float m_run = NEGV, l_run = 0.f;
    f32x16 o[NDB], c0, c1;
#pragma unroll
    for (int i = 0; i < NDB; ++i)
#pragma unroll
        for (int r = 0; r < 16; ++r) o[i][r] = 0.f;
#pragma unroll
    for (int r = 0; r < 16; ++r) { c0[r] = 0.f; c1[r] = 0.f; }
    bool cur_needed = false;
    int tm0, tm1;
    { const int lim = (BIAS == 2) ? (a.q0 - 128) : a.q0;
      const int num = lim - a.pb - 63 * a.pa;
      int tl = (num >= 0) ? (num / (64 * a.pa)) - 1 : -1;
      tl = min(tl, a.t_hi - 2);
      int tf = a.t_lo;
      if (a.window < (1 << 29)) { const int x = a.q0 + 255 - a.window - a.pb; if (x >= 0) tf = max(tf, x / (64 * a.pa) + 1); }
      tm0 = tf + 1; tm1 = tl + 1;
      if (tm1 < tm0) { tm0 = a.t_hi + 1; tm1 = tm0; } }
    if (DIR > 0) {
        int t = a.t_lo - 1;
        for (; t < tm0 && t <= a.t_hi; ++t) fa_iter<DV, BIAS, false, 1>(lds, a, t, tid, srow, sch, r32, hi, qw0, qpos, qf, o, c0, c1, m_run, l_run, cur_needed, kreg, vreg, breg);
        for (; t < tm1; ++t) fa_iter<DV, BIAS, true, 1>(lds, a, t, tid, srow, sch, r32, hi, qw0, qpos, qf, o, c0, c1, m_run, l_run, cur_needed, kreg, vreg, breg);
        for (; t <= a.t_hi; ++t) fa_iter<DV, BIAS, false, 1>(lds, a, t, tid, srow, sch, r32, hi, qw0, qpos, qf, o, c0, c1, m_run, l_run, cur_needed, kreg, vreg, breg);
    } else {
        const int tfull = (a.q0 - a.pb - 63 * a.pa >= 0) ? (a.q0 - a.pb - 63 * a.pa) / (64 * a.pa) : -1;
        int t = a.t_hi + 1;
        for (; t > tfull && t >= a.t_lo; --t) fa_iter<DV, BIAS, false, -1>(lds, a, t, tid, srow, sch, r32, hi, qw0, qpos, qf, o, c0, c1, m_run, l_run, cur_needed, kreg, vreg, breg);
        for (; t >= a.t_lo + 2; --t) fa_iter<DV, BIAS, true, -1>(lds, a, t, tid, srow, sch, r32, hi, qw0, qpos, qf, o, c0, c1, m_run, l_run, cur_needed, kreg, vreg, breg);
        for (; t >= a.t_lo; --t) fa_iter<DV, BIAS, false, -1>(lds, a, t, tid, srow, sch, r32, hi, qw0, qpos, qf, o, c0, c1, m_run, l_run, cur_needed, kreg, vreg, breg);
    }
    const float l_tot = l_run + __shfl_xor(l_run, 32);
    float inv = (m_run > -1e29f) ? 1.0f / l_tot : 0.f;
    if (OUT == 1) inv *= a.gate[(size_t)(32 * wid + r32) * a.ldg];
    bf16_t* orow = a.O + (size_t)(32 * wid + r32) * a.ldo;
#pragma unroll
    for (int db = 0; db < NDB; ++db)
#pragma unroll
        for (int g = 0; g < 4; ++g) { u32x2 w; w.x = pg8::cvt_pk_bf16(o[db][4 * g] * inv, o[db][4 * g + 1] * inv); w.y = pg8::cvt_pk_bf16(o[db][4 * g + 2] * inv, o[db][4 * g + 3] * inv);
            *(u32x2*)(orow + 32 * db + 8 * g + 4 * hi) = w; }
}
#undef FA_GK
#undef FA_GV
#undef FA_SK
#undef FA_SV
__device__ __forceinline__ void glds16(const void* gsrc, unsigned lds_dst) { unsigned keep;
    asm volatile("s_mov_b32 %0, m0\n\ts_mov_b32 m0, %2\n\ts_nop 0\n\tglobal_load_lds_dwordx4 %1, off\n\ts_mov_b32 m0, %0" : "=&s"(keep) : "v"(gsrc), "s"(lds_dst) : "memory"); }
__device__ __forceinline__ void glds4(const void* gsrc, unsigned lds_dst) { unsigned keep;
    asm volatile("s_mov_b32 %0, m0\n\ts_mov_b32 m0, %2\n\ts_nop 0\n\tglobal_load_lds_dword %1, off\n\ts_mov_b32 m0, %0" : "=&s"(keep) : "v"(gsrc), "s"(lds_dst) : "memory"); }
constexpr int D_K = 0, D_V = 32768, D_B = 32768 + 4 * 16384, D_TAB = D_B + 4 * 256, D_END = D_TAB + 512;
template <int DV, int BIAS, int OUT>
__device__ __forceinline__ void flash_unit(LAS unsigned char* lds, const FlashArgs& a) {
    const int tid = otid(), lane = tid & 63, wid = __builtin_amdgcn_readfirstlane(tid >> 6), r32 = lane & 31, hi = lane >> 5;
    constexpr int NVB = DV / 64, NDB = DV / 32, VSLOT = DV * 128, NP = 1 + NVB + (BIAS == 1 ? 1 : 0);
    static_assert(NP == 2 || NP == 3, "counted waits are written for 2 or 3 DMA pieces per wave and tile");
    const int drow = lane >> 3, dchunk = (lane & 7) ^ (((8 * wid + drow) >> 1) & 7);
    const bf16_t* ksrc = a.K + (size_t)(8 * wid + drow) * a.ldk + dchunk * 8;
    const bf16_t* vsrc = a.Vt + (size_t)(8 * wid + drow) * a.ldv + dchunk * 8;
    const unsigned lds0 = (unsigned)(__UINTPTR_TYPE__)lds;
#define FA_ISSUE(t_, s_) do { const unsigned so_ = (unsigned)__builtin_amdgcn_readfirstlane(s_); \
        glds16(ksrc + (size_t)(64 * (t_)) * a.ldk, (unsigned)__builtin_amdgcn_readfirstlane((int)(lds0 + D_K + so_ * 8192 + wid * 1024))); \
        _Pragma("unroll") for (int i_ = 0; i_ < NVB; ++i_) glds16(vsrc + (size_t)(64 * i_) * a.ldv + 64 * (t_), (unsigned)__builtin_amdgcn_readfirstlane((int)(lds0 + D_V + so_ * VSLOT + (wid + 8 * i_) * 1024))); \
        if (BIAS == 1) glds4(a.kbias + 64 * (t_) + lane, (unsigned)__builtin_amdgcn_readfirstlane((int)(lds0 + D_B + so_ * 256))); } while (0)
    int s_cur = 0;
    FA_ISSUE(a.t_lo, 0);
    if (a.t_lo + 1 <= a.t_hi) FA_ISSUE(a.t_lo + 1, 1);
    if (a.t_lo + 2 <= a.t_hi) FA_ISSUE(a.t_lo + 2, 2);
    if (BIAS == 2) { if (tid < 128) *(LAS float*)(lds + D_TAB + 4 * tid) = a.tab[tid]; }
    bf16x8 qf[4];
#pragma unroll
    for (int d0 = 0; d0 < 4; ++d0) qf[d0] = *(const bf16x8*)(a.Q + (size_t)(32 * wid + r32) * a.ldq + 16 * d0 + 8 * hi);
    asm volatile("" : "+v"(qf[0]), "+v"(qf[1]), "+v"(qf[2]), "+v"(qf[3]));
    asm volatile("s_waitcnt vmcnt(0) lgkmcnt(0)" ::: "memory");
    __builtin_amdgcn_s_barrier();
    asm volatile("" ::: "memory");
    const int qw0 = a.q0 + 32 * wid, qpos = qw0 + r32;
    float m_run = NEGV, l_run = 0.f;
    f32x16 o[NDB];
#pragma unroll
    for (int i = 0; i < NDB; ++i)
#pragma unroll
        for (int r = 0; r < 16; ++r) o[i][r] = 0.f;
    const LAS float* tabL = (const LAS float*)(lds + D_TAB);
    const int sw0 = ((r32 >> 1) & 7), sw1 = (((32 + r32) >> 1) & 7);
    for (int t = a.t_lo; t <= a.t_hi; ++t) {
        if (t + 2 <= a.t_hi) { if (NP == 3) asm volatile("s_waitcnt vmcnt(3)" ::: "memory"); else asm volatile("s_waitcnt vmcnt(2)" ::: "memory"); }
        else asm volatile("s_waitcnt vmcnt(0)" ::: "memory");
        asm volatile("s_waitcnt lgkmcnt(0)" ::: "memory");
        __builtin_amdgcn_s_barrier();
        asm volatile("" ::: "memory");
        const int s_nn = (s_cur + 3) & 3;
        if (t + 3 <= a.t_hi) FA_ISSUE(t + 3, s_nn);
        const int minpos = a.pa * (64 * t) + a.pb, maxpos = minpos + a.pa * 63;
        const bool needed = (minpos <= qw0 + 31) && (maxpos > qw0 - a.window);
        if (needed) {
            const LAS unsigned char* kb = lds + D_K + s_cur * 8192; const LAS unsigned char* vb = lds + D_V + s_cur * VSLOT;
            f32x16 p0, p1;
#pragma unroll
            for (int r = 0; r < 16; ++r) { p0[r] = 0.f; p1[r] = 0.f; }
#pragma unroll
            for (int d0 = 0; d0 < 4; ++d0) {
                const bf16x8 k0 = *(const LAS bf16x8*)(kb + r32 * 128 + (((2 * d0 + hi) ^ sw0) * 16));
                const bf16x8 k1 = *(const LAS bf16x8*)(kb + (32 + r32) * 128 + (((2 * d0 + hi) ^ sw1) * 16));
                p0 = __builtin_amdgcn_mfma_f32_32x32x16_bf16(k0, qf[d0], p0, 0, 0, 0);
                p1 = __builtin_amdgcn_mfma_f32_32x32x16_bf16(k1, qf[d0], p1, 0, 0, 0);
            }
            if (BIAS == 1) {
                const LAS unsigned char* bb = lds + D_B + s_cur * 256;
#pragma unroll
                for (int g = 0; g < 4; ++g) { const f32x4 b0 = *(const LAS f32x4*)(bb + (8 * g + 4 * hi) * 4), b1 = *(const LAS f32x4*)(bb + (32 + 8 * g + 4 * hi) * 4);
#pragma unroll
                    for (int i = 0; i < 4; ++i) { p0[4 * g + i] += b0[i]; p1[4 * g + i] += b1[i]; } }
            }
            const bool full = (maxpos <= qw0) && (minpos > qw0 + 31 - a.window);
            const bool nearb = (BIAS == 2) && (maxpos >= qw0 - 127);
            if (!full || nearb) {
#pragma unroll
                for (int r = 0; r < 16; ++r) { const int kv = crow(r, hi); const int d0_ = qpos - (minpos + a.pa * kv), d1_ = d0_ - 32 * a.pa;
                    if (BIAS == 2) { p0[r] += tabL[min(max(d0_, 0), 127)]; p1[r] += tabL[min(max(d1_, 0), 127)]; }
                    if (d0_ < 0 || d0_ >= a.window) p0[r] = NEGV;
                    if (d1_ < 0 || d1_ >= a.window) p1[r] = NEGV; }
            }
            float mx = fmaxf(p0[0], p1[0]);
#pragma unroll
            for (int r = 1; r < 16; ++r) mx = fmaxf(mx, fmaxf(p0[r], p1[r]));
            mx = xhalf_max(mx);
            if (__any(mx > m_run + 8.f)) {
                const float mn = fmaxf(m_run, mx), al = ex2(m_run - mn); l_run *= al; m_run = mn;
#pragma unroll
                for (int i = 0; i < NDB; ++i)
#pragma unroll
                    for (int r = 0; r < 16; ++r) o[i][r] *= al;
            }
            float rs = 0.f;
#pragma unroll
            for (int r = 0; r < 16; ++r) { p0[r] = ex2(p0[r] - m_run); p1[r] = ex2(p1[r] - m_run); rs += p0[r] + p1[r]; }
            l_run += rs;
            bf16x8 pf[4]; pf[0] = packp(p0, 0); pf[1] = packp(p0, 1); pf[2] = packp(p1, 0); pf[3] = packp(p1, 1);
#pragma unroll
            for (int db = 0; db < NDB; ++db)
#pragma unroll
                for (int ks = 0; ks < 4; ++ks) { const bf16x8 vf = *(const LAS bf16x8*)(vb + (32 * db + r32) * 128 + (((2 * ks + hi) ^ sw0) * 16));
                    o[db] = __builtin_amdgcn_mfma_f32_32x32x16_bf16(vf, pf[ks], o[db], 0, 0, 0); }
        }
        s_cur = (s_cur + 1) & 3;
    }
    const float l_tot = l_run + __shfl_xor(l_run, 32);
    float inv = (m_run > -1e29f) ? 1.0f / l_tot : 0.f;
    if (OUT == 1) inv *= a.gate[(size_t)(32 * wid + r32) * a.ldg];
    bf16_t* orow = a.O + (size_t)(32 * wid + r32) * a.ldo;
#pragma unroll
    for (int db = 0; db < NDB; ++db)
#pragma unroll
        for (int g = 0; g < 4; ++g) { u32x2 w; w.x = pg8::cvt_pk_bf16(o[db][4 * g] * inv, o[db][4 * g + 1] * inv); w.y = pg8::cvt_pk_bf16(o[db][4 * g + 2] * inv, o[db][4 * g + 3] * inv);
            *(u32x2*)(orow + 32 * db + 8 * g + 4 * hi) = w; }
    asm volatile("s_waitcnt lgkmcnt(0)" ::: "memory");
    __builtin_amdgcn_s_barrier();
    asm volatile("" ::: "memory");
#undef FA_ISSUE
}
struct AttnOrder {
    int vcu, G;
    __device__ __forceinline__ bool next(int i, int& bh, int& qb) const {
        if (G == 256) { if (i >= 4) return false; const int s = vcu & 7; bh = vcu >> 3; qb = (i == 0) ? 31 - s : (i == 1) ? 16 + s : (i == 2) ? 15 - s : s; return true; }
        const int u = vcu + i * G; if (u >= 1024) return false; bh = u >> 5; qb = 31 - (u & 31); return true;
    }
};

__device__ __forceinline__ float gelu_tanh(float x) { const float u = 0.7978845608028654f * (x + 0.044715f * x * x * x); const float e = __expf(2.f * u); return 0.5f * x * (2.f - 2.f / (e + 1.f)); }
template <bool SPLIT>
__device__ __forceinline__ void nsa_compress_unit(LAS unsigned char* lds, int bg, int n0, const bf16_t* AH, const bf16_t* AL, const bf16_t* W1H, const bf16_t* W1L,
                                                  const bf16_t* W2H, const bf16_t* W2L, const float* C1P, bf16_t* KCH, bf16_t* KCL, bf16_t* VCT) {
    const int tid = otid(), lane = tid & 63, wid = __builtin_amdgcn_readfirstlane(tid >> 6), r32 = lane & 31, hi = lane >> 5;
    const size_t aoff = ((size_t)bg * 8192 + 16 * (size_t)(n0 + r32)) * 64 + 8 * hi;
    const bf16_t* ah = AH + aoff; const bf16_t* al = SPLIT ? AL + aoff : nullptr;
    const size_t boff = (size_t)(32 * wid + r32) * 2048 + 8 * hi;
    const bf16_t* bh = W1H + boff; const bf16_t* bl = SPLIT ? W1L + boff : nullptr;
    f32x16 acc;
#pragma unroll
    for (int r = 0; r < 16; ++r) acc[r] = 0.f;
#pragma unroll 1
    for (int k8 = 0; k8 < 16; ++k8) {
        bf16x8 fa_h[8], fb_h[8], fa_l[8], fb_l[8];
#pragma unroll
        for (int u = 0; u < 8; ++u) { const int kk = 8 * k8 + u; fa_h[u] = *(const bf16x8*)(ah + 16 * kk); fb_h[u] = *(const bf16x8*)(bh + 16 * kk);
            if (SPLIT) { fa_l[u] = *(const bf16x8*)(al + 16 * kk); fb_l[u] = *(const bf16x8*)(bl + 16 * kk); } }
#pragma unroll
        for (int u = 0; u < 8; ++u) { acc = __builtin_amdgcn_mfma_f32_32x32x16_bf16(fa_h[u], fb_h[u], acc, 0, 0, 0);
            if (SPLIT) { acc = __builtin_amdgcn_mfma_f32_32x32x16_bf16(fa_h[u], fb_l[u], acc, 0, 0, 0); acc = __builtin_amdgcn_mfma_f32_32x32x16_bf16(fa_l[u], fb_h[u], acc, 0, 0, 0); } }
    }
    const int col = 32 * wid + r32;
    float c1 = 0.f;
#pragma unroll 8
    for (int kc = 0; kc < 32; ++kc) c1 += C1P[kc * 256 + col];
    constexpr int GP = 528;
#pragma unroll
    for (int r = 0; r < 16; ++r) { const float gv = gelu_tanh(acc[r] + c1); const unsigned short h = pg8::f2bf_rne(gv); const int row = crow(r, hi);
        *(LAS unsigned short*)(lds + row * GP + col * 2) = h;
        if (SPLIT) *(LAS unsigned short*)(lds + 32 * GP + row * GP + col * 2) = pg8::f2bf_rne(gv - pg8::bf2f(h)); }
    __syncthreads();
    if (wid < 2) {
        f32x16 a2;
#pragma unroll
        for (int r = 0; r < 16; ++r) a2[r] = 0.f;
        const size_t woff = (size_t)(32 * wid + r32) * 256 + 8 * hi;
#pragma unroll
        for (int kk = 0; kk < 16; ++kk) {
            const bf16x8 g_h = *(const LAS bf16x8*)(lds + r32 * GP + (16 * kk + 8 * hi) * 2);
            const bf16x8 w_h = *(const bf16x8*)(W2H + woff + 16 * kk);
            a2 = __builtin_amdgcn_mfma_f32_32x32x16_bf16(g_h, w_h, a2, 0, 0, 0);
            if (SPLIT) { const bf16x8 g_l = *(const LAS bf16x8*)(lds + 32 * GP + r32 * GP + (16 * kk + 8 * hi) * 2); const bf16x8 w_l = *(const bf16x8*)(W2L + woff + 16 * kk);
                a2 = __builtin_amdgcn_mfma_f32_32x32x16_bf16(g_h, w_l, a2, 0, 0, 0);
                a2 = __builtin_amdgcn_mfma_f32_32x32x16_bf16(g_l, w_h, a2, 0, 0, 0); }
        }
        const int e = 32 * wid + r32;
#pragma unroll
        for (int r = 0; r < 16; ++r) { const int n = n0 + crow(r, hi); const float v = (n < 511) ? a2[r] : 0.f;
            if (SPLIT) { const unsigned short h = pg8::f2bf_rne(v); KCH[((size_t)bg * 512 + n) * 64 + e] = h; KCL[((size_t)bg * 512 + n) * 64 + e] = pg8::f2bf_rne(v - pg8::bf2f(h)); }
            else { const int pos = (n & ~12) | ((n & 4) << 1) | ((n & 8) >> 1); VCT[((size_t)bg * 64 + e) * 512 + pos] = pg8::f2bf_rne(v); } }
    }
    __syncthreads();
}

constexpr int IM_P = 0, IM_PPITCH = 516, IM_VAL = 66048, IM_RED = 82432, IM_RED2 = 86528, IM_TAB = 90624, IM_END = 92672;
__device__ __forceinline__ void nsa_importance_unit(LAS unsigned char* lds, int b, int g, int qblk, const bf16_t* QH, const bf16_t* QL, const bf16_t* KCH, const bf16_t* KCL,
                                                    const float* TAB, unsigned char* SEL) {
    const int tid = otid(), lane = tid & 63, wid = __builtin_amdgcn_readfirstlane(tid >> 6), r32 = lane & 31, hi = lane >> 5;
    const int t0 = 32 * qblk, qpos = t0 + r32; const size_t tok = (size_t)b * 8192 + qpos;
    LAS float* P = (LAS float*)(lds + IM_P); LAS float* VAL = (LAS float*)(lds + IM_VAL); LAS float* RED = (LAS float*)(lds + IM_RED); LAS float* RED2 = (LAS float*)(lds + IM_RED2); LAS float* TABL = (LAS float*)(lds + IM_TAB);
    TABL[tid] = TAB[(g * 4) * 128 + tid];
    __syncthreads();
    const int nmax = 2 * qblk;
    const bool act0 = 32 * wid <= nmax, act1 = 32 * (wid + 8) <= nmax;
    f32x16 sc[4][2];
#pragma unroll
    for (int r = 0; r < 4; ++r)
#pragma unroll
        for (int nt = 0; nt < 2; ++nt)
#pragma unroll
            for (int i = 0; i < 16; ++i) sc[r][nt][i] = 0.f;
    if (act0) {
        const size_t qoff = tok * 1024 + (size_t)(g * 4) * 64 + 8 * hi;
#pragma unroll
        for (int d0 = 0; d0 < 4; ++d0) {
            bf16x8 kh[2], kl[2];
#pragma unroll
            for (int nt = 0; nt < 2; ++nt) { const size_t koff = ((size_t)(b * 4 + g) * 512 + 32 * (wid + 8 * nt) + r32) * 64 + 8 * hi + 16 * d0; kh[nt] = *(const bf16x8*)(KCH + koff); kl[nt] = *(const bf16x8*)(KCL + koff); }
#pragma unroll
            for (int r = 0; r < 4; ++r) { const bf16x8 qh = *(const bf16x8*)(QH + qoff + r * 64 + 16 * d0), ql = *(const bf16x8*)(QL + qoff + r * 64 + 16 * d0);
                sc[r][0] = __builtin_amdgcn_mfma_f32_32x32x16_bf16(kh[0], qh, sc[r][0], 0, 0, 0);
                sc[r][0] = __builtin_amdgcn_mfma_f32_32x32x16_bf16(kh[0], ql, sc[r][0], 0, 0, 0);
                sc[r][0] = __builtin_amdgcn_mfma_f32_32x32x16_bf16(kl[0], qh, sc[r][0], 0, 0, 0);
                if (act1) { sc[r][1] = __builtin_amdgcn_mfma_f32_32x32x16_bf16(kh[1], qh, sc[r][1], 0, 0, 0);
                    sc[r][1] = __builtin_amdgcn_mfma_f32_32x32x16_bf16(kh[1], ql, sc[r][1], 0, 0, 0);
                    sc[r][1] = __builtin_amdgcn_mfma_f32_32x32x16_bf16(kl[1], qh, sc[r][1], 0, 0, 0); } }
        }
    }
#pragma unroll
    for (int nt = 0; nt < 2; ++nt)
#pragma unroll
        for (int i = 0; i < 16; ++i) { const int n = 32 * (wid + 8 * nt) + crow(i, hi); const int dist = qpos - (16 * n + 31); const int idx = min(max(dist, 0), 127);
#pragma unroll
            for (int r = 0; r < 4; ++r) sc[r][nt][i] = (dist >= 0) ? sc[r][nt][i] + TABL[r * 128 + idx] : NEGV; }
    float mrow[4];
#pragma unroll
    for (int r = 0; r < 4; ++r) { float mx = NEGV;
#pragma unroll
        for (int nt = 0; nt < 2; ++nt)
#pragma unroll
            for (int i = 0; i < 16; ++i) mx = fmaxf(mx, sc[r][nt][i]);
        mx = fmaxf(mx, __shfl_xor(mx, 32));
        if (hi == 0) RED[(wid * 4 + r) * 32 + r32] = mx; }
    __syncthreads();
#pragma unroll
    for (int r = 0; r < 4; ++r) { float mx = NEGV;
#pragma unroll
        for (int w = 0; w < 8; ++w) mx = fmaxf(mx, RED[(w * 4 + r) * 32 + r32]);
        mrow[r] = mx; }
#pragma unroll
    for (int r = 0; r < 4; ++r) { float sm = 0.f; const bool any = mrow[r] > -1e29f;
#pragma unroll
        for (int nt = 0; nt < 2; ++nt)
#pragma unroll
            for (int i = 0; i < 16; ++i) { const float p = any ? ex2(sc[r][nt][i] - mrow[r]) : 0.f; sc[r][nt][i] = p; sm += p; }
        sm += __shfl_xor(sm, 32);
        if (hi == 0) RED2[(wid * 4 + r) * 32 + r32] = sm; }
    __syncthreads();
    float inv[4];
#pragma unroll
    for (int r = 0; r < 4; ++r) { float sm = 0.f;
#pragma unroll
        for (int w = 0; w < 8; ++w) sm += RED2[(w * 4 + r) * 32 + r32];
        inv[r] = sm > 0.f ? 1.0f / sm : 0.f; }
#pragma unroll
    for (int nt = 0; nt < 2; ++nt)
#pragma unroll
        for (int gq = 0; gq < 4; ++gq) { f32x4 v;
#pragma unroll
            for (int i = 0; i < 4; ++i) v[i] = sc[0][nt][4 * gq + i] * inv[0] + sc[1][nt][4 * gq + i] * inv[1] + sc[2][nt][4 * gq + i] * inv[2] + sc[3][nt][4 * gq + i] * inv[3];
            *(LAS f32x4*)(P + r32 * IM_PPITCH + 32 * (wid + 8 * nt) + 8 * gq + 4 * hi) = v; }
    __syncthreads();
    const int q = tid >> 4, jc = tid & 15; const int tq = t0 + q, cur = tq >> 6;
    unsigned key[8];
#pragma unroll
    for (int jj = 0; jj < 8; ++jj) { const int j = 8 * jc + jj; const f32x4 v = *(const LAS f32x4*)(P + q * IM_PPITCH + 4 * j);
        float s = (v[0] + v[1]) + (v[2] + v[3]); if (j > 0) s += P[q * IM_PPITCH + 4 * j - 1];
        const bool valid = j <= cur, forced = (j == 0) || (j == cur) || (j == cur - 1);
        key[jj] = valid ? (__float_as_uint(forced ? 1e4f : s) + 1u) : 0u; }
#define ROW16_SUM(v_) do { v_ += __builtin_amdgcn_update_dpp(0, v_, 0xB1, 0xf, 0xf, false); v_ += __builtin_amdgcn_update_dpp(0, v_, 0x4E, 0xf, 0xf, false); \
        v_ += __builtin_amdgcn_update_dpp(0, v_, 0x141, 0xf, 0xf, false); v_ += __builtin_amdgcn_update_dpp(0, v_, 0x140, 0xf, 0xf, false); } while (0)
#define ROW16_SCAN(v_) do { v_ += __builtin_amdgcn_update_dpp(0, v_, 0x111, 0xf, 0xf, false); v_ += __builtin_amdgcn_update_dpp(0, v_, 0x112, 0xf, 0xf, false); \
        v_ += __builtin_amdgcn_update_dpp(0, v_, 0x114, 0xf, 0xf, false); v_ += __builtin_amdgcn_update_dpp(0, v_, 0x118, 0xf, 0xf, false); } while (0)
    unsigned T = 0u;
#pragma unroll
    for (int bit = 31; bit >= 0; --bit) { const unsigned cand = T | (1u << bit); int c = 0;
#pragma unroll
        for (int jj = 0; jj < 8; ++jj) c += (key[jj] >= cand) ? 1 : 0;
        ROW16_SUM(c);
        if (c >= 16) T = cand; }
    int gcnt = 0, ecnt = 0;
#pragma unroll
    for (int jj = 0; jj < 8; ++jj) { gcnt += (key[jj] > T) ? 1 : 0; ecnt += (key[jj] == T) ? 1 : 0; }
    int gtot = gcnt; ROW16_SUM(gtot);
    const int need = 16 - gtot;
    int eincl = ecnt; ROW16_SCAN(eincl);
    int erun = eincl - ecnt, scnt = 0; bool sel[8];
#pragma unroll
    for (int jj = 0; jj < 8; ++jj) { const bool eq = key[jj] == T; sel[jj] = (key[jj] > T) || (eq && erun < need); erun += eq ? 1 : 0; scnt += sel[jj] ? 1 : 0; }
    int sincl = scnt; ROW16_SCAN(sincl);
    int slot = sincl - scnt;
    unsigned char* selrow = SEL + (((size_t)b * 8192 + tq) * 4 + g) * 16;
#pragma unroll
    for (int jj = 0; jj < 8; ++jj) if (sel[jj]) { selrow[slot] = (unsigned char)(8 * jc + jj); ++slot; }
#undef ROW16_SUM
#undef ROW16_SCAN
    __syncthreads();
}

struct SelFr { bf16x8 k[8], v[8]; };
__device__ __forceinline__ float wave_max64(float v) {
#pragma unroll
    for (int o = 1; o < 64; o <<= 1) v = fmaxf(v, __shfl_xor(v, o));
    return v;
}
__device__ __forceinline__ float wave_sum64(float v) {
#pragma unroll
    for (int o = 1; o < 64; o <<= 1) v += __shfl_xor(v, o);
    return v;
}
__device__ __forceinline__ void nsa_selected_phase(LAS unsigned char* lds, int gw, int ngw, const bf16_t* QH, const bf16_t* KF, const bf16_t* VF, const unsigned char* SEL, const float* TAB, const float* GATE,
                                                   const bf16_t* OC, const bf16_t* OW, bf16_t* O) {
    const int tid = otid(), lane = tid & 63, wid = __builtin_amdgcn_readfirstlane(tid >> 6), r32 = lane & 31, hi = lane >> 5;
    LAS float* TABL = (LAS float*)lds;
    for (int i = tid; i < 2048; i += 512) TABL[i] = TAB[i];
    __syncthreads();
    LAS unsigned char* pt = lds + 8192 + wid * 1024;
    const int ppos = (lane & ~12) | ((lane & 4) << 1) | ((lane & 8) >> 1);
#define SEL_LOAD(S, j_) do { const bf16_t* kb_ = KF + ((size_t)(bg * 128 + (j_)) * 8) * 512 + lane * 8; const bf16_t* vb_ = VF + ((size_t)(bg * 128 + (j_)) * 8) * 512 + lane * 8; \
        _Pragma("unroll") for (int f_ = 0; f_ < 8; ++f_) { S.k[f_] = *(const bf16x8*)(kb_ + f_ * 512); S.v[f_] = *(const bf16x8*)(vb_ + f_ * 512); } } while (0)
#define SEL_COMPUTE(S, j_) do { f32x16 p0, p1; \
        _Pragma("unroll") for (int r_ = 0; r_ < 16; ++r_) { p0[r_] = 0.f; p1[r_] = 0.f; } \
        _Pragma("unroll") for (int d0 = 0; d0 < 4; ++d0) { p0 = __builtin_amdgcn_mfma_f32_32x32x16_bf16(qa[d0], S.k[d0], p0, 0, 0, 0); p1 = __builtin_amdgcn_mfma_f32_32x32x16_bf16(qa[d0], S.k[4 + d0], p1, 0, 0, 0); } \
        float s_[4]; _Pragma("unroll") for (int h = 0; h < 4; ++h) s_[h] = hi ? p1[h] : p0[h]; \
        if (64 * (j_) + 63 >= t - 127) { const int dist = t - (64 * (j_) + lane); const int idx = min(max(dist, 0), 127); \
            _Pragma("unroll") for (int h = 0; h < 4; ++h) s_[h] = (dist >= 0) ? s_[h] + TABL[(g * 4 + h) * 128 + idx] : NEGV; } \
        const bool ex_ = (s_[0] > m_run[0] + 8.f) || (s_[1] > m_run[1] + 8.f) || (s_[2] > m_run[2] + 8.f) || (s_[3] > m_run[3] + 8.f); \
        if (__any(ex_)) { float asel = 1.f; \
            _Pragma("unroll") for (int h = 0; h < 4; ++h) { const float mn = fmaxf(m_run[h], wave_max64(s_[h])); const float al = ex2(m_run[h] - mn); ll[h] *= al; m_run[h] = mn; if ((r32 & 3) == h) asel = al; } \
            _Pragma("unroll") for (int r_ = 0; r_ < 16; ++r_) { o[0][r_] *= asel; o[1][r_] *= asel; } } \
        _Pragma("unroll") for (int h = 0; h < 4; ++h) { const float p_ = ex2(s_[h] - m_run[h]); ll[h] += p_; *(LAS unsigned short*)(pt + h * 144 + ppos * 2) = (unsigned short)(pg8::cvt_pk_bf16(p_, 0.f) & 0xffffu); } \
        bf16x8 pf[4]; _Pragma("unroll") for (int ks = 0; ks < 4; ++ks) pf[ks] = *(const LAS bf16x8*)(pt + (r32 & 3) * 144 + (16 * ks + 8 * hi) * 2); \
        _Pragma("unroll") for (int db = 0; db < 2; ++db) _Pragma("unroll") for (int ks = 0; ks < 4; ++ks) o[db] = __builtin_amdgcn_mfma_f32_32x32x16_bf16(S.v[db * 4 + ks], pf[ks], o[db], 0, 0, 0); } while (0)
#define SEL_BYTE(i_) __builtin_amdgcn_readfirstlane((int)(((((i_) < 4) ? selw.x : ((i_) < 8) ? selw.y : ((i_) < 12) ? selw.z : selw.w) >> (8 * ((i_) & 3))) & 255u))
    const int nper = ngw >> 3;
    for (int it = gw % nper; it < 8192; it += nper) {
        const int bg = gw / nper, b = bg >> 2, g = bg & 3, t = it, tokI = b * 8192 + t; const size_t tok = (size_t)tokI;
        const int head = g * 4 + (r32 & 3);
        bf16x8 qa[4];
#pragma unroll
        for (int d0 = 0; d0 < 4; ++d0) qa[d0] = *(const bf16x8*)(QH + tok * 1024 + head * 64 + 16 * d0 + 8 * hi);
        const u32x4 selw = *(const u32x4*)(SEL + (tok * 4 + g) * 16);
        float m_run[4], ll[4]; f32x16 o[2];
#pragma unroll
        for (int h = 0; h < 4; ++h) { m_run[h] = NEGV; ll[h] = 0.f; }
#pragma unroll
        for (int r = 0; r < 16; ++r) { o[0][r] = 0.f; o[1][r] = 0.f; }
        SelFr A, B;
        int jn = SEL_BYTE(0); SEL_LOAD(A, jn);
#pragma unroll 1
        for (int i = 0; i < 16; i += 2) {
            const int j0 = jn; jn = SEL_BYTE(i + 1); SEL_LOAD(B, jn);
            if (64 * j0 <= t) SEL_COMPUTE(A, j0);
            const int j1 = jn; if (i + 2 < 16) { jn = SEL_BYTE(i + 2); SEL_LOAD(A, jn); }
            if (64 * j1 <= t) SEL_COMPUTE(B, j1);
        }
        float lsel = 1.f;
#pragma unroll
        for (int h = 0; h < 4; ++h) { const float lt = wave_sum64(ll[h]); if ((r32 & 3) == h) lsel = lt; }
        if (r32 < 4) {
            const float inv = GATE[tok * 48 + head * 3 + 1] / lsel;
#pragma unroll
            for (int db = 0; db < 2; ++db)
#pragma unroll
                for (int gq = 0; gq < 4; ++gq) { const size_t off = tok * 1024 + head * 64 + 32 * db + 8 * gq + 4 * hi;
                    const u32x2 c = *(const u32x2*)(OC + off), w = *(const u32x2*)(OW + off);
                    const float r0 = o[db][4 * gq] * inv + __uint_as_float(c.x << 16) + __uint_as_float(w.x << 16), r1 = o[db][4 * gq + 1] * inv + __uint_as_float(c.x & 0xffff0000u) + __uint_as_float(w.x & 0xffff0000u);
                    const float r2 = o[db][4 * gq + 2] * inv + __uint_as_float(c.y << 16) + __uint_as_float(w.y << 16), r3 = o[db][4 * gq + 3] * inv + __uint_as_float(c.y & 0xffff0000u) + __uint_as_float(w.y & 0xffff0000u);
                    u32x2 ov; ov.x = pg8::cvt_pk_bf16(r0, r1); ov.y = pg8::cvt_pk_bf16(r2, r3); *(u32x2*)(O + off) = ov; }
        }
    }
#undef SEL_LOAD
#undef SEL_COMPUTE
#undef SEL_BYTE
    __syncthreads();
}
}
typedef unsigned v4u __attribute__((ext_vector_type(4)));
#define XB_TMO      128
#define XB_XCNT(j)  (256  + 64 * (j))
#define XB_XSUB(j)  (1280 + 64 * (j))
#define XB_XGEN(j)  (2304 + 64 * (j))
#define XB_TOP      3328
#define XB_TOPGEN   3392
#define XCD_BAR_WORDS 3456
#define XB_SPIN_CAP (1u << 18)

__device__ __forceinline__ unsigned xb_ld(unsigned* p)              { return __hip_atomic_load(p, __ATOMIC_RELAXED, __HIP_MEMORY_SCOPE_AGENT); }
__device__ __forceinline__ unsigned xb_add(unsigned* p, unsigned v) { return __hip_atomic_fetch_add(p, v, __ATOMIC_RELAXED, __HIP_MEMORY_SCOPE_AGENT); }
__device__ __forceinline__ unsigned xb_xcc_id() { return (unsigned)__builtin_amdgcn_s_getreg((3 << 11) | 20) & 0xFu; }
#define XB_SPIN(cond, bar) do { unsigned _sp = 0; while (cond) { __builtin_amdgcn_s_sleep(1); \
    if ((++_sp & 255u) == 0u) { if (xb_ld(&(bar)[XB_TMO])) break; if (_sp > XB_SPIN_CAP) { atomicAdd(&(bar)[XB_TMO], 1u); break; } } } } while (0)

struct XcdBarrier {
    unsigned* bar; unsigned x;
    volatile LAS unsigned* st;
};

__device__ __forceinline__ XcdBarrier xcd_barrier_post(unsigned* bar, volatile LAS unsigned* st) {
    XcdBarrier b; b.bar = bar; b.x = xb_xcc_id(); b.st = st;
    if (threadIdx.x == 0) (void)xb_add(&bar[XB_XCNT(b.x)], 1u);
    return b;
}
__device__ __forceinline__ void xcd_barrier_complete(unsigned* bar, unsigned x, unsigned& nloc, unsigned& nx) {
    const unsigned G = gridDim.x * gridDim.y * gridDim.z;
    unsigned sum, cnt, mine, sp = 0u;
    for (;;) {
        sum = 0u; cnt = 0u; mine = 0u;
#pragma unroll
        for (unsigned j = 0; j < 16; ++j) { const unsigned c = xb_ld(&bar[XB_XCNT(j)]); sum += c; cnt += (c > 0u) ? 1u : 0u; mine = (j == x) ? c : mine; }
        if (sum == G) break;
        __builtin_amdgcn_s_sleep(1);
        if ((++sp & 255u) == 0u) { if (xb_ld(&bar[XB_TMO])) break; if (sp > XB_SPIN_CAP) { atomicAdd(&bar[XB_TMO], 1u); break; } }
    }
    nloc = mine > 0u ? mine : 1u; nx = cnt > 0u ? cnt : 1u;
}

__device__ __forceinline__ void xcd_barrier(const XcdBarrier& b) {
    asm volatile("s_waitcnt vmcnt(0)" ::: "memory");
    __syncthreads();
    if (threadIdx.x == 0) {
        unsigned* bar = b.bar;
        __builtin_amdgcn_s_waitcnt(0);
        unsigned nloc = b.st[0], nx = b.st[1];
        if (nloc == 0u) { xcd_barrier_complete(bar, b.x, nloc, nx); b.st[0] = nloc; b.st[1] = nx; }
        const unsigned old = xb_add(&bar[XB_XSUB(b.x)], 1u);
        const unsigned gen = old / nloc;
        if (old + 1u == (gen + 1u) * nloc) {
            __builtin_amdgcn_fence(__ATOMIC_RELEASE, "agent");
            asm volatile("s_waitcnt vmcnt(0)" ::: "memory");
            const unsigned og = xb_add(&bar[XB_TOP], 1u);
            const unsigned tg = og / nx;
            if (og + 1u == (tg + 1u) * nx) xb_add(&bar[XB_TOPGEN], 1u);
            else XB_SPIN(xb_ld(&bar[XB_TOPGEN]) == tg, bar);
            __builtin_amdgcn_fence(__ATOMIC_ACQUIRE, "agent");
            xb_add(&bar[XB_XGEN(b.x)], 1u);
            asm volatile("s_waitcnt vmcnt(0)" ::: "memory");
        } else {
            XB_SPIN(xb_ld(&bar[XB_XGEN(b.x)]) == gen, bar);
            __builtin_amdgcn_fence(__ATOMIC_ACQUIRE, "agent");
            asm volatile("s_waitcnt vmcnt(0)" ::: "memory");
        }
    }
    __syncthreads();
}
using pg8::bf16_t; using pg8::f32x4; using pg8::u32x4; using pg8::u32x2;
constexpr int NWAVES = 8, NTHREADS = 512;
constexpr int MTOK = 16384, DM = 1024, SEQ = 8192, DFF = 4096;
constexpr float NORM_EPS = 1e-6f, LOG2E = 1.4426950408889634f, QSCALE = 0.125f * 1.4426950408889634f;
constexpr size_t MiB = 1u << 20;
constexpr size_t WS_TAB = 0;
constexpr size_t WS_C1P = 64 * 1024;
constexpr size_t WS_CTL = 512 * 1024, CTL_BYTES = 16 * 1024;
constexpr size_t WS_W1T = 1 * MiB, WS_W2T = 9 * MiB, WS_WGT = 17 * MiB, WS_WPT = 19 * MiB, WS_WOT = 20 * MiB, WS_WIN = 22 * MiB, WS_WVT = 30 * MiB, WS_WB = 32 * MiB;
constexpr size_t WS_CW1 = 34 * MiB;
constexpr size_t WS_CW2 = 38 * MiB;
constexpr size_t WS_XH = 40 * MiB;
constexpr size_t WS_BIG = 72 * MiB;
constexpr size_t WS_Y = 200 * MiB;
constexpr size_t WS_AUX = 264 * MiB;
constexpr size_t WS_PB = 296 * MiB;
constexpr size_t WS_LF = 304 * MiB, WS_KBIAS = 305 * MiB, WS_SEL = 306 * MiB, WS_GATE = 307 * MiB;
constexpr size_t WS_KC = 310 * MiB;
constexpr size_t WS_END = 312 * MiB;
constexpr int LDS_BYTES = 147456, LDS_MISC = 131072 + 320;

__device__ const unsigned char kBucket[128] = {0, 1, 2, 3, 4, 5, 6, 7, 8, 9, 10, 11, 12, 13, 14, 15, 16, 16, 16, 17, 17, 18, 18, 18, 19, 19, 19, 20, 20, 20, 20, 21, 21, 21, 21, 22, 22, 22, 22, 22, 23, 23, 23, 23, 23, 23, 24, 24, 24, 24, 24, 24,
    25, 25, 25, 25, 25, 25, 25, 26, 26, 26, 26, 26, 26, 26, 26, 27, 27, 27, 27, 27, 27, 27, 27, 27, 27, 28, 28, 28, 28, 28, 28, 28, 28, 28, 28, 29, 29, 29, 29, 29, 29, 29, 29, 29, 29, 29, 29, 30, 30, 30, 30, 30, 30, 30, 30, 30, 30, 30, 30, 30, 30,
    31, 31, 31, 31, 31, 31, 31, 31, 31, 31, 31, 31, 31, 31, 31};

struct Args { const float* in[20]; float* out; unsigned char* ws; int ph_lo, ph_hi; };
enum { IN_X = 0, IN_P, IN_REL, IN_NG, IN_W1, IN_W2, IN_PLEW, IN_GATEW, IN_DAIN, IN_DALAM, IN_DASUB, IN_DAOUT, IN_NSAIN, IN_NSAPE, IN_NSAW1, IN_NSAW2, IN_NSAOUT, IN_FOXIN, IN_FOXB, IN_FOXOUT };

__device__ __forceinline__ float wave_sum(float v) {
#pragma unroll
    for (int o = 1; o < 64; o <<= 1) v += __shfl_xor(v, o);
    return v;
}
__device__ __forceinline__ unsigned pk2(float lo, float hi) { return pg8::cvt_pk_bf16(lo, hi); }

__device__ __forceinline__ void tr_item(const float* W, int ldn, int cbeg, int nvalid, bf16_t* dst, int ldd, int row0, int kofs, int lo, LAS float* scr, int kb, int nb, int lane) {
    const int k0 = 64 * kb, n0 = 32 * nb;
    float ld_[32]; const int nn = n0 + (lane & 31); const float* wp = W + (size_t)(k0 + (lane >> 5)) * ldn + cbeg + nn;
#pragma unroll
    for (int i = 0; i < 32; ++i) ld_[i] = (nn < nvalid) ? wp[(size_t)(2 * i) * ldn] : 0.f;
#pragma unroll
    for (int i = 0; i < 32; ++i) scr[(2 * i + (lane >> 5)) * 33 + (lane & 31)] = ld_[i];
    asm volatile("s_waitcnt lgkmcnt(0)" ::: "memory");
    const int c = lane & 7;
#pragma unroll
    for (int j = 0; j < 4; ++j) { const int n = (lane >> 3) + 8 * j; const LAS float* s = scr + (8 * c) * 33 + n; float v[8];
#pragma unroll
        for (int i = 0; i < 8; ++i) { v[i] = s[i * 33]; if (lo) v[i] = v[i] - pg8::bf2f(pg8::f2bf_rne(v[i])); }
        u32x4 o; o.x = pk2(v[0], v[1]); o.y = pk2(v[2], v[3]); o.z = pk2(v[4], v[5]); o.w = pk2(v[6], v[7]);
        *(u32x4*)(dst + (size_t)(row0 + n0 + n) * ldd + kofs + k0 + 8 * c) = o; }
    asm volatile("s_waitcnt lgkmcnt(0)" ::: "memory");
}
__device__ __forceinline__ void tr_job(const float* W, int K, int ldn, int cbeg, int nvalid, int npad, bf16_t* dst, int ldd, int row0, int kofs, int lo, LAS float* scr, int gw, int ngw, int lane) {
    const int nnb = npad / 32, nitems = (K / 64) * nnb;
    for (int it = gw; it < nitems; it += ngw) tr_item(W, ldn, cbeg, nvalid, dst, ldd, row0, kofs, lo, scr, it / nnb, it % nnb, lane);
}

template <int MODE  >
__device__ __forceinline__ void norm_rows(const float* xsrc, float* X, const bf16_t* Y, const float* ga, const float* gb, bf16_t* XH, bf16_t* H3, int gw, int ngw, int lane) {
    constexpr int R = 2;
    for (int m0 = gw * R; m0 < MTOK; m0 += ngw * R) {
        f32x4 v[R][4], y[R][4];
#pragma unroll
        for (int q = 0; q < R; ++q) { const f32x4* xr = (const f32x4*)(xsrc + (size_t)(m0 + q) * DM) + lane;
#pragma unroll
            for (int j = 0; j < 4; ++j) v[q][j] = xr[64 * j];
            if (MODE != 0) { const u32x2* yr = (const u32x2*)(Y + (size_t)(m0 + q) * DM) + lane;
#pragma unroll
                for (int j = 0; j < 4; ++j) { const u32x2 w = yr[64 * j]; y[q][j][0] = __uint_as_float(w.x << 16); y[q][j][1] = __uint_as_float(w.x & 0xffff0000u); y[q][j][2] = __uint_as_float(w.y << 16); y[q][j][3] = __uint_as_float(w.y & 0xffff0000u); } } }
#pragma unroll
        for (int q = 0; q < R; ++q) { const int m = m0 + q;
            if (MODE != 0) { float s = 0.f;
#pragma unroll
                for (int j = 0; j < 4; ++j) s += (y[q][j][0] * y[q][j][0] + y[q][j][1] * y[q][j][1]) + (y[q][j][2] * y[q][j][2] + y[q][j][3] * y[q][j][3]);
                const float ry = rsqrtf(wave_sum(s) * (1.f / DM) + NORM_EPS);
#pragma unroll
                for (int j = 0; j < 4; ++j) { const f32x4 g = ((const f32x4*)ga)[lane + 64 * j]; v[q][j] = v[q][j] + y[q][j] * ry * g; } }
            if (MODE != 0 || xsrc != X) { f32x4* xo = (f32x4*)(X + (size_t)m * DM) + lane;
#pragma unroll
                for (int j = 0; j < 4; ++j) xo[64 * j] = v[q][j]; }
            if (MODE != 2) { float s = 0.f;
#pragma unroll
                for (int j = 0; j < 4; ++j) s += (v[q][j][0] * v[q][j][0] + v[q][j][1] * v[q][j][1]) + (v[q][j][2] * v[q][j][2] + v[q][j][3] * v[q][j][3]);
                const float rx = rsqrtf(wave_sum(s) * (1.f / DM) + NORM_EPS);
#pragma unroll
                for (int j = 0; j < 4; ++j) { const f32x4 g = ((const f32x4*)gb)[lane + 64 * j]; v[q][j] = v[q][j] * rx * g; } }
            u32x2* ho = (u32x2*)(XH + (size_t)m * DM) + lane;
#pragma unroll
            for (int j = 0; j < 4; ++j) { u32x2 h; h.x = pk2(v[q][j][0], v[q][j][1]); h.y = pk2(v[q][j][2], v[q][j][3]); ho[64 * j] = h;
                if (MODE == 0) { if (H3) { u32x2 l; l.x = pk2(v[q][j][0] - __uint_as_float(h.x << 16), v[q][j][1] - __uint_as_float(h.x & 0xffff0000u)); l.y = pk2(v[q][j][2] - __uint_as_float(h.y << 16), v[q][j][3] - __uint_as_float(h.y & 0xffff0000u));
                    u32x2* h3 = (u32x2*)(H3 + (size_t)m * 3072) + lane; h3[64 * j] = h; h3[256 + 64 * j] = h; h3[512 + 64 * j] = l; } } } }
    }
}

template <class Epi> __device__ __forceinline__ void run_gemm(LAS unsigned char* lds, const bf16_t* A, const bf16_t* Bt, int M, int N, int K, const Epi& E, int rot = 0) {
    pg8::Gemm g{A, Bt, M, N, oqi(K)}; pg8::StaticOrder S; const int G_ = oqi((int)gridDim.x); S.init(M, N, G_, (oqi((int)blockIdx.x) + rot) % G_);
    pg8::gemm_phase<Epi, pg8::StaticOrder, true, true>((PG8_LAS unsigned char*)lds, g, S, E);
}

#ifndef FLASH_DA
#define FLASH_DA fa::flash_unit_reg
#endif
#ifndef FLASH_FOX
#define FLASH_FOX fa::flash_unit_reg
#endif
#ifndef FLASH_NSA
#define FLASH_NSA fa::flash_unit_reg
#endif
#ifndef ONLY_PK
#define ONLY_PK -1
#endif
#ifndef ONLY_KIND
#define ONLY_KIND -1
#endif
#define PH_ON(k) (ONLY_PK < 0 || ONLY_PK == (k))
#define KIND_IS(kk) ((ONLY_KIND < 0 || ONLY_KIND == (kk)) && kind == (kk))
__device__ __forceinline__ int layer_kind(int layer) { return layer % 3; }
__device__ __forceinline__ int layer_nph(int layer) { return layer_kind(layer) == 1 ? 11 : 10; }
constexpr int N_PHASES = 10 + 11 + 10 + 10;
enum { PK_PRO = 0, PK_INPROJ, PK_MIX1, PK_MIX2, PK_MIX3, PK_OUTPROJ, PK_NORMB, PK_UP, PK_DOWN, PK_NORMC, PK_GATE };

__global__ void __launch_bounds__(NTHREADS, 2) trunk_fwd(Args args) {
    extern __shared__ __attribute__((aligned(16))) unsigned char lds_raw[];
    LAS unsigned char* lds = (LAS unsigned char*)lds_raw;
#define X (args.out)
#define TAB ((float*)(ws + WS_TAB))
#define C1P ((float*)(ws + WS_C1P))
#define W1T ((bf16_t*)(ws + WS_W1T))
#define W2T ((bf16_t*)(ws + WS_W2T))
#define WGT ((bf16_t*)(ws + WS_WGT))
#define WPT ((bf16_t*)(ws + WS_WPT))
#define WOT ((bf16_t*)(ws + WS_WOT))
#define WIN ((bf16_t*)(ws + WS_WIN))
#define WVT ((bf16_t*)(ws + WS_WVT))
#define WB ((bf16_t*)(ws + WS_WB))
#define CW1 ((bf16_t*)(ws + WS_CW1))
#define CW2 ((bf16_t*)(ws + WS_CW2))
#define XH ((bf16_t*)(ws + WS_XH))
#define BIG ((bf16_t*)(ws + WS_BIG))
#define Y ((bf16_t*)(ws + WS_Y))
#define PB ((bf16_t*)(ws + WS_PB))
#define AUX ((bf16_t*)(ws + WS_AUX))
#define LF ((float*)(ws + WS_LF))
#define KBIAS ((float*)(ws + WS_KBIAS))
#define SEL (ws + WS_SEL)
#define GATE ((float*)(ws + WS_GATE))
#define KCH ((bf16_t*)(ws + WS_KC))
#define KCL (KCH + 262144)
#define VCT (KCH + 524288)
#define QK BIG
#define VT (BIG + 32 * MiB)
#define O_DF (BIG + 48 * MiB)
#define OD ((bf16_t*)(ws + WS_Y))
#define H3 BIG
#define KSb (BIG + 48 * MiB)
#define KWb (BIG + 52 * MiB)
#define VTn (BIG + 56 * MiB)
#define OC BIG
#define OW (BIG + 16 * MiB)
#define O_N (BIG + 32 * MiB)
#define QH ((bf16_t*)(ws + WS_Y))
#define QL (QH + 16 * MiB)
#define KIH AUX
#define KIL (AUX + (9 * MiB) / 2)
#define VCI (AUX + 9 * MiB)
#define PW AUX
#define U BIG
    cg::grid_group grid = cg::this_grid();
    { volatile LAS unsigned* misc = (volatile LAS unsigned*)(lds + LDS_MISC); if (threadIdx.x < 32) misc[threadIdx.x] = 0u; }
    __syncthreads();
    XcdBarrier xbar = xcd_barrier_post((unsigned*)(args.ws + WS_CTL), (volatile LAS unsigned*)(lds + LDS_MISC + 32));
    bool first_seam = true;

    int layer = 0, base = 0;
#if REP_PK >= 0
    int rep_done = 0;
#endif
    for (int ph = args.ph_lo; ph < args.ph_hi; ++ph) {
        const int wave = __builtin_amdgcn_readfirstlane(otid() >> 6);
#define TIDL const int tid = otid(), lane = tid & 63; (void)tid; (void)lane;
        const int G = oqi((int)gridDim.x), bx = oqi((int)blockIdx.x); const int vcu = (G % 8 == 0) ? (bx % 8) * (G / 8) + bx / 8 : bx;
        const int gw = vcu * NWAVES + wave, ngw = G * NWAVES;
        unsigned char* ws = oq(args.ws);
        while (ph - base >= layer_nph(layer)) { base += layer_nph(layer); ++layer; }
        const int kind = layer_kind(layer); int pk = ph - base; if (kind != 1 && pk >= PK_MIX3) pk += 1;
        const int mi = layer / 3;
        const float* ng = args.in[IN_NG] + (size_t)layer * 4 * DM;
        bf16_t* Omix = (kind == 1) ? O_N : O_DF;
        LAS float* scr = (LAS float*)(lds + wave * 16384);
        switch (pk) {
        case PK_PRO: if (PH_ON(PK_PRO)) { TIDL
            if (layer == 0 && bx == 0) { const float* rel = args.in[IN_REL]; for (int i = tid; i < 2048; i += NTHREADS) { const int head = i >> 7, d = i & 127; TAB[i] = (rel[kBucket[d] * 16 + head] - rel[31 * 16 + head]) * LOG2E; } }
            tr_job(args.in[IN_W1] + (size_t)layer * DM * DFF, DM, DFF, 0, DFF, DFF, W1T, DM, 0, 0, 0, scr, gw, ngw, lane);
            tr_job(args.in[IN_W2] + (size_t)layer * DFF * DM, DFF, DM, 0, DM, DM, W2T, DFF, 0, 0, 0, scr, gw, ngw, lane);
            tr_job(args.in[IN_GATEW] + (size_t)layer * DM * DM, DM, DM, 0, DM, DM, WGT, DM, 0, 0, 0, scr, gw, ngw, lane);
            tr_job(args.in[IN_PLEW] + (size_t)layer * 256 * DM, 256, DM, 0, DM, DM, WPT, 256, 0, 0, 0, scr, gw, ngw, lane);
            if (kind == 0) { const float* wi = args.in[IN_DAIN] + (size_t)mi * DM * 3072;
                tr_job(args.in[IN_DAOUT] + (size_t)mi * DM * DM, DM, DM, 0, DM, DM, WOT, DM, 0, 0, 0, scr, gw, ngw, lane);
                tr_job(wi, DM, 3072, 0, 2048, 2048, WIN, DM, 0, 0, 0, scr, gw, ngw, lane);
                tr_job(wi, DM, 3072, 2048, 1024, 1024, WVT, DM, 0, 0, 0, scr, gw, ngw, lane);
            } else if (kind == 2) { const float* wi = args.in[IN_FOXIN] + (size_t)mi * DM * 3088;
                tr_job(args.in[IN_FOXOUT] + (size_t)mi * DM * DM, DM, DM, 0, DM, DM, WOT, DM, 0, 0, 0, scr, gw, ngw, lane);
                tr_job(wi, DM, 3088, 0, 2048, 2048, WIN, DM, 0, 0, 0, scr, gw, ngw, lane);
                tr_job(wi, DM, 3088, 3072, 16, 256, WIN, DM, 2048, 0, 0, scr, gw, ngw, lane);
                tr_job(wi, DM, 3088, 2048, 1024, 1024, WVT, DM, 0, 0, 0, scr, gw, ngw, lane);
            } else { const float* wi = args.in[IN_NSAIN] + (size_t)mi * DM * 2608;
                tr_job(args.in[IN_NSAOUT] + (size_t)mi * DM * DM, DM, DM, 0, DM, DM, WOT, DM, 0, 0, 0, scr, gw, ngw, lane);
                tr_job(wi, DM, 2608, 0, 1280, 1280, WIN, 3072, 0, 0, 0, scr, gw, ngw, lane);
                tr_job(wi, DM, 2608, 0, 1280, 1280, WIN, 3072, 0, 1024, 1, scr, gw, ngw, lane);
                tr_job(wi, DM, 2608, 0, 1280, 1280, WIN, 3072, 0, 2048, 0, scr, gw, ngw, lane);
                tr_job(wi, DM, 2608, 1280, 256, 256, WB, DM, 0, 0, 0, scr, gw, ngw, lane);
                tr_job(wi, DM, 2608, 1536, 256, 256, WB, DM, 256, 0, 0, scr, gw, ngw, lane);
                tr_job(wi, DM, 2608, 2048, 256, 256, WB, DM, 512, 0, 0, scr, gw, ngw, lane);
                tr_job(wi, DM, 2608, 2560, 48, 256, WB, DM, 768, 0, 0, scr, gw, ngw, lane);
                tr_job(wi, DM, 2608, 1792, 256, 256, WVT, DM, 0, 0, 0, scr, gw, ngw, lane);
                tr_job(wi, DM, 2608, 2304, 256, 256, WVT, DM, 256, 0, 0, scr, gw, ngw, lane);
                const float* cw1 = args.in[IN_NSAW1] + (size_t)mi * 2 * 2048 * 256; const float* cw2 = args.in[IN_NSAW2] + (size_t)mi * 2 * 256 * 64;
                tr_job(cw1, 2048, 256, 0, 256, 256, CW1, 2048, 0, 0, 0, scr, gw, ngw, lane);
                tr_job(cw1, 2048, 256, 0, 256, 256, CW1 + 524288, 2048, 0, 0, 1, scr, gw, ngw, lane);
                tr_job(cw1 + 2048 * 256, 2048, 256, 0, 256, 256, CW1 + 2 * 524288, 2048, 0, 0, 0, scr, gw, ngw, lane);
                tr_job(cw2, 256, 64, 0, 64, 64, CW2, 256, 0, 0, 0, scr, gw, ngw, lane);
                tr_job(cw2, 256, 64, 0, 64, 64, CW2 + 16384, 256, 0, 0, 1, scr, gw, ngw, lane);
                tr_job(cw2 + 256 * 64, 256, 64, 0, 64, 64, CW2 + 2 * 16384, 256, 0, 0, 0, scr, gw, ngw, lane);
                const float* pe = args.in[IN_NSAPE] + (size_t)mi * 2 * 2048;
                for (int task = gw; task < 256; task += ngw) { const int which = task >> 7, kc = (task >> 2) & 31, cc = task & 3; const float* w = cw1 + (size_t)which * 2048 * 256 + (size_t)(64 * kc) * 256 + 64 * cc + lane;
                    const float* pp = pe + which * 2048 + 64 * kc; float s = 0.f;
                    for (int k = 0; k < 64; ++k) s += pp[k] * w[(size_t)k * 256];
                    C1P[(which * 32 + kc) * 256 + 64 * cc + lane] = s; }
            }
            { const f32x4* src = (const f32x4*)(args.in[IN_P] + (size_t)layer * MTOK * 256); u32x4* dstp = (u32x4*)PB;
              for (int i = bx * NTHREADS + tid; i < MTOK * 256 / 8; i += G * NTHREADS) { const f32x4 a = src[2 * i], b = src[2 * i + 1]; dstp[i] = pg8::pack8(a, b); } }
            norm_rows<0>(layer == 0 ? args.in[IN_X] : (const float*)X, X, (const bf16_t*)nullptr, nullptr, ng, XH, kind == 1 ? H3 : (bf16_t*)nullptr, gw, ngw, lane);
        } break;
        case PK_INPROJ: if (PH_ON(PK_INPROJ)) {
            if (kind == 1) {
                pg8::EpiNsaA EA{QH, QL, KIH, KIL, QSCALE}; run_gemm(lds, H3, WIN, MTOK, 1280, 3072, EA);
                pg8::EpiNsaB EB{VCI, KSb, KWb, GATE}; run_gemm(lds, XH, WB, MTOK, 1024, DM, EB);
                pg8::EpiVt EV{VTn, MTOK, 256}; run_gemm(lds, WVT, XH, 512, MTOK, DM, EV, 128);
            } else {
                pg8::EpiQK EQ{QK, LF, args.in[IN_FOXB] + (size_t)mi * 16, QSCALE}; run_gemm(lds, XH, WIN, MTOK, kind == 2 ? 2304 : 2048, DM, EQ);
                pg8::EpiVt EV{VT, MTOK, 0}; run_gemm(lds, WVT, XH, 1024, MTOK, DM, EV);
            }
        } break;
        case PK_MIX1: if (PH_ON(PK_MIX1)) { TIDL
            if (kind == 0) {
                fa::AttnOrder ord{vcu, G}; int bh, qb;
                for (int i = 0; ord.next(i, bh, qb); ++i) { const int b = bh >> 4, sh = bh & 15; fa::FlashArgs a;
                    a.Q = QK + ((size_t)b * SEQ + 256 * qb) * 2048 + sh * 64; a.ldq = 2048; a.K = QK + (size_t)b * SEQ * 2048 + 1024 + sh * 64; a.ldk = 2048;
                    a.Vt = VT + (size_t)((sh >> 1) * 128) * MTOK + (size_t)b * SEQ; a.ldv = MTOK; a.q0 = 256 * qb; a.t_lo = 0; a.t_hi = 4 * qb + 3; a.pa = 1; a.pb = 0; a.window = 1 << 30;
                    a.kbias = nullptr; a.tab = TAB + sh * 128; a.O = OD + ((size_t)b * SEQ + 256 * qb) * 2048 + sh * 128; a.ldo = 2048; a.gate = nullptr; a.ldg = 0;
                    FLASH_DA<128, 2, 0>(lds, a); }
            } else if (kind == 2) {
                if (vcu < 32) { const int b = vcu >> 4, h = vcu & 15; const float* src = LF + ((size_t)b * SEQ + 16 * tid) * 16 + h; float v[16];
#pragma unroll
                    for (int i = 0; i < 16; ++i) v[i] = src[(size_t)i * 16];
#pragma unroll
                    for (int i = 1; i < 16; ++i) v[i] += v[i - 1];
                    float incl = v[15];
#pragma unroll
                    for (int o = 1; o < 64; o <<= 1) { const float tmp = __shfl_up(incl, o); if (lane >= o) incl += tmp; }
                    LAS float* wt = (LAS float*)lds;
                    if (lane == 63) wt[wave] = incl;
                    __syncthreads();
                    float off = incl - v[15];
                    for (int w = 0; w < wave; ++w) off += wt[w];
                    f32x4* dst = (f32x4*)(KBIAS + (size_t)(b * 16 + h) * SEQ + 16 * tid);
#pragma unroll
                    for (int q = 0; q < 4; ++q) { f32x4 ov; ov[0] = -(off + v[4 * q]) * LOG2E; ov[1] = -(off + v[4 * q + 1]) * LOG2E; ov[2] = -(off + v[4 * q + 2]) * LOG2E; ov[3] = -(off + v[4 * q + 3]) * LOG2E; dst[q] = ov; }
                    __syncthreads(); }
            } else {
                for (int u = vcu; u < 256; u += G) { const int which = u >> 7, bg = (u >> 4) & 7, n0 = 32 * (u & 15);
                    if (which == 0) fa::nsa_compress_unit<true>(lds, bg, n0, KIH, KIL, CW1, CW1 + 524288, CW2, CW2 + 16384, C1P, KCH, KCL, VCT);
                    else fa::nsa_compress_unit<false>(lds, bg, n0, VCI, nullptr, CW1 + 2 * 524288, nullptr, CW2 + 2 * 16384, nullptr, C1P + 32 * 256, KCH, KCL, VCT); }
            }
        } break;
        case PK_MIX2: if (PH_ON(PK_MIX2)) { TIDL
            if (kind == 0) {
                const float* lamp = args.in[IN_DALAM] + (size_t)mi * 256; const float lam_init = 0.8f - 0.6f * expf(-0.3f * (float)layer);
                const float lam = expf(wave_sum(lamp[lane] * lamp[64 + lane])) - expf(wave_sum(lamp[128 + lane] * lamp[192 + lane])) + lam_init;
                const float* sg = args.in[IN_DASUB] + (size_t)mi * 128; const int hd = lane >> 3, e0 = (lane & 7) * 16;
                float gsc[16];
#pragma unroll
                for (int i = 0; i < 16; ++i) gsc[i] = sg[e0 + i] * (1.f - lam_init);
                for (int m = gw; m < MTOK; m += ngw) { const bf16_t* p0 = OD + (size_t)m * 2048 + (2 * hd) * 128 + e0; const bf16_t* p1 = p0 + 128;
                    const u32x4 a0 = *(const u32x4*)p0, a1 = *(const u32x4*)(p0 + 8), b0 = *(const u32x4*)p1, b1 = *(const u32x4*)(p1 + 8);
                    const unsigned aw[8] = {a0.x, a0.y, a0.z, a0.w, a1.x, a1.y, a1.z, a1.w}, bw[8] = {b0.x, b0.y, b0.z, b0.w, b1.x, b1.y, b1.z, b1.w};
                    float v[16]; float s = 0.f;
#pragma unroll
                    for (int i = 0; i < 8; ++i) { v[2 * i] = __uint_as_float(aw[i] << 16) - lam * __uint_as_float(bw[i] << 16); v[2 * i + 1] = __uint_as_float(aw[i] & 0xffff0000u) - lam * __uint_as_float(bw[i] & 0xffff0000u);
                        s += v[2 * i] * v[2 * i] + v[2 * i + 1] * v[2 * i + 1]; }
                    s += __shfl_xor(s, 1); s += __shfl_xor(s, 2); s += __shfl_xor(s, 4);
                    const float r = rsqrtf(s * (1.f / 128.f) + NORM_EPS);
                    u32x4 o0, o1; o0.x = pk2(v[0] * r * gsc[0], v[1] * r * gsc[1]); o0.y = pk2(v[2] * r * gsc[2], v[3] * r * gsc[3]); o0.z = pk2(v[4] * r * gsc[4], v[5] * r * gsc[5]); o0.w = pk2(v[6] * r * gsc[6], v[7] * r * gsc[7]);
                    o1.x = pk2(v[8] * r * gsc[8], v[9] * r * gsc[9]); o1.y = pk2(v[10] * r * gsc[10], v[11] * r * gsc[11]); o1.z = pk2(v[12] * r * gsc[12], v[13] * r * gsc[13]); o1.w = pk2(v[14] * r * gsc[14], v[15] * r * gsc[15]);
                    bf16_t* op = O_DF + (size_t)m * DM + hd * 128 + e0; *(u32x4*)op = o0; *(u32x4*)(op + 8) = o1; }
            } else if (kind == 2) {
                fa::AttnOrder ord{vcu, G}; int bh, qb;
                for (int i = 0; ord.next(i, bh, qb); ++i) { const int b = bh >> 4, h = bh & 15; fa::FlashArgs a;
                    a.Q = QK + ((size_t)b * SEQ + 256 * qb) * 2048 + h * 64; a.ldq = 2048; a.K = QK + (size_t)b * SEQ * 2048 + 1024 + h * 64; a.ldk = 2048;
                    a.Vt = VT + (size_t)(h * 64) * MTOK + (size_t)b * SEQ; a.ldv = MTOK; a.q0 = 256 * qb; a.t_lo = 0; a.t_hi = 4 * qb + 3; a.pa = 1; a.pb = 0; a.window = 1 << 30;
                    a.kbias = KBIAS + (size_t)(b * 16 + h) * SEQ; a.tab = nullptr; a.O = O_DF + ((size_t)b * SEQ + 256 * qb) * DM + h * 64; a.ldo = DM; a.gate = nullptr; a.ldg = 0;
                    FLASH_FOX<64, 1, 0, -1>(lds, a); }
            } else {
                fa::AttnOrder ord{vcu, G}; int bh, qb;
                for (int br = 0; br < 2; ++br)
                    for (int i = 0; ord.next(i, bh, qb); ++i) { const int b = bh >> 4, h = bh & 15, g = h >> 2, q0 = 256 * qb; fa::FlashArgs a; const size_t tok0 = (size_t)b * SEQ + q0;
                        a.Q = QH + tok0 * DM + h * 64; a.ldq = DM; a.q0 = q0; a.tab = TAB + h * 128; a.kbias = nullptr; a.ldo = DM; a.ldg = 48;
                        if (br == 0) { a.K = KCH + (size_t)(b * 4 + g) * 512 * 64; a.ldk = 64; a.Vt = VCT + (size_t)(b * 4 + g) * 64 * 512; a.ldv = 512; a.t_lo = 0; a.t_hi = min(7, (q0 + 224) >> 10); a.pa = 16; a.pb = 31; a.window = 1 << 30;
                            a.O = OC + tok0 * DM + h * 64; a.gate = GATE + tok0 * 48 + h * 3 + 0; }
                        else { a.K = KWb + (size_t)b * SEQ * 256 + g * 64; a.ldk = 256; a.Vt = VTn + (size_t)(256 + g * 64) * MTOK + (size_t)b * SEQ; a.ldv = MTOK; a.t_lo = max(0, q0 - 511) >> 6; a.t_hi = (q0 + 255) >> 6; a.pa = 1; a.pb = 0; a.window = 512;
                            a.O = OW + tok0 * DM + h * 64; a.gate = GATE + tok0 * 48 + h * 3 + 2; }
                        FLASH_NSA<64, 2, 1>(lds, a); }
                for (int u = vcu; u < 2048; u += G) { const int b = u >> 10, g = (u >> 8) & 3, qblk = u & 255; fa::nsa_importance_unit(lds, b, g, qblk, QH, QL, KCH, KCL, TAB, SEL); }
            }
        } break;
        case PK_MIX3: if (PH_ON(PK_MIX3)) { fa::nsa_selected_phase(lds, gw, ngw, QH, KSb, VTn, SEL, TAB, GATE, OC, OW, O_N); } break;
        case PK_OUTPROJ: if (PH_ON(PK_OUTPROJ)) { pg8::EpiAct<0> E{Y, DM}; run_gemm(lds, Omix, WOT, MTOK, DM, DM, E); } break;
        case PK_NORMB: if (PH_ON(PK_NORMB)) { TIDL norm_rows<1>(X, X, Y, ng + DM, ng + 2 * DM, XH, nullptr, gw, ngw, lane); } break;
        case PK_UP: if (PH_ON(PK_UP)) { pg8::EpiAct<1> E{U, DFF}; run_gemm(lds, XH, W1T, MTOK, DFF, DM, E); } break;
        case PK_DOWN: if (PH_ON(PK_DOWN)) { pg8::EpiAct<0> E{Y, DM}; run_gemm(lds, U, W2T, MTOK, DM, DFF, E); } break;
        case PK_NORMC: if (PH_ON(PK_NORMC)) { TIDL norm_rows<2>(X, X, Y, ng + 3 * DM, nullptr, XH, nullptr, gw, ngw, lane);
                        pg8::EpiAct<0> E2{PW, DM}; run_gemm(lds, PB, WPT, MTOK, DM, 256, E2); } break;
        case PK_GATE: if (PH_ON(PK_GATE)) { pg8::EpiGate E{X, PW}; run_gemm(lds, XH, WGT, MTOK, DM, DM, E); } break;
        default: break;
        }
#if REP_PK >= 0
        if (pk == REP_PK && (REP_LAYER < 0 || layer == REP_LAYER) && rep_done == 0) { rep_done = 1; xcd_barrier(xbar); --ph; continue; }
        rep_done = 0;
#endif
        if (ph + 1 < args.ph_hi) {
            if (first_seam) { first_seam = false; __syncthreads(); grid.sync(); }
            else xcd_barrier(xbar);
#if EXTRA_SYNC > 0
            for (int es = 0; es < EXTRA_SYNC; ++es) xcd_barrier(xbar);
#endif
        }
    }
}

extern "C" void kernel_launch(void* const* d_in, const int* in_sizes, int n_in, void* d_out, int out_size, void* d_ws, size_t ws_size, hipStream_t stream) {
    static int grid = 0;
    if (grid == 0) {
        if (n_in != 20 || out_size != MTOK * DM || ws_size < WS_END) { fprintf(stderr, "kernel_launch: unexpected shapes (n_in %d, out %d, ws %zu)\n", n_in, out_size, ws_size); grid = -1; return; }
        int dev = 0, cus = 0, per_cu = 0;
        hipGetDevice(&dev); hipDeviceGetAttribute(&cus, hipDeviceAttributeMultiprocessorCount, dev);
        if (hipFuncSetAttribute((const void*)trunk_fwd, hipFuncAttributeMaxDynamicSharedMemorySize, LDS_BYTES) != hipSuccess) { fprintf(stderr, "kernel_launch: hipFuncSetAttribute failed\n"); grid = -1; return; }
        hipOccupancyMaxActiveBlocksPerMultiprocessor(&per_cu, (const void*)trunk_fwd, NTHREADS, LDS_BYTES);
        (void)hipGetLastError();
        if (per_cu < 1) { fprintf(stderr, "kernel_launch: occupancy query says %d blocks/CU\n", per_cu); per_cu = 1; }
        grid = cus;
    }
    if (grid < 0) return;
    if (hipMemsetAsync((char*)d_ws + WS_CTL, 0, CTL_BYTES, stream) != hipSuccess) { fprintf(stderr, "kernel_launch: memset of the barrier words failed\n"); return; }
    Args a{};
    for (int i = 0; i < 20; ++i) a.in[i] = (const float*)d_in[i];
    a.out = (float*)d_out; a.ws = (unsigned char*)d_ws;
#if ONE_LAUNCH
    a.ph_lo = 0; a.ph_hi = N_PHASES;
    void* kargs[] = {&a};
    hipError_t e = hipLaunchCooperativeKernel((const void*)trunk_fwd, dim3(grid), dim3(NTHREADS), kargs, LDS_BYTES, stream);
    if (e != hipSuccess) fprintf(stderr, "kernel_launch: cooperative launch failed: %s (grid %d)\n", hipGetErrorString(e), grid);
#else
    for (int ph = 0; ph < N_PHASES; ++ph) { a.ph_lo = ph; a.ph_hi = ph + 1; hipLaunchKernelGGL(trunk_fwd, dim3(grid), dim3(NTHREADS), LDS_BYTES, stream, a); }
#endif
}
```

```cpp
#include <hip/hip_runtime.h>
#include <hip/hip_cooperative_groups.h>
#include <cstdio>
#include <cstdint>
namespace cg = cooperative_groups;
#ifndef REP_PK
#define REP_PK -1
#endif
#ifndef REP_LAYER
#define REP_LAYER -1
#endif
#ifndef EXTRA_SYNC
#define EXTRA_SYNC 0
#endif
#ifndef ONE_LAUNCH
#define ONE_LAUNCH 1
#endif
__device__ __forceinline__ int otid() { int t = (int)threadIdx.x; asm volatile("" : "+v"(t)); return t; }
template <class T> __device__ __forceinline__ T* oq(T* p) { asm volatile("" : "+s"(p)); return p; }
__device__ __forceinline__ int oqi(int v) { asm volatile("" : "+s"(v)); return v; }
namespace pg8 {
#define PG8_LAS __attribute__((address_space(3)))
typedef unsigned short bf16_t;
typedef short bf16x8 __attribute__((ext_vector_type(8)));
typedef float f32x4 __attribute__((ext_vector_type(4)));
typedef unsigned u32x4 __attribute__((ext_vector_type(4)));
constexpr int BM = 256, BK = 64, HALF = 128, HTB = HALF * BK * 2  , STAGE_BYTES = 8 * HTB, NXCD = 8, WGM = 8;

__host__ __device__ __forceinline__ int lds_byte(int r, int c) { const int st = (r >> 4) * 2 + (c >> 5), rr = r & 15, cc = c & 31, ob = rr * 64 + cc * 2; return st * 1024 + (ob ^ (((ob >> 9) & 1) << 5)); }
__host__ __device__ __forceinline__ void stage_rc(int b, int& R, int& C) { const int st = b / 1024, sb = b % 1024, swz = sb ^ (((sb >> 9) & 1) << 5); R = (st >> 1) * 16 + swz / 64; C = (st & 1) * 32 + (swz % 64) / 2; }
__host__ __device__ __forceinline__ int perm32(int rho) { const int n = rho >> 4, i = rho & 15; return 8 * (i >> 2) + 4 * n + (i & 3); }

struct Unit { int pm, pn; };
struct Gemm { const bf16_t* A; const bf16_t* Bt; int M, N, K; };

struct StaticOrder {
    int nM, nN, nwg, G, c;
    __host__ __device__ void init(int M, int N, int G_, int c_) { nM = M / BM; nN = N / BM; nwg = nM * nN; G = G_; c = c_; }
    __host__ __device__ bool next(int i, Unit& u) const {
        const long L = (long)i * G + c; if (L >= nwg) return false;
        int wgid = (int)L; { const int q = nwg / NXCD, r = nwg % NXCD, xcd = wgid % NXCD, off = wgid / NXCD; wgid = (xcd < r ? xcd * (q + 1) : r * (q + 1) + (xcd - r) * q) + off; }
        const int nig = WGM * nN, gid = wgid / nig, fm = gid * WGM, gsz = (nM - fm) < WGM ? (nM - fm) : WGM;
        u.pm = fm + ((wgid % nig) % gsz); u.pn = (wgid % nig) / gsz; return true;
    }
    __device__ __forceinline__ void a_ready(const Unit&) const {}
    __device__ __forceinline__ void done(const Unit&) const {}
};

__device__ __forceinline__ unsigned cvt_pk_bf16(float lo, float hi) { unsigned r; asm volatile("v_cvt_pk_bf16_f32 %0, %1, %2" : "=v"(r) : "v"(lo), "v"(hi)); return r; }
typedef float f32x2 __attribute__((ext_vector_type(2)));
template <class Epi, class Sched, bool ALIGN_EPI = false, bool SP2 = false>
__device__ __forceinline__ void gemm_phase(PG8_LAS unsigned char* lds, const Gemm g, const Sched& S, const Epi& E) {
    const int tid = otid(), wid = __builtin_amdgcn_readfirstlane(tid >> 6), lane = tid & 63, wr = wid >> 2, wc = wid & 3, fr = lane & 15, fq = lane >> 4;
    const int K = g.K, nt = K / BK;
    unsigned voffA[2], voffB[2];
#pragma unroll
    for (int i = 0; i < 2; ++i) { int R, C; stage_rc(tid * 16 + i * 8192, R, C); const int Rb = Epi::PERM ? ((R & ~31) + perm32(R & 31)) : R;
        voffA[i] = (unsigned)(R * K + C) * 2u; voffB[i] = (unsigned)(Rb * K + C) * 2u; }
    const size_t kstep = (size_t)(BK * 2);
    const size_t hstep = (size_t)HALF * K * 2;
    const size_t tstep = 2 * hstep;
    const unsigned ldsw = (unsigned)wid * 1024u;
    const int aoff = lds_byte(wr * 64 + fr, fq * 8), boff = lds_byte(wc * 32 + fr, fq * 8);
#define PG8_SA(b, h) (((b) * 2 + (h)) * HTB)
#define PG8_SB(b, h) ((4 + (b) * 2 + (h)) * HTB)
#define PG8_STAGE(bufoff, gbase, voff) do { _Pragma("unroll") for (int _i = 0; _i < 2; ++_i) \
        __builtin_amdgcn_global_load_lds((const unsigned*)((const char*)(gbase) + (voff)[_i]), (PG8_LAS unsigned*)(lds + (bufoff) + ldsw + _i * 8192), 16, 0, 0); } while (0)
#define PG8_LDA(dst, b, h) do { _Pragma("unroll") for (int m = 0; m < 4; ++m) _Pragma("unroll") for (int k = 0; k < 2; ++k) dst[m][k] = *(const PG8_LAS bf16x8*)(lds + PG8_SA(b, h) + aoff + m * 2048 + k * 1024); } while (0)
#define PG8_LDB(dst, b, h) do { _Pragma("unroll") for (int n = 0; n < 2; ++n) _Pragma("unroll") for (int k = 0; k < 2; ++k) dst[n][k] = *(const PG8_LAS bf16x8*)(lds + PG8_SB(b, h) + boff + n * 2048 + k * 1024); } while (0)
#define PG8_MMA(ai, bj, At, Bt) do { __builtin_amdgcn_s_setprio(1); _Pragma("unroll") for (int m = 0; m < 4; ++m) _Pragma("unroll") for (int n = 0; n < 2; ++n) _Pragma("unroll") for (int k = 0; k < 2; ++k) \
        acc[ai][bj][m][n] = __builtin_amdgcn_mfma_f32_16x16x32_bf16(Bt[n][k], At[m][k], acc[ai][bj][m][n], 0, 0, 0); __builtin_amdgcn_s_setprio(0); } while (0)
#define PG8_WAIT_V(n) asm volatile("s_waitcnt vmcnt(" #n ")" ::: "memory")
#define PG8_WAIT_L(n) asm volatile("s_waitcnt lgkmcnt(" #n ")" ::: "memory")
#define PG8_BAR __builtin_amdgcn_s_barrier()
#define PG8_SCHED __builtin_amdgcn_sched_barrier(0)
    Unit cur, nxt; int ui = 0;
    if (!S.next(0, cur)) return;
    f32x4 acc[2][2][4][2];
#pragma unroll
    for (int a = 0; a < 2; ++a)
#pragma unroll
        for (int b = 0; b < 2; ++b)
#pragma unroll
            for (int m = 0; m < 4; ++m)
#pragma unroll
                for (int n = 0; n < 2; ++n) acc[a][b][m][n] = (f32x4){0.f, 0.f, 0.f, 0.f};
    bf16x8 At[4][2], B0[2][2], B1[2][2];
    const char* cA = (const char*)g.A + (size_t)cur.pm * tstep; const char* cB = (const char*)g.Bt + (size_t)cur.pn * tstep;
    S.a_ready(cur);
    if constexpr (SP2) {
        PG8_STAGE(PG8_SB(0, 0), cB, voffB); PG8_STAGE(PG8_SB(0, 1), cB + hstep, voffB); PG8_STAGE(PG8_SA(0, 0), cA, voffA); PG8_STAGE(PG8_SA(0, 1), cA + hstep, voffA);
        if (wr == 1) PG8_BAR;
        PG8_WAIT_V(2); PG8_BAR;
        PG8_STAGE(PG8_SB(1, 0), cB + kstep, voffB); PG8_STAGE(PG8_SA(1, 0), cA + kstep, voffA); PG8_STAGE(PG8_SB(1, 1), cB + hstep + kstep, voffB);
        PG8_WAIT_V(6); PG8_BAR;
    } else {
        PG8_STAGE(PG8_SB(0, 0), cB, voffB); PG8_STAGE(PG8_SA(0, 0), cA, voffA); PG8_STAGE(PG8_SB(0, 1), cB + hstep, voffB); PG8_STAGE(PG8_SA(0, 1), cA + hstep, voffA);
        if (wr == 1) PG8_BAR;
        PG8_WAIT_V(4); PG8_BAR;
        PG8_STAGE(PG8_SB(1, 0), cB + kstep, voffB); PG8_STAGE(PG8_SA(1, 0), cA + kstep, voffA); PG8_STAGE(PG8_SB(1, 1), cB + hstep + kstep, voffB);
        PG8_WAIT_V(6); PG8_BAR;
    }
    for (;;) {
        const bool has_next = S.next(ui + 1, nxt);
        const char* nA = has_next ? (const char*)g.A + (size_t)nxt.pm * tstep : cA; const char* nB = has_next ? (const char*)g.Bt + (size_t)nxt.pn * tstep : cB;
        for (int t = 0; t < nt; t += 2) {
            const bool last = (t == nt - 2);
            const char* a1 = cA + (size_t)(t + 1) * kstep;
            const char* a2 = last ? nA : cA + (size_t)(t + 2) * kstep; const char* b2 = last ? nB : cB + (size_t)(t + 2) * kstep;
            const char* a3 = a2 + kstep; const char* b3 = b2 + kstep;
            if (last && has_next) S.a_ready(nxt);
            if constexpr (SP2) {
            PG8_LDB(B0, 0, 0); PG8_LDB(B1, 0, 1); PG8_SCHED; PG8_LDA(At, 0, 0); PG8_STAGE(PG8_SA(1, 1), a1 + hstep, voffA);
            PG8_WAIT_V(8); PG8_WAIT_L(0); PG8_BAR; PG8_MMA(0, 0, At, B0); PG8_MMA(0, 1, At, B1); PG8_BAR; PG8_SCHED;
            PG8_LDA(At, 0, 1); PG8_STAGE(PG8_SB(0, 0), b2, voffB); PG8_STAGE(PG8_SB(0, 1), b2 + hstep, voffB); PG8_STAGE(PG8_SA(0, 0), a2, voffA);
            PG8_WAIT_V(8); PG8_WAIT_L(0); PG8_BAR; PG8_MMA(1, 0, At, B0); PG8_MMA(1, 1, At, B1); PG8_BAR; PG8_SCHED;
            PG8_LDB(B0, 1, 0); PG8_LDB(B1, 1, 1); PG8_SCHED; PG8_LDA(At, 1, 0); PG8_STAGE(PG8_SA(0, 1), a2 + hstep, voffA);
            PG8_WAIT_V(8); PG8_WAIT_L(0); PG8_BAR; PG8_MMA(0, 0, At, B0); PG8_MMA(0, 1, At, B1); PG8_BAR; PG8_SCHED;
            PG8_LDA(At, 1, 1); PG8_STAGE(PG8_SB(1, 0), b3, voffB); PG8_STAGE(PG8_SB(1, 1), b3 + hstep, voffB); PG8_STAGE(PG8_SA(1, 0), a3, voffA);
            PG8_WAIT_V(8); PG8_WAIT_L(0); PG8_BAR; PG8_MMA(1, 0, At, B0); PG8_MMA(1, 1, At, B1); PG8_BAR; PG8_SCHED;
            } else {
            PG8_LDB(B0, 0, 0); PG8_SCHED; PG8_LDA(At, 0, 0); PG8_STAGE(PG8_SA(1, 1), a1 + hstep, voffA);
            PG8_WAIT_L(8); PG8_BAR; PG8_WAIT_L(0); PG8_MMA(0, 0, At, B0); PG8_BAR; PG8_SCHED;
            PG8_LDB(B1, 0, 1); PG8_STAGE(PG8_SB(0, 0), b2, voffB);
            PG8_BAR; PG8_WAIT_L(0); PG8_MMA(0, 1, At, B1); PG8_BAR;
            PG8_LDA(At, 0, 1); PG8_STAGE(PG8_SA(0, 0), a2, voffA);
            PG8_BAR; PG8_WAIT_L(0); PG8_MMA(1, 0, At, B0); PG8_BAR; PG8_SCHED;
            PG8_STAGE(PG8_SB(0, 1), b2 + hstep, voffB);
            PG8_WAIT_V(6); PG8_BAR; PG8_MMA(1, 1, At, B1); PG8_BAR;
            PG8_LDB(B0, 1, 0); PG8_SCHED; PG8_LDA(At, 1, 0); PG8_STAGE(PG8_SA(0, 1), a2 + hstep, voffA);
            PG8_WAIT_L(8); PG8_BAR; PG8_WAIT_L(0); PG8_MMA(0, 0, At, B0); PG8_BAR; PG8_SCHED;
            PG8_LDB(B1, 1, 1); PG8_STAGE(PG8_SB(1, 0), b3, voffB);
            PG8_BAR; PG8_WAIT_L(0); PG8_MMA(0, 1, At, B1); PG8_BAR;
            PG8_LDA(At, 1, 1); PG8_STAGE(PG8_SA(1, 0), a3, voffA);
            PG8_BAR; PG8_WAIT_L(0); PG8_MMA(1, 0, At, B0); PG8_BAR; PG8_SCHED;
            PG8_STAGE(PG8_SB(1, 1), b3 + hstep, voffB);
            PG8_WAIT_V(6); PG8_BAR; PG8_MMA(1, 1, At, B1); PG8_BAR;
            }
        }
        if constexpr (ALIGN_EPI) { if (wr == 0) PG8_BAR; }
        if constexpr (!Epi::AFTER_DRAIN) { E(acc, cur, wr, wc, fr, fq); S.done(cur); }
        if (!has_next) break;
#pragma unroll
        for (int a = 0; a < 2; ++a)
#pragma unroll
            for (int b = 0; b < 2; ++b)
#pragma unroll
                for (int m = 0; m < 4; ++m)
#pragma unroll
                    for (int n = 0; n < 2; ++n) acc[a][b][m][n] = (f32x4){0.f, 0.f, 0.f, 0.f};
        cur = nxt; cA = nA; cB = nB; ++ui;
        if constexpr (ALIGN_EPI) { if (wr == 1) PG8_BAR; }
    }
    PG8_WAIT_V(0);
    if constexpr (!ALIGN_EPI) { if (wr == 0) PG8_BAR; }
    PG8_BAR;
    if constexpr (Epi::AFTER_DRAIN) { E.fused(acc, cur, wr, wc, fr, fq, lds, wid, lane); S.done(cur); }
#undef PG8_SA
#undef PG8_SB
#undef PG8_STAGE
#undef PG8_LDA
#undef PG8_LDB
#undef PG8_MMA
#undef PG8_WAIT_V
#undef PG8_WAIT_L
#undef PG8_BAR
#undef PG8_SCHED
}
}
namespace pg8 {
typedef unsigned u32x2 __attribute__((ext_vector_type(2)));
__device__ __forceinline__ float bf2f(unsigned short h) { return __uint_as_float(((unsigned)h) << 16); }
__device__ __forceinline__ unsigned short f2bf_rne(float f) { unsigned u = __float_as_uint(f); return (unsigned short)((u + 0x7fffu + ((u >> 16) & 1u)) >> 16); }
__device__ __forceinline__ float sigmoidf_(float v) { return 1.0f / (1.0f + __expf(-v)); }
__device__ __forceinline__ float logsigf_(float z) { return fminf(z, 0.f) - log1pf(__expf(-fabsf(z))); }
__device__ __forceinline__ u32x4 pack8(const f32x4 a, const f32x4 b) { u32x4 w; w.x = cvt_pk_bf16(a[0], a[1]); w.y = cvt_pk_bf16(a[2], a[3]); w.z = cvt_pk_bf16(b[0], b[1]); w.w = cvt_pk_bf16(b[2], b[3]); return w; }
__device__ __forceinline__ void split8(const f32x4 a, const f32x4 b, u32x4& hi, u32x4& lo) {
    hi = pack8(a, b);
    f32x4 ra, rb;
    ra[0] = a[0] - __uint_as_float(hi.x << 16); ra[1] = a[1] - __uint_as_float(hi.x & 0xffff0000u);
    ra[2] = a[2] - __uint_as_float(hi.y << 16); ra[3] = a[3] - __uint_as_float(hi.y & 0xffff0000u);
    rb[0] = b[0] - __uint_as_float(hi.z << 16); rb[1] = b[1] - __uint_as_float(hi.z & 0xffff0000u);
    rb[2] = b[2] - __uint_as_float(hi.w << 16); rb[3] = b[3] - __uint_as_float(hi.w & 0xffff0000u);
    lo = pack8(ra, rb);
}
#define PG8_FOR8(...) \
  _Pragma("unroll") for (int ai = 0; ai < 2; ++ai) _Pragma("unroll") for (int m = 0; m < 4; ++m) { const int lrow = ai * HALF + wr * 64 + m * 16 + fr; \
    _Pragma("unroll") for (int bj = 0; bj < 2; ++bj) { const int lcol = bj * HALF + wc * 32 + 8 * fq; f32x4 v0 = acc[ai][bj][m][0], v1 = acc[ai][bj][m][1]; __VA_ARGS__ } asm volatile("" ::: "memory"); }

struct EpiQK {
    static constexpr bool PERM = true, AFTER_DRAIN = false;
    bf16_t* QK; float* LF; const float* bf; float qscale;
    __device__ __forceinline__ void operator()(const f32x4 (&acc)[2][2][4][2], const Unit& u, int wr, int wc, int fr, int fq) const {
        const int pn = u.pn;
        if (pn < 8) { const float sc = pn < 4 ? qscale : 1.f;
            PG8_FOR8({ const unsigned row = (unsigned)u.pm * BM + lrow; *(u32x4*)(QK + row * 2048 + pn * 256 + lcol) = pack8(v0 * sc, v1 * sc); })
        } else {
            PG8_FOR8({ if (lcol < 16) { const unsigned row = (unsigned)u.pm * BM + lrow; f32x4 o0, o1;
                _Pragma("unroll") for (int i = 0; i < 4; ++i) { o0[i] = logsigf_(v0[i] + bf[lcol + i]); o1[i] = logsigf_(v1[i] + bf[lcol + 4 + i]); }
                *(f32x4*)(LF + row * 16 + lcol) = o0; *(f32x4*)(LF + row * 16 + lcol + 4) = o1; } })
        }
    }
};
struct EpiVt {
    static constexpr bool PERM = false, AFTER_DRAIN = false;
    bf16_t* VT; int ld; int vf_rows;
    __device__ __forceinline__ void operator()(const f32x4 (&acc)[2][2][4][2], const Unit& u, int wr, int wc, int fr, int fq) const {
#pragma unroll
        for (int ai = 0; ai < 2; ++ai)
#pragma unroll
            for (int m = 0; m < 4; ++m) { const unsigned row = (unsigned)u.pm * BM + ai * HALF + wr * 64 + m * 16 + fr;
#pragma unroll
                for (int bj = 0; bj < 2; ++bj)
#pragma unroll
                    for (int n = 0; n < 2; ++n) { const unsigned tok0 = u.pn * BM + bj * HALF + wc * 32 + 16 * n; const f32x4 v = acc[ai][bj][m][n];
                        u32x2 w; w.x = cvt_pk_bf16(v[0], v[1]); w.y = cvt_pk_bf16(v[2], v[3]);
                        if ((int)row < vf_rows) { const unsigned g = row >> 6, d = row & 63, db = d >> 5, r = d & 31, b = tok0 >> 13, s0 = tok0 & 8191, blk = s0 >> 6, ks = (s0 >> 4) & 3;
                            *(u32x2*)(VT + (((((b * 4 + g) * 128 + blk) * 2 + db) * 4 + ks) * 512 + ((fq & 1) * 32 + r) * 8 + 4 * (fq >> 1))) = w; }
                        else *(u32x2*)(VT + row * ld + tok0 + 8 * (fq & 1) + 4 * (fq >> 1)) = w; } }
    }
};
struct EpiF32 {
    static constexpr bool PERM = true, AFTER_DRAIN = false;
    float* Y; int ld;
    __device__ __forceinline__ void operator()(const f32x4 (&acc)[2][2][4][2], const Unit& u, int wr, int wc, int fr, int fq) const {
        PG8_FOR8({ float* p = Y + (unsigned)(((unsigned)u.pm * BM + lrow) * ld + u.pn * BM + lcol); *(f32x4*)p = v0; *(f32x4*)(p + 4) = v1; })
    }
};
template <int ACT  > struct EpiAct {
    static constexpr bool PERM = true, AFTER_DRAIN = false;
    bf16_t* O; int ld;
    __device__ __forceinline__ void operator()(const f32x4 (&acc)[2][2][4][2], const Unit& u, int wr, int wc, int fr, int fq) const {
        PG8_FOR8({ if (ACT == 1) { _Pragma("unroll") for (int i = 0; i < 4; ++i) { const float a = fmaxf(v0[i], 0.f), b = fmaxf(v1[i], 0.f); v0[i] = a * a; v1[i] = b * b; } }
            *(u32x4*)(O + (unsigned)(((unsigned)u.pm * BM + lrow) * ld + u.pn * BM + lcol)) = pack8(v0, v1); })
    }
};
struct EpiGate {
    static constexpr bool PERM = true, AFTER_DRAIN = false;
    float* X; const bf16_t* PW;
    __device__ __forceinline__ void operator()(const f32x4 (&acc)[2][2][4][2], const Unit& u, int wr, int wc, int fr, int fq) const {
        PG8_FOR8({ const unsigned off = ((unsigned)u.pm * BM + lrow) * 1024 + u.pn * BM + lcol; float* xp = X + off;
            const u32x4 pw = *(const u32x4*)(PW + off); f32x4 x0 = *(const f32x4*)xp, x1 = *(const f32x4*)(xp + 4);
            x0[0] += sigmoidf_(v0[0]) * __uint_as_float(pw.x << 16); x0[1] += sigmoidf_(v0[1]) * __uint_as_float(pw.x & 0xffff0000u);
            x0[2] += sigmoidf_(v0[2]) * __uint_as_float(pw.y << 16); x0[3] += sigmoidf_(v0[3]) * __uint_as_float(pw.y & 0xffff0000u);
            x1[0] += sigmoidf_(v1[0]) * __uint_as_float(pw.z << 16); x1[1] += sigmoidf_(v1[1]) * __uint_as_float(pw.z & 0xffff0000u);
            x1[2] += sigmoidf_(v1[2]) * __uint_as_float(pw.w << 16); x1[3] += sigmoidf_(v1[3]) * __uint_as_float(pw.w & 0xffff0000u);
            *(f32x4*)xp = x0; *(f32x4*)(xp + 4) = x1; })
    }
};
struct EpiNsaA {
    static constexpr bool PERM = true, AFTER_DRAIN = false;
    bf16_t *QH, *QL, *KH, *KL; float qscale;
    __device__ __forceinline__ void operator()(const f32x4 (&acc)[2][2][4][2], const Unit& u, int wr, int wc, int fr, int fq) const {
        const int pn = u.pn;
        PG8_FOR8({ const unsigned row = (unsigned)u.pm * BM + lrow; u32x4 h, l;
            if (pn < 4) { split8(v0 * qscale, v1 * qscale, h, l); const unsigned off = row * 1024 + pn * 256 + lcol; *(u32x4*)(QH + off) = h; *(u32x4*)(QL + off) = l; }
            else { split8(v0, v1, h, l); const unsigned b = row >> 13, s = row & 8191; const int g = lcol >> 6, d = lcol & 63;
                const unsigned off = ((b * 4 + g) * 8192 + s) * 64 + d; *(u32x4*)(KH + off) = h; *(u32x4*)(KL + off) = l; } })
    }
};
struct EpiNsaB {
    static constexpr bool PERM = true, AFTER_DRAIN = false;
    bf16_t *VC, *KS, *KW; float* GATE;
    __device__ __forceinline__ void operator()(const f32x4 (&acc)[2][2][4][2], const Unit& u, int wr, int wc, int fr, int fq) const {
        const int pn = u.pn;
        PG8_FOR8({ const unsigned row = (unsigned)u.pm * BM + lrow;
            if (pn == 0) { const unsigned b = row >> 13, s = row & 8191; const int g = lcol >> 6, d = lcol & 63; *(u32x4*)(VC + ((b * 4 + g) * 8192 + s) * 64 + d) = pack8(v0, v1); }
            else if (pn == 1) { const unsigned b = row >> 13, s = row & 8191; const unsigned g = lcol >> 6, d = lcol & 63;
                *(u32x4*)(KS + (((((b * 4 + g) * 128 + (s >> 6)) * 2 + ((s >> 5) & 1)) * 4 + (d >> 4)) * 512 + ((((d >> 3) & 1) * 32 + (s & 31)) * 8))) = pack8(v0, v1); }
            else if (pn == 2) { *(u32x4*)(KW + row * 256 + lcol) = pack8(v0, v1); }
            else if (lcol < 48) { f32x4 o0, o1; _Pragma("unroll") for (int i = 0; i < 4; ++i) { o0[i] = sigmoidf_(v0[i]); o1[i] = sigmoidf_(v1[i]); }
                *(f32x4*)(GATE + row * 48 + lcol) = o0; *(f32x4*)(GATE + row * 48 + lcol + 4) = o1; } })
    }
};
}
namespace fa {
using pg8::bf16_t; using pg8::bf16x8; using pg8::f32x4; using pg8::u32x4; using pg8::u32x2;
typedef float f32x16 __attribute__((ext_vector_type(16)));
#define LAS __attribute__((address_space(3)))
constexpr int ROWB = 144;
constexpr int L_STASH = 57344;
constexpr int L_K0 = 0, L_K1 = 9216, L_V0 = 18432, L_V1 = 36864, L_B0 = 55296, L_B1 = 55552, L_TAB = 55808, L_END = 56320;
constexpr float NEGV = -1e30f;
__device__ __forceinline__ int crow(int r, int hi) { return (r & 3) + 8 * (r >> 2) + 4 * hi; }
__device__ __forceinline__ float ex2(float v) { return __builtin_amdgcn_exp2f(v); }
__device__ __forceinline__ bf16x8 packp(const f32x16& p, int s) {
    u32x4 w; w.x = pg8::cvt_pk_bf16(p[8 * s + 0], p[8 * s + 1]); w.y = pg8::cvt_pk_bf16(p[8 * s + 2], p[8 * s + 3]);
    w.z = pg8::cvt_pk_bf16(p[8 * s + 4], p[8 * s + 5]); w.w = pg8::cvt_pk_bf16(p[8 * s + 6], p[8 * s + 7]); return __builtin_bit_cast(bf16x8, w);
}
struct FlashArgs {
    const bf16_t* Q; int ldq;
    const bf16_t* K; int ldk;
    const bf16_t* Vt; int ldv;
    int q0, t_lo, t_hi, pa, pb, window;
    const float* kbias;
    const float* tab;
    bf16_t* O; int ldo;
    const float* gate; int ldg;
    float lam, oscale; const float* sg;
};
__device__ __forceinline__ float xhalf_max(float m) { auto rr = __builtin_amdgcn_permlane32_swap(__float_as_uint(m), __float_as_uint(m), false, false); return fmaxf(__uint_as_float(rr[0]), __uint_as_float(rr[1])); }
#define FA_GK(t) do { kreg = *(const u32x4*)(a.K + (size_t)(64 * (t) + srow) * a.ldk + sch * 8); } while (0)
#define FA_GV(t) do { _Pragma("unroll") for (int i_ = 0; i_ < NVB; ++i_) vreg[i_] = *(const u32x4*)(a.Vt + (size_t)(srow + 64 * i_) * a.ldv + 64 * (t) + sch * 8); \
    if (BIAS == 1) { if (tid < 16) breg = *(const f32x4*)(a.kbias + 64 * (t) + 4 * tid); } } while (0)
#define FA_SK(b_) do { *(LAS u32x4*)(lds + ((b_) ? L_K1 : L_K0) + srow * ROWB + sch * 16) = kreg; } while (0)
#define FA_SV(b_) do { _Pragma("unroll") for (int i_ = 0; i_ < NVB; ++i_) *(LAS u32x4*)(lds + ((b_) ? L_V1 : L_V0) + (srow + 64 * i_) * ROWB + sch * 16) = vreg[i_]; \
    if (BIAS == 1) { if (tid < 16) *(LAS f32x4*)(lds + ((b_) ? L_B1 : L_B0) + 16 * tid) = breg; } } while (0)
template <int DV, int BIAS, bool MAIN, int DIR>
__device__ __forceinline__ void fa_iter(LAS unsigned char* lds, const FlashArgs& a, const int t, const int tid, const int srow, const int sch, const int r32, const int hi, const int qw0, const int qpos,
                                        const bf16x8 (&qf)[4], f32x16 (&o)[DV / 32], f32x16& c0, f32x16& c1, float& m_run, float& l_run, bool& cur_needed, u32x4& kreg, u32x4 (&vreg)[DV / 64], f32x4& breg) {
    constexpr int NVB = DV / 64, NDB = DV / 32;
    const LAS float* tabL = (const LAS float*)(lds + L_TAB);
    const int t1 = t + DIR, t2 = t + 2 * DIR;
    const bool hk = MAIN || (t2 >= a.t_lo && t2 <= a.t_hi), hv = MAIN || (t1 >= a.t_lo && t1 <= a.t_hi);
    if (hk) FA_GK(t2);
    if (hv) FA_GV(t1);
    bool nn = MAIN;
    if (!MAIN) { if (hv) { const int minp = a.pa * (64 * t1) + a.pb, maxp = minp + a.pa * 63; nn = (minp <= qw0 + 31) && (maxp > qw0 - a.window); } }
    const bool cn = MAIN || cur_needed;
    bool skip_b2 = false;
    if (cn) {
        if (BIAS == 1) {
            const LAS unsigned char* bb = lds + ((t & 1) ? L_B1 : L_B0);
#pragma unroll
            for (int g = 0; g < 4; ++g) { const f32x4 b0 = *(const LAS f32x4*)(bb + (8 * g + 4 * hi) * 4), b1 = *(const LAS f32x4*)(bb + (32 + 8 * g + 4 * hi) * 4);
#pragma unroll
                for (int i = 0; i < 4; ++i) { c0[4 * g + i] += b0[i]; c1[4 * g + i] += b1[i]; } }
        }
        if (!MAIN) {
            const int minpos = a.pa * (64 * t) + a.pb, maxpos = minpos + a.pa * 63;
            const bool full = (maxpos <= qw0) && (minpos > qw0 + 31 - a.window);
            const bool nearb = (BIAS == 2) && (maxpos >= qw0 - 127);
            if (!full || nearb) {
#pragma unroll
                for (int r = 0; r < 16; ++r) { const int kv = crow(r, hi); const int d0_ = qpos - (minpos + a.pa * kv), d1_ = d0_ - 32 * a.pa;
                    if (BIAS == 2) { c0[r] += tabL[min(max(d0_, 0), 127)]; c1[r] += tabL[min(max(d1_, 0), 127)]; }
                    if (d0_ < 0 || d0_ >= a.window) c0[r] = NEGV;
                    if (d1_ < 0 || d1_ >= a.window) c1[r] = NEGV; }
            }
        }
        float mx = fmaxf(c0[0], c1[0]);
#pragma unroll
        for (int r = 1; r < 16; ++r) mx = fmaxf(mx, fmaxf(c0[r], c1[r]));
        mx = xhalf_max(mx);
        const bool real = m_run > -1e29f, seen = mx > -1e29f;
        if (DIR < 0) skip_b2 = !__any(!real || mx > -150.f);
        if (__any(real ? (mx > 8.f) : seen)) {
            const float dl = real ? fmaxf(mx, 0.f) : (seen ? mx : 0.f);
            const float al = real ? ex2(-dl) : 0.f;
            m_run = real ? (m_run + dl) : (seen ? mx : m_run);
            l_run *= al;
#pragma unroll
            for (int r = 0; r < 16; ++r) { c0[r] -= dl; c1[r] -= dl; }
#pragma unroll
            for (int i = 0; i < NDB; ++i)
#pragma unroll
                for (int r = 0; r < 16; ++r) o[i][r] *= al;
        }
    }
    f32x16 n0, n1;
    if (nn) {
        const float refn = (m_run > -1e29f) ? m_run : 0.f;
        const LAS unsigned char* kb = lds + (((t + 1) & 1) ? L_K1 : L_K0);
#pragma unroll
        for (int r = 0; r < 16; ++r) { n0[r] = -refn; n1[r] = -refn; }
        bf16x8 kf0[4], kf1[4];
#pragma unroll
        for (int d0 = 0; d0 < 4; ++d0) { kf0[d0] = *(const LAS bf16x8*)(kb + r32 * ROWB + (2 * d0 + hi) * 16); kf1[d0] = *(const LAS bf16x8*)(kb + (32 + r32) * ROWB + (2 * d0 + hi) * 16); }
        __builtin_amdgcn_sched_barrier(0);
#pragma unroll
        for (int d0 = 0; d0 < 4; ++d0) {
            n0 = __builtin_amdgcn_mfma_f32_32x32x16_bf16(kf0[d0], qf[d0], n0, 0, 0, 0);
            n1 = __builtin_amdgcn_mfma_f32_32x32x16_bf16(kf1[d0], qf[d0], n1, 0, 0, 0);
        }
    }
    if (cn && !skip_b2) {
        const LAS unsigned char* vb = lds + ((t & 1) ? L_V1 : L_V0);
        float rs = 0.f;
#pragma unroll
        for (int r = 0; r < 16; ++r) { c0[r] = ex2(c0[r]); c1[r] = ex2(c1[r]); rs += c0[r] + c1[r]; }
        l_run += rs;
        bf16x8 pf[4]; pf[0] = packp(c0, 0); pf[1] = packp(c0, 1); pf[2] = packp(c1, 0); pf[3] = packp(c1, 1);
#pragma unroll
        for (int dh = 0; dh < NDB / 2; ++dh) {
            bf16x8 vf[8];
#pragma unroll
            for (int i = 0; i < 8; ++i) vf[i] = *(const LAS bf16x8*)(vb + (32 * (2 * dh + (i >> 2)) + r32) * ROWB + (2 * (i & 3) + hi) * 16);
            __builtin_amdgcn_sched_barrier(0);
    #pragma unroll
            for (int i = 0; i < 8; ++i) o[2 * dh + (i >> 2)] = __builtin_amdgcn_mfma_f32_32x32x16_bf16(vf[i], pf[i & 3], o[2 * dh + (i >> 2)], 0, 0, 0);
                __builtin_amdgcn_sched_barrier(0);
        }
    }
    if (hk) FA_SK(t & 1);
    if (hv) FA_SV((t + 1) & 1);
    __syncthreads();
    if (nn) { c0 = n0; c1 = n1; }
    cur_needed = nn;
}
template <int DV, int BIAS, int OUT, int DIR = 1>
__device__ __forceinline__ void flash_unit_reg(LAS unsigned char* lds, const FlashArgs& a) {
    const int tid = otid(), lane = tid & 63, wid = __builtin_amdgcn_readfirstlane(tid >> 6), r32 = lane & 31, hi = lane >> 5;
    const int srow = tid >> 3, sch = tid & 7;
    constexpr int NVB = DV / 64, NDB = DV / 32;
    u32x4 kreg, vreg[NVB]; f32x4 breg = (f32x4){0.f, 0.f, 0.f, 0.f};
    const int tfirst = (DIR > 0) ? a.t_lo : a.t_hi;
    FA_GK(tfirst);
    if (BIAS == 2) { if (tid < 128) *(LAS float*)(lds + L_TAB + 4 * tid) = a.tab[tid]; }
    bf16x8 qf[4];
#pragma unroll
    for (int d0 = 0; d0 < 4; ++d0) qf[d0] = *(const bf16x8*)(a.Q + (size_t)(32 * wid + r32) * a.ldq + 16 * d0 + 8 * hi);
    FA_SK(tfirst & 1);
    __syncthreads();
    const int qw0 = a.q0 + 32 * wid, qpos = qw0 + r32;
    float m_run = NEGV, l_run = 0.f;
    f32x16 o[NDB], c0, c1;
#pragma unroll
    for (int i = 0; i < NDB; ++i)
#pragma unroll
        for (int r = 0; r < 16; ++r) o[i][r] = 0.f;
#pragma unroll
    for (int r = 0; r < 16; ++r) { c0[r] = 0.f; c1[r] = 0.f; }
    bool cur_needed = false;
    int tm0, tm1;
    { const int lim = (BIAS == 2) ? (a.q0 - 128) : a.q0;
      const int num = lim - a.pb - 63 * a.pa;
      int tl = (num >= 0) ? (num / (64 * a.pa)) - 1 : -1;
      tl = min(tl, a.t_hi - 2);
      int tf = a.t_lo;
      if (a.window < (1 << 29)) { const int x = a.q0 + 255 - a.window - a.pb; if (x >= 0) tf = max(tf, x / (64 * a.pa) + 1); }
      tm0 = tf + 1; tm1 = tl + 1;
      if (tm1 < tm0) { tm0 = a.t_hi + 1; tm1 = tm0; } }
    if (DIR > 0) {
        int t = a.t_lo - 1;
        for (; t < tm0 && t <= a.t_hi; ++t) fa_iter<DV, BIAS, false, 1>(lds, a, t, tid, srow, sch, r32, hi, qw0, qpos, qf, o, c0, c1, m_run, l_run, cur_needed, kreg, vreg, breg);
        for (; t < tm1; ++t) fa_iter<DV, BIAS, true, 1>(lds, a, t, tid, srow, sch, r32, hi, qw0, qpos, qf, o, c0, c1, m_run, l_run, cur_needed, kreg, vreg, breg);
        for (; t <= a.t_hi; ++t) fa_iter<DV, BIAS, false, 1>(lds, a, t, tid, srow, sch, r32, hi, qw0, qpos, qf, o, c0, c1, m_run, l_run, cur_needed, kreg, vreg, breg);
    } else {
        const int tfull = (a.q0 - a.pb - 63 * a.pa >= 0) ? (a.q0 - a.pb - 63 * a.pa) / (64 * a.pa) : -1;
        int t = a.t_hi + 1;
        for (; t > tfull && t >= a.t_lo; --t) fa_iter<DV, BIAS, false, -1>(lds, a, t, tid, srow, sch, r32, hi, qw0, qpos, qf, o, c0, c1, m_run, l_run, cur_needed, kreg, vreg, breg);
        for (; t >= a.t_lo + 2; --t) fa_iter<DV, BIAS, true, -1>(lds, a, t, tid, srow, sch, r32, hi, qw0, qpos, qf, o, c0, c1, m_run, l_run, cur_needed, kreg, vreg, breg);
        for (; t >= a.t_lo; --t) fa_iter<DV, BIAS, false, -1>(lds, a, t, tid, srow, sch, r32, hi, qw0, qpos, qf, o, c0, c1, m_run, l_run, cur_needed, kreg, vreg, breg);
    }
    const float l_tot = l_run + __shfl_xor(l_run, 32);
    float inv = (m_run > -1e29f) ? 1.0f / l_tot : 0.f;
    if (OUT == 1) inv *= a.gate[(size_t)(32 * wid + r32) * a.ldg];
    if (OUT == 2) {
        LAS unsigned char* st = lds + L_STASH + (32 * wid + r32) * (DV * 2);
#pragma unroll
        for (int db = 0; db < NDB; ++db)
#pragma unroll
            for (int g = 0; g < 4; ++g) { u32x2 w; w.x = pg8::cvt_pk_bf16(o[db][4 * g] * inv, o[db][4 * g + 1] * inv); w.y = pg8::cvt_pk_bf16(o[db][4 * g + 2] * inv, o[db][4 * g + 3] * inv);
                *(LAS u32x2*)(st + (32 * db + 8 * g + 4 * hi) * 2) = w; }
    } else if (OUT == 3) {
        const LAS unsigned char* st = lds + L_STASH + (32 * wid + r32) * (DV * 2);
        float ss = 0.f;
#pragma unroll
        for (int db = 0; db < NDB; ++db)
#pragma unroll
            for (int g = 0; g < 4; ++g) { const u32x2 s0 = *(const LAS u32x2*)(st + (32 * db + 8 * g + 4 * hi) * 2);
                const float a0 = __uint_as_float(s0.x << 16), a1 = __uint_as_float(s0.x & 0xffff0000u), a2 = __uint_as_float(s0.y << 16), a3 = __uint_as_float(s0.y & 0xffff0000u);
                o[db][4 * g] = a0 - a.lam * (o[db][4 * g] * inv); o[db][4 * g + 1] = a1 - a.lam * (o[db][4 * g + 1] * inv); o[db][4 * g + 2] = a2 - a.lam * (o[db][4 * g + 2] * inv); o[db][4 * g + 3] = a3 - a.lam * (o[db][4 * g + 3] * inv);
                ss += (o[db][4 * g] * o[db][4 * g] + o[db][4 * g + 1] * o[db][4 * g + 1]) + (o[db][4 * g + 2] * o[db][4 * g + 2] + o[db][4 * g + 3] * o[db][4 * g + 3]); }
        { auto rr = __builtin_amdgcn_permlane32_swap(__float_as_uint(ss), __float_as_uint(ss), false, false); ss = __uint_as_float(rr[0]) + __uint_as_float(rr[1]); }
        const float rn = rsqrtf(ss * (1.0f / DV) + 1e-6f) * a.oscale;
        bf16_t* orow = a.O + (size_t)(32 * wid + r32) * a.ldo;
#pragma unroll
        for (int db = 0; db < NDB; ++db)
#pragma unroll
            for (int g = 0; g < 4; ++g) { const f32x4 gg = *(const f32x4*)(a.sg + 32 * db + 8 * g + 4 * hi);
                u32x2 w; w.x = pg8::cvt_pk_bf16(o[db][4 * g] * rn * gg[0], o[db][4 * g + 1] * rn * gg[1]); w.y = pg8::cvt_pk_bf16(o[db][4 * g + 2] * rn * gg[2], o[db][4 * g + 3] * rn * gg[3]);
                *(u32x2*)(orow + 32 * db + 8 * g + 4 * hi) = w; }
    } else {
        bf16_t* orow = a.O + (size_t)(32 * wid + r32) * a.ldo;
#pragma unroll
        for (int db = 0; db < NDB; ++db)
#pragma unroll
            for (int g = 0; g < 4; ++g) { u32x2 w; w.x = pg8::cvt_pk_bf16(o[db][4 * g] * inv, o[db][4 * g + 1] * inv); w.y = pg8::cvt_pk_bf16(o[db][4 * g + 2] * inv, o[db][4 * g + 3] * inv);
                *(u32x2*)(orow + 32 * db + 8 * g + 4 * hi) = w; }
    }
}
#undef FA_GK
#undef FA_GV
#undef FA_SK
#undef FA_SV
__device__ __forceinline__ void glds16(const void* gsrc, unsigned lds_dst) { unsigned keep;
    asm volatile("s_mov_b32 %0, m0\n\ts_mov_b32 m0, %2\n\ts_nop 0\n\tglobal_load_lds_dwordx4 %1, off\n\ts_mov_b32 m0, %0" : "=&s"(keep) : "v"(gsrc), "s"(lds_dst) : "memory"); }
__device__ __forceinline__ void glds4(const void* gsrc, unsigned lds_dst) { unsigned keep;
    asm volatile("s_mov_b32 %0, m0\n\ts_mov_b32 m0, %2\n\ts_nop 0\n\tglobal_load_lds_dword %1, off\n\ts_mov_b32 m0, %0" : "=&s"(keep) : "v"(gsrc), "s"(lds_dst) : "memory"); }
constexpr int D_K = 0, D_V = 32768, D_B = 32768 + 4 * 16384, D_TAB = D_B + 4 * 256, D_END = D_TAB + 512;
template <int DV, int BIAS, int OUT>
__device__ __forceinline__ void flash_unit(LAS unsigned char* lds, const FlashArgs& a) {
    const int tid = otid(), lane = tid & 63, wid = __builtin_amdgcn_readfirstlane(tid >> 6), r32 = lane & 31, hi = lane >> 5;
    constexpr int NVB = DV / 64, NDB = DV / 32, VSLOT = DV * 128, NP = 1 + NVB + (BIAS == 1 ? 1 : 0);
    static_assert(NP == 2 || NP == 3, "counted waits are written for 2 or 3 DMA pieces per wave and tile");
    const int drow = lane >> 3, dchunk = (lane & 7) ^ (((8 * wid + drow) >> 1) & 7);
    const bf16_t* ksrc = a.K + (size_t)(8 * wid + drow) * a.ldk + dchunk * 8;
    const bf16_t* vsrc = a.Vt + (size_t)(8 * wid + drow) * a.ldv + dchunk * 8;
    const unsigned lds0 = (unsigned)(__UINTPTR_TYPE__)lds;
#define FA_ISSUE(t_, s_) do { const unsigned so_ = (unsigned)__builtin_amdgcn_readfirstlane(s_); \
        glds16(ksrc + (size_t)(64 * (t_)) * a.ldk, (unsigned)__builtin_amdgcn_readfirstlane((int)(lds0 + D_K + so_ * 8192 + wid * 1024))); \
        _Pragma("unroll") for (int i_ = 0; i_ < NVB; ++i_) glds16(vsrc + (size_t)(64 * i_) * a.ldv + 64 * (t_), (unsigned)__builtin_amdgcn_readfirstlane((int)(lds0 + D_V + so_ * VSLOT + (wid + 8 * i_) * 1024))); \
        if (BIAS == 1) glds4(a.kbias + 64 * (t_) + lane, (unsigned)__builtin_amdgcn_readfirstlane((int)(lds0 + D_B + so_ * 256))); } while (0)
    int s_cur = 0;
    FA_ISSUE(a.t_lo, 0);
    if (a.t_lo + 1 <= a.t_hi) FA_ISSUE(a.t_lo + 1, 1);
    if (a.t_lo + 2 <= a.t_hi) FA_ISSUE(a.t_lo + 2, 2);
    if (BIAS == 2) { if (tid < 128) *(LAS float*)(lds + D_TAB + 4 * tid) = a.tab[tid]; }
    bf16x8 qf[4];
#pragma unroll
    for (int d0 = 0; d0 < 4; ++d0) qf[d0] = *(const bf16x8*)(a.Q + (size_t)(32 * wid + r32) * a.ldq + 16 * d0 + 8 * hi);
    asm volatile("" : "+v"(qf[0]), "+v"(qf[1]), "+v"(qf[2]), "+v"(qf[3]));
    asm volatile("s_waitcnt vmcnt(0) lgkmcnt(0)" ::: "memory");
    __builtin_amdgcn_s_barrier();
    asm volatile("" ::: "memory");
    const int qw0 = a.q0 + 32 * wid, qpos = qw0 + r32;
    float m_run = NEGV, l_run = 0.f;
    f32x16 o[NDB];
#pragma unroll
    for (int i = 0; i < NDB; ++i)
#pragma unroll
        for (int r = 0; r < 16; ++r) o[i][r] = 0.f;
    const LAS float* tabL = (const LAS float*)(lds + D_TAB);
    const int sw0 = ((r32 >> 1) & 7), sw1 = (((32 + r32) >> 1) & 7);
    for (int t = a.t_lo; t <= a.t_hi; ++t) {
        if (t + 2 <= a.t_hi) { if (NP == 3) asm volatile("s_waitcnt vmcnt(3)" ::: "memory"); else asm volatile("s_waitcnt vmcnt(2)" ::: "memory"); }
        else asm volatile("s_waitcnt vmcnt(0)" ::: "memory");
        asm volatile("s_waitcnt lgkmcnt(0)" ::: "memory");
        __builtin_amdgcn_s_barrier();
        asm volatile("" ::: "memory");
        const int s_nn = (s_cur + 3) & 3;
        if (t + 3 <= a.t_hi) FA_ISSUE(t + 3, s_nn);
        const int minpos = a.pa * (64 * t) + a.pb, maxpos = minpos + a.pa * 63;
        const bool needed = (minpos <= qw0 + 31) && (maxpos > qw0 - a.window);
        if (needed) {
            const LAS unsigned char* kb = lds + D_K + s_cur * 8192; const LAS unsigned char* vb = lds + D_V + s_cur * VSLOT;
            f32x16 p0, p1;
#pragma unroll
            for (int r = 0; r < 16; ++r) { p0[r] = 0.f; p1[r] = 0.f; }
#pragma unroll
            for (int d0 = 0; d0 < 4; ++d0) {
                const bf16x8 k0 = *(const LAS bf16x8*)(kb + r32 * 128 + (((2 * d0 + hi) ^ sw0) * 16));
                const bf16x8 k1 = *(const LAS bf16x8*)(kb + (32 + r32) * 128 + (((2 * d0 + hi) ^ sw1) * 16));
                p0 = __builtin_amdgcn_mfma_f32_32x32x16_bf16(k0, qf[d0], p0, 0, 0, 0);
                p1 = __builtin_amdgcn_mfma_f32_32x32x16_bf16(k1, qf[d0], p1, 0, 0, 0);
            }
            if (BIAS == 1) {
                const LAS unsigned char* bb = lds + D_B + s_cur * 256;
#pragma unroll
                for (int g = 0; g < 4; ++g) { const f32x4 b0 = *(const LAS f32x4*)(bb + (8 * g + 4 * hi) * 4), b1 = *(const LAS f32x4*)(bb + (32 + 8 * g + 4 * hi) * 4);
#pragma unroll
                    for (int i = 0; i < 4; ++i) { p0[4 * g + i] += b0[i]; p1[4 * g + i] += b1[i]; } }
            }
            const bool full = (maxpos <= qw0) && (minpos > qw0 + 31 - a.window);
            const bool nearb = (BIAS == 2) && (maxpos >= qw0 - 127);
            if (!full || nearb) {
#pragma unroll
                for (int r = 0; r < 16; ++r) { const int kv = crow(r, hi); const int d0_ = qpos - (minpos + a.pa * kv), d1_ = d0_ - 32 * a.pa;
                    if (BIAS == 2) { p0[r] += tabL[min(max(d0_, 0), 127)]; p1[r] += tabL[min(max(d1_, 0), 127)]; }
                    if (d0_ < 0 || d0_ >= a.window) p0[r] = NEGV;
                    if (d1_ < 0 || d1_ >= a.window) p1[r] = NEGV; }
            }
            float mx = fmaxf(p0[0], p1[0]);
#pragma unroll
            for (int r = 1; r < 16; ++r) mx = fmaxf(mx, fmaxf(p0[r], p1[r]));
            mx = xhalf_max(mx);
            if (__any(mx > m_run + 8.f)) {
                const float mn = fmaxf(m_run, mx), al = ex2(m_run - mn); l_run *= al; m_run = mn;
#pragma unroll
                for (int i = 0; i < NDB; ++i)
#pragma unroll
                    for (int r = 0; r < 16; ++r) o[i][r] *= al;
            }
            float rs = 0.f;
#pragma unroll
            for (int r = 0; r < 16; ++r) { p0[r] = ex2(p0[r] - m_run); p1[r] = ex2(p1[r] - m_run); rs += p0[r] + p1[r]; }
            l_run += rs;
            bf16x8 pf[4]; pf[0] = packp(p0, 0); pf[1] = packp(p0, 1); pf[2] = packp(p1, 0); pf[3] = packp(p1, 1);
#pragma unroll
            for (int db = 0; db < NDB; ++db)
#pragma unroll
                for (int ks = 0; ks < 4; ++ks) { const bf16x8 vf = *(const LAS bf16x8*)(vb + (32 * db + r32) * 128 + (((2 * ks + hi) ^ sw0) * 16));
                    o[db] = __builtin_amdgcn_mfma_f32_32x32x16_bf16(vf, pf[ks], o[db], 0, 0, 0); }
        }
        s_cur = (s_cur + 1) & 3;
    }
    const float l_tot = l_run + __shfl_xor(l_run, 32);
    float inv = (m_run > -1e29f) ? 1.0f / l_tot : 0.f;
    if (OUT == 1) inv *= a.gate[(size_t)(32 * wid + r32) * a.ldg];
    bf16_t* orow = a.O + (size_t)(32 * wid + r32) * a.ldo;
#pragma unroll
    for (int db = 0; db < NDB; ++db)
#pragma unroll
        for (int g = 0; g < 4; ++g) { u32x2 w; w.x = pg8::cvt_pk_bf16(o[db][4 * g] * inv, o[db][4 * g + 1] * inv); w.y = pg8::cvt_pk_bf16(o[db][4 * g + 2] * inv, o[db][4 * g + 3] * inv);
            *(u32x2*)(orow + 32 * db + 8 * g + 4 * hi) = w; }
    asm volatile("s_waitcnt lgkmcnt(0)" ::: "memory");
    __builtin_amdgcn_s_barrier();
    asm volatile("" ::: "memory");
#undef FA_ISSUE
}
struct AttnOrder {
    int vcu, G;
    __device__ __forceinline__ bool next(int i, int& bh, int& qb) const {
        if (G == 256) { if (i >= 4) return false; const int s = vcu & 7; bh = vcu >> 3; qb = (i == 0) ? 31 - s : (i == 1) ? 16 + s : (i == 2) ? 15 - s : s; return true; }
        const int u = vcu + i * G; if (u >= 1024) return false; bh = u >> 5; qb = 31 - (u & 31); return true;
    }
};

__device__ __forceinline__ float gelu_tanh(float x) { const float u = 0.7978845608028654f * (x + 0.044715f * x * x * x); const float e = __expf(2.f * u); return 0.5f * x * (2.f - 2.f / (e + 1.f)); }
template <bool SPLIT>
__device__ __forceinline__ void nsa_compress_unit(LAS unsigned char* lds, int bg, int n0, const bf16_t* AH, const bf16_t* AL, const bf16_t* W1H, const bf16_t* W1L,
                                                  const bf16_t* W2H, const bf16_t* W2L, const float* C1P, bf16_t* KCH, bf16_t* KCL, bf16_t* VCT) {
    const int tid = otid(), lane = tid & 63, wid = __builtin_amdgcn_readfirstlane(tid >> 6), r32 = lane & 31, hi = lane >> 5;
    const size_t aoff = ((size_t)bg * 8192 + 16 * (size_t)(n0 + r32)) * 64 + 8 * hi;
    const bf16_t* ah = AH + aoff; const bf16_t* al = SPLIT ? AL + aoff : nullptr;
    const size_t boff = (size_t)(32 * wid + r32) * 2048 + 8 * hi;
    const bf16_t* bh = W1H + boff; const bf16_t* bl = SPLIT ? W1L + boff : nullptr;
    f32x16 acc;
#pragma unroll
    for (int r = 0; r < 16; ++r) acc[r] = 0.f;
#pragma unroll 1
    for (int k8 = 0; k8 < 16; ++k8) {
        bf16x8 fa_h[8], fb_h[8], fa_l[8], fb_l[8];
#pragma unroll
        for (int u = 0; u < 8; ++u) { const int kk = 8 * k8 + u; fa_h[u] = *(const bf16x8*)(ah + 16 * kk); fb_h[u] = *(const bf16x8*)(bh + 16 * kk);
            if (SPLIT) { fa_l[u] = *(const bf16x8*)(al + 16 * kk); fb_l[u] = *(const bf16x8*)(bl + 16 * kk); } }
#pragma unroll
        for (int u = 0; u < 8; ++u) { acc = __builtin_amdgcn_mfma_f32_32x32x16_bf16(fa_h[u], fb_h[u], acc, 0, 0, 0);
            if (SPLIT) { acc = __builtin_amdgcn_mfma_f32_32x32x16_bf16(fa_h[u], fb_l[u], acc, 0, 0, 0); acc = __builtin_amdgcn_mfma_f32_32x32x16_bf16(fa_l[u], fb_h[u], acc, 0, 0, 0); } }
    }
    const int col = 32 * wid + r32;
    float c1 = 0.f;
#pragma unroll 8
    for (int kc = 0; kc < 32; ++kc) c1 += C1P[kc * 256 + col];
    constexpr int GP = 528;
#pragma unroll
    for (int r = 0; r < 16; ++r) { const float gv = gelu_tanh(acc[r] + c1); const unsigned short h = pg8::f2bf_rne(gv); const int row = crow(r, hi);
        *(LAS unsigned short*)(lds + row * GP + col * 2) = h;
        if (SPLIT) *(LAS unsigned short*)(lds + 32 * GP + row * GP + col * 2) = pg8::f2bf_rne(gv - pg8::bf2f(h)); }
    __syncthreads();
    if (wid < 2) {
        f32x16 a2;
#pragma unroll
        for (int r = 0; r < 16; ++r) a2[r] = 0.f;
        const size_t woff = (size_t)(32 * wid + r32) * 256 + 8 * hi;
#pragma unroll
        for (int kk = 0; kk < 16; ++kk) {
            const bf16x8 g_h = *(const LAS bf16x8*)(lds + r32 * GP + (16 * kk + 8 * hi) * 2);
            const bf16x8 w_h = *(const bf16x8*)(W2H + woff + 16 * kk);
            a2 = __builtin_amdgcn_mfma_f32_32x32x16_bf16(g_h, w_h, a2, 0, 0, 0);
            if (SPLIT) { const bf16x8 g_l = *(const LAS bf16x8*)(lds + 32 * GP + r32 * GP + (16 * kk + 8 * hi) * 2); const bf16x8 w_l = *(const bf16x8*)(W2L + woff + 16 * kk);
                a2 = __builtin_amdgcn_mfma_f32_32x32x16_bf16(g_h, w_l, a2, 0, 0, 0);
                a2 = __builtin_amdgcn_mfma_f32_32x32x16_bf16(g_l, w_h, a2, 0, 0, 0); }
        }
        const int e = 32 * wid + r32;
#pragma unroll
        for (int r = 0; r < 16; ++r) { const int n = n0 + crow(r, hi); const float v = (n < 511) ? a2[r] : 0.f;
            if (SPLIT) { const unsigned short h = pg8::f2bf_rne(v); KCH[((size_t)bg * 512 + n) * 64 + e] = h; KCL[((size_t)bg * 512 + n) * 64 + e] = pg8::f2bf_rne(v - pg8::bf2f(h)); }
            else { const int pos = (n & ~12) | ((n & 4) << 1) | ((n & 8) >> 1); VCT[((size_t)bg * 64 + e) * 512 + pos] = pg8::f2bf_rne(v); } }
    }
    __syncthreads();
}

constexpr int IM_P = 0, IM_PPITCH = 516, IM_VAL = 66048, IM_RED = 82432, IM_RED2 = 86528, IM_TAB = 90624, IM_END = 92672;
__device__ __forceinline__ void nsa_importance_unit(LAS unsigned char* lds, int b, int g, int qblk, const bf16_t* QH, const bf16_t* QL, const bf16_t* KCH, const bf16_t* KCL,
                                                    const float* TAB, unsigned char* SEL) {
    const int tid = otid(), lane = tid & 63, wid = __builtin_amdgcn_readfirstlane(tid >> 6), r32 = lane & 31, hi = lane >> 5;
    const int t0 = 32 * qblk, qpos = t0 + r32; const size_t tok = (size_t)b * 8192 + qpos;
    LAS float* P = (LAS float*)(lds + IM_P); LAS float* VAL = (LAS float*)(lds + IM_VAL); LAS float* RED = (LAS float*)(lds + IM_RED); LAS float* RED2 = (LAS float*)(lds + IM_RED2); LAS float* TABL = (LAS float*)(lds + IM_TAB);
    TABL[tid] = TAB[(g * 4) * 128 + tid];
    __syncthreads();
    const int nmax = 2 * qblk;
    const bool act0 = 32 * wid <= nmax, act1 = 32 * (wid + 8) <= nmax;
    f32x16 sc[4][2];
#pragma unroll
    for (int r = 0; r < 4; ++r)
#pragma unroll
        for (int nt = 0; nt < 2; ++nt)
#pragma unroll
            for (int i = 0; i < 16; ++i) sc[r][nt][i] = 0.f;
    if (act0) {
        const size_t qoff = tok * 1024 + (size_t)(g * 4) * 64 + 8 * hi;
#pragma unroll
        for (int d0 = 0; d0 < 4; ++d0) {
            bf16x8 kh[2], kl[2];
#pragma unroll
            for (int nt = 0; nt < 2; ++nt) { const size_t koff = ((size_t)(b * 4 + g) * 512 + 32 * (wid + 8 * nt) + r32) * 64 + 8 * hi + 16 * d0; kh[nt] = *(const bf16x8*)(KCH + koff); kl[nt] = *(const bf16x8*)(KCL + koff); }
#pragma unroll
            for (int r = 0; r < 4; ++r) { const bf16x8 qh = *(const bf16x8*)(QH + qoff + r * 64 + 16 * d0), ql = *(const bf16x8*)(QL + qoff + r * 64 + 16 * d0);
                sc[r][0] = __builtin_amdgcn_mfma_f32_32x32x16_bf16(kh[0], qh, sc[r][0], 0, 0, 0);
                sc[r][0] = __builtin_amdgcn_mfma_f32_32x32x16_bf16(kh[0], ql, sc[r][0], 0, 0, 0);
                sc[r][0] = __builtin_amdgcn_mfma_f32_32x32x16_bf16(kl[0], qh, sc[r][0], 0, 0, 0);
                if (act1) { sc[r][1] = __builtin_amdgcn_mfma_f32_32x32x16_bf16(kh[1], qh, sc[r][1], 0, 0, 0);
                    sc[r][1] = __builtin_amdgcn_mfma_f32_32x32x16_bf16(kh[1], ql, sc[r][1], 0, 0, 0);
                    sc[r][1] = __builtin_amdgcn_mfma_f32_32x32x16_bf16(kl[1], qh, sc[r][1], 0, 0, 0); } }
        }
    }
#pragma unroll
    for (int nt = 0; nt < 2; ++nt)
#pragma unroll
        for (int i = 0; i < 16; ++i) { const int n = 32 * (wid + 8 * nt) + crow(i, hi); const int dist = qpos - (16 * n + 31); const int idx = min(max(dist, 0), 127);
#pragma unroll
            for (int r = 0; r < 4; ++r) sc[r][nt][i] = (dist >= 0) ? sc[r][nt][i] + TABL[r * 128 + idx] : NEGV; }
    float mrow[4];
#pragma unroll
    for (int r = 0; r < 4; ++r) { float mx = NEGV;
#pragma unroll
        for (int nt = 0; nt < 2; ++nt)
#pragma unroll
            for (int i = 0; i < 16; ++i) mx = fmaxf(mx, sc[r][nt][i]);
        mx = fmaxf(mx, __shfl_xor(mx, 32));
        if (hi == 0) RED[(wid * 4 + r) * 32 + r32] = mx; }
    __syncthreads();
#pragma unroll
    for (int r = 0; r < 4; ++r) { float mx = NEGV;
#pragma unroll
        for (int w = 0; w < 8; ++w) mx = fmaxf(mx, RED[(w * 4 + r) * 32 + r32]);
        mrow[r] = mx; }
#pragma unroll
    for (int r = 0; r < 4; ++r) { float sm = 0.f; const bool any = mrow[r] > -1e29f;
#pragma unroll
        for (int nt = 0; nt < 2; ++nt)
#pragma unroll
            for (int i = 0; i < 16; ++i) { const float p = any ? ex2(sc[r][nt][i] - mrow[r]) : 0.f; sc[r][nt][i] = p; sm += p; }
        sm += __shfl_xor(sm, 32);
        if (hi == 0) RED2[(wid * 4 + r) * 32 + r32] = sm; }
    __syncthreads();
    float inv[4];
#pragma unroll
    for (int r = 0; r < 4; ++r) { float sm = 0.f;
#pragma unroll
        for (int w = 0; w < 8; ++w) sm += RED2[(w * 4 + r) * 32 + r32];
        inv[r] = sm > 0.f ? 1.0f / sm : 0.f; }
#pragma unroll
    for (int nt = 0; nt < 2; ++nt)
#pragma unroll
        for (int gq = 0; gq < 4; ++gq) { f32x4 v;
#pragma unroll
            for (int i = 0; i < 4; ++i) v[i] = sc[0][nt][4 * gq + i] * inv[0] + sc[1][nt][4 * gq + i] * inv[1] + sc[2][nt][4 * gq + i] * inv[2] + sc[3][nt][4 * gq + i] * inv[3];
            *(LAS f32x4*)(P + r32 * IM_PPITCH + 32 * (wid + 8 * nt) + 8 * gq + 4 * hi) = v; }
    __syncthreads();
    const int q = tid >> 4, jc = tid & 15; const int tq = t0 + q, cur = tq >> 6;
    unsigned key[8];
#pragma unroll
    for (int jj = 0; jj < 8; ++jj) { const int j = 8 * jc + jj; const f32x4 v = *(const LAS f32x4*)(P + q * IM_PPITCH + 4 * j);
        float s = (v[0] + v[1]) + (v[2] + v[3]); if (j > 0) s += P[q * IM_PPITCH + 4 * j - 1];
        const bool valid = j <= cur, forced = (j == 0) || (j == cur) || (j == cur - 1);
        key[jj] = valid ? (__float_as_uint(forced ? 1e4f : s) + 1u) : 0u; }
#define ROW16_SUM(v_) do { v_ += __builtin_amdgcn_update_dpp(0, v_, 0xB1, 0xf, 0xf, false); v_ += __builtin_amdgcn_update_dpp(0, v_, 0x4E, 0xf, 0xf, false); \
        v_ += __builtin_amdgcn_update_dpp(0, v_, 0x141, 0xf, 0xf, false); v_ += __builtin_amdgcn_update_dpp(0, v_, 0x140, 0xf, 0xf, false); } while (0)
#define ROW16_SCAN(v_) do { v_ += __builtin_amdgcn_update_dpp(0, v_, 0x111, 0xf, 0xf, false); v_ += __builtin_amdgcn_update_dpp(0, v_, 0x112, 0xf, 0xf, false); \
        v_ += __builtin_amdgcn_update_dpp(0, v_, 0x114, 0xf, 0xf, false); v_ += __builtin_amdgcn_update_dpp(0, v_, 0x118, 0xf, 0xf, false); } while (0)
    unsigned T = 0u;
#pragma unroll
    for (int bit = 31; bit >= 0; --bit) { const unsigned cand = T | (1u << bit); int c = 0;
#pragma unroll
        for (int jj = 0; jj < 8; ++jj) c += (key[jj] >= cand) ? 1 : 0;
        ROW16_SUM(c);
        if (c >= 16) T = cand; }
    int gcnt = 0, ecnt = 0;
#pragma unroll
    for (int jj = 0; jj < 8; ++jj) { gcnt += (key[jj] > T) ? 1 : 0; ecnt += (key[jj] == T) ? 1 : 0; }
    int gtot = gcnt; ROW16_SUM(gtot);
    const int need = 16 - gtot;
    int eincl = ecnt; ROW16_SCAN(eincl);
    int erun = eincl - ecnt, scnt = 0; bool sel[8];
#pragma unroll
    for (int jj = 0; jj < 8; ++jj) { const bool eq = key[jj] == T; sel[jj] = (key[jj] > T) || (eq && erun < need); erun += eq ? 1 : 0; scnt += sel[jj] ? 1 : 0; }
    int sincl = scnt; ROW16_SCAN(sincl);
    int slot = sincl - scnt;
    unsigned char* selrow = SEL + (((size_t)b * 8192 + tq) * 4 + g) * 16;
#pragma unroll
    for (int jj = 0; jj < 8; ++jj) if (sel[jj]) { selrow[slot] = (unsigned char)(8 * jc + jj); ++slot; }
#undef ROW16_SUM
#undef ROW16_SCAN
    __syncthreads();
}

struct SelFr { bf16x8 k[8], v[8]; };
__device__ __forceinline__ float wave_max64(float v) {
#pragma unroll
    for (int o = 1; o < 64; o <<= 1) v = fmaxf(v, __shfl_xor(v, o));
    return v;
}
__device__ __forceinline__ float wave_sum64(float v) {
#pragma unroll
    for (int o = 1; o < 64; o <<= 1) v += __shfl_xor(v, o);
    return v;
}
__device__ __forceinline__ void nsa_selected_phase(LAS unsigned char* lds, int gw, int ngw, const bf16_t* QH, const bf16_t* KF, const bf16_t* VF, const unsigned char* SEL, const float* TAB, const float* GATE,
                                                   const bf16_t* OC, const bf16_t* OW, bf16_t* O) {
    const int tid = otid(), lane = tid & 63, wid = __builtin_amdgcn_readfirstlane(tid >> 6), r32 = lane & 31, hi = lane >> 5;
    LAS float* TABL = (LAS float*)lds;
    for (int i = tid; i < 2048; i += 512) TABL[i] = TAB[i];
    __syncthreads();
    LAS unsigned char* pt = lds + 8192 + wid * 1024;
    const int ppos = (lane & ~12) | ((lane & 4) << 1) | ((lane & 8) >> 1);
#define SEL_LOAD(S, j_) do { const bf16_t* kb_ = KF + ((size_t)(bg * 128 + (j_)) * 8) * 512 + lane * 8; const bf16_t* vb_ = VF + ((size_t)(bg * 128 + (j_)) * 8) * 512 + lane * 8; \
        _Pragma("unroll") for (int f_ = 0; f_ < 8; ++f_) { S.k[f_] = *(const bf16x8*)(kb_ + f_ * 512); S.v[f_] = *(const bf16x8*)(vb_ + f_ * 512); } } while (0)
#define SEL_COMPUTE(S, j_) do { f32x16 p0, p1; \
        _Pragma("unroll") for (int r_ = 0; r_ < 16; ++r_) { p0[r_] = 0.f; p1[r_] = 0.f; } \
        _Pragma("unroll") for (int d0 = 0; d0 < 4; ++d0) { p0 = __builtin_amdgcn_mfma_f32_32x32x16_bf16(qa[d0], S.k[d0], p0, 0, 0, 0); p1 = __builtin_amdgcn_mfma_f32_32x32x16_bf16(qa[d0], S.k[4 + d0], p1, 0, 0, 0); } \
        float s_[4]; _Pragma("unroll") for (int h = 0; h < 4; ++h) s_[h] = hi ? p1[h] : p0[h]; \
        if (64 * (j_) + 63 >= t - 127) { const int dist = t - (64 * (j_) + lane); const int idx = min(max(dist, 0), 127); \
            _Pragma("unroll") for (int h = 0; h < 4; ++h) s_[h] = (dist >= 0) ? s_[h] + TABL[(g * 4 + h) * 128 + idx] : NEGV; } \
        const bool ex_ = (s_[0] > m_run[0] + 8.f) || (s_[1] > m_run[1] + 8.f) || (s_[2] > m_run[2] + 8.f) || (s_[3] > m_run[3] + 8.f); \
        if (__any(ex_)) { float asel = 1.f; \
            _Pragma("unroll") for (int h = 0; h < 4; ++h) { const float mn = fmaxf(m_run[h], wave_max64(s_[h])); const float al = ex2(m_run[h] - mn); ll[h] *= al; m_run[h] = mn; if ((r32 & 3) == h) asel = al; } \
            _Pragma("unroll") for (int r_ = 0; r_ < 16; ++r_) { o[0][r_] *= asel; o[1][r_] *= asel; } } \
        _Pragma("unroll") for (int h = 0; h < 4; ++h) { const float p_ = ex2(s_[h] - m_run[h]); ll[h] += p_; *(LAS unsigned short*)(pt + h * 144 + ppos * 2) = (unsigned short)(pg8::cvt_pk_bf16(p_, 0.f) & 0xffffu); } \
        bf16x8 pf[4]; _Pragma("unroll") for (int ks = 0; ks < 4; ++ks) pf[ks] = *(const LAS bf16x8*)(pt + (r32 & 3) * 144 + (16 * ks + 8 * hi) * 2); \
        _Pragma("unroll") for (int db = 0; db < 2; ++db) _Pragma("unroll") for (int ks = 0; ks < 4; ++ks) o[db] = __builtin_amdgcn_mfma_f32_32x32x16_bf16(S.v[db * 4 + ks], pf[ks], o[db], 0, 0, 0); } while (0)
#define SEL_BYTE(i_) __builtin_amdgcn_readfirstlane((int)(((((i_) < 4) ? selw.x : ((i_) < 8) ? selw.y : ((i_) < 12) ? selw.z : selw.w) >> (8 * ((i_) & 3))) & 255u))
    const int nper = ngw >> 3;
    for (int it = gw % nper; it < 8192; it += nper) {
        const int bg = gw / nper, b = bg >> 2, g = bg & 3, t = it, tokI = b * 8192 + t; const size_t tok = (size_t)tokI;
        const int head = g * 4 + (r32 & 3);
        bf16x8 qa[4];
#pragma unroll
        for (int d0 = 0; d0 < 4; ++d0) qa[d0] = *(const bf16x8*)(QH + tok * 1024 + head * 64 + 16 * d0 + 8 * hi);
        const u32x4 selw = *(const u32x4*)(SEL + (tok * 4 + g) * 16);
        float m_run[4], ll[4]; f32x16 o[2];
#pragma unroll
        for (int h = 0; h < 4; ++h) { m_run[h] = NEGV; ll[h] = 0.f; }
#pragma unroll
        for (int r = 0; r < 16; ++r) { o[0][r] = 0.f; o[1][r] = 0.f; }
        SelFr A, B;
        int jn = SEL_BYTE(0); SEL_LOAD(A, jn);
#pragma unroll 1
        for (int i = 0; i < 16; i += 2) {
            const int j0 = jn; jn = SEL_BYTE(i + 1); SEL_LOAD(B, jn);
            if (64 * j0 <= t) SEL_COMPUTE(A, j0);
            const int j1 = jn; if (i + 2 < 16) { jn = SEL_BYTE(i + 2); SEL_LOAD(A, jn); }
            if (64 * j1 <= t) SEL_COMPUTE(B, j1);
        }
        float lsel = 1.f;
#pragma unroll
        for (int h = 0; h < 4; ++h) { const float lt = wave_sum64(ll[h]); if ((r32 & 3) == h) lsel = lt; }
        if (r32 < 4) {
            const float inv = GATE[tok * 48 + head * 3 + 1] / lsel;
#pragma unroll
            for (int db = 0; db < 2; ++db)
#pragma unroll
                for (int gq = 0; gq < 4; ++gq) { const size_t off = tok * 1024 + head * 64 + 32 * db + 8 * gq + 4 * hi;
                    const u32x2 c = *(const u32x2*)(OC + off), w = *(const u32x2*)(OW + off);
                    const float r0 = o[db][4 * gq] * inv + __uint_as_float(c.x << 16) + __uint_as_float(w.x << 16), r1 = o[db][4 * gq + 1] * inv + __uint_as_float(c.x & 0xffff0000u) + __uint_as_float(w.x & 0xffff0000u);
                    const float r2 = o[db][4 * gq + 2] * inv + __uint_as_float(c.y << 16) + __uint_as_float(w.y << 16), r3 = o[db][4 * gq + 3] * inv + __uint_as_float(c.y & 0xffff0000u) + __uint_as_float(w.y & 0xffff0000u);
                    u32x2 ov; ov.x = pg8::cvt_pk_bf16(r0, r1); ov.y = pg8::cvt_pk_bf16(r2, r3); *(u32x2*)(O + off) = ov; }
        }
    }
#undef SEL_LOAD
#undef SEL_COMPUTE
#undef SEL_BYTE
    __syncthreads();
}
}
typedef unsigned v4u __attribute__((ext_vector_type(4)));
#define XB_TMO      128
#define XB_XCNT(j)  (256  + 64 * (j))
#define XB_XSUB(j)  (1280 + 64 * (j))
#define XB_XGEN(j)  (2304 + 64 * (j))
#define XB_TOP      3328
#define XB_TOPGEN   3392
#define XCD_BAR_WORDS 3456
#define XB_SPIN_CAP (1u << 18)

__device__ __forceinline__ unsigned xb_ld(unsigned* p)              { return __hip_atomic_load(p, __ATOMIC_RELAXED, __HIP_MEMORY_SCOPE_AGENT); }
__device__ __forceinline__ unsigned xb_add(unsigned* p, unsigned v) { return __hip_atomic_fetch_add(p, v, __ATOMIC_RELAXED, __HIP_MEMORY_SCOPE_AGENT); }
__device__ __forceinline__ unsigned xb_xcc_id() { return (unsigned)__builtin_amdgcn_s_getreg((3 << 11) | 20) & 0xFu; }
#define XB_SPIN(cond, bar) do { unsigned _sp = 0; while (cond) { __builtin_amdgcn_s_sleep(1); \
    if ((++_sp & 255u) == 0u) { if (xb_ld(&(bar)[XB_TMO])) break; if (_sp > XB_SPIN_CAP) { atomicAdd(&(bar)[XB_TMO], 1u); break; } } } } while (0)

struct XcdBarrier {
    unsigned* bar; unsigned x;
    volatile LAS unsigned* st;
};

__device__ __forceinline__ XcdBarrier xcd_barrier_post(unsigned* bar, volatile LAS unsigned* st) {
    XcdBarrier b; b.bar = bar; b.x = xb_xcc_id(); b.st = st;
    if (threadIdx.x == 0) (void)xb_add(&bar[XB_XCNT(b.x)], 1u);
    return b;
}
__device__ __forceinline__ void xcd_barrier_complete(unsigned* bar, unsigned x, unsigned& nloc, unsigned& nx) {
    const unsigned G = gridDim.x * gridDim.y * gridDim.z;
    unsigned sum, cnt, mine, sp = 0u;
    for (;;) {
        sum = 0u; cnt = 0u; mine = 0u;
#pragma unroll
        for (unsigned j = 0; j < 16; ++j) { const unsigned c = xb_ld(&bar[XB_XCNT(j)]); sum += c; cnt += (c > 0u) ? 1u : 0u; mine = (j == x) ? c : mine; }
        if (sum == G) break;
        __builtin_amdgcn_s_sleep(1);
        if ((++sp & 255u) == 0u) { if (xb_ld(&bar[XB_TMO])) break; if (sp > XB_SPIN_CAP) { atomicAdd(&bar[XB_TMO], 1u); break; } }
    }
    nloc = mine > 0u ? mine : 1u; nx = cnt > 0u ? cnt : 1u;
}

__device__ __forceinline__ void xcd_barrier(const XcdBarrier& b) {
    asm volatile("s_waitcnt vmcnt(0)" ::: "memory");
    __syncthreads();
    if (threadIdx.x == 0) {
        unsigned* bar = b.bar;
        __builtin_amdgcn_s_waitcnt(0);
        unsigned nloc = b.st[0], nx = b.st[1];
        if (nloc == 0u) { xcd_barrier_complete(bar, b.x, nloc, nx); b.st[0] = nloc; b.st[1] = nx; }
        const unsigned old = xb_add(&bar[XB_XSUB(b.x)], 1u);
        const unsigned gen = old / nloc;
        if (old + 1u == (gen + 1u) * nloc) {
            __builtin_amdgcn_fence(__ATOMIC_RELEASE, "agent");
            asm volatile("s_waitcnt vmcnt(0)" ::: "memory");
            const unsigned og = xb_add(&bar[XB_TOP], 1u);
            const unsigned tg = og / nx;
            if (og + 1u == (tg + 1u) * nx) xb_add(&bar[XB_TOPGEN], 1u);
            else XB_SPIN(xb_ld(&bar[XB_TOPGEN]) == tg, bar);
            __builtin_amdgcn_fence(__ATOMIC_ACQUIRE, "agent");
            xb_add(&bar[XB_XGEN(b.x)], 1u);
            asm volatile("s_waitcnt vmcnt(0)" ::: "memory");
        } else {
            XB_SPIN(xb_ld(&bar[XB_XGEN(b.x)]) == gen, bar);
            __builtin_amdgcn_fence(__ATOMIC_ACQUIRE, "agent");
            asm volatile("s_waitcnt vmcnt(0)" ::: "memory");
        }
    }
    __syncthreads();
}
using pg8::bf16_t; using pg8::f32x4; using pg8::u32x4; using pg8::u32x2;
constexpr int NWAVES = 8, NTHREADS = 512;
constexpr int MTOK = 16384, DM = 1024, SEQ = 8192, DFF = 4096;
constexpr float NORM_EPS = 1e-6f, LOG2E = 1.4426950408889634f, QSCALE = 0.125f * 1.4426950408889634f;
constexpr size_t MiB = 1u << 20;
constexpr size_t WS_TAB = 0;
constexpr size_t WS_C1P = 64 * 1024;
constexpr size_t WS_CTL = 512 * 1024, CTL_BYTES = 16 * 1024;
constexpr size_t WS_W1T = 1 * MiB, WS_W2T = 9 * MiB, WS_WGT = 17 * MiB, WS_WPT = 19 * MiB, WS_WOT = 20 * MiB, WS_WIN = 22 * MiB, WS_WVT = 30 * MiB, WS_WB = 32 * MiB;
constexpr size_t WS_CW1 = 34 * MiB;
constexpr size_t WS_CW2 = 38 * MiB;
constexpr size_t WS_XH = 40 * MiB;
constexpr size_t WS_BIG = 72 * MiB;
constexpr size_t WS_Y = 200 * MiB;
constexpr size_t WS_AUX = 264 * MiB;
constexpr size_t WS_PB = 296 * MiB;
constexpr size_t WS_LF = 304 * MiB, WS_KBIAS = 305 * MiB, WS_SEL = 306 * MiB, WS_GATE = 307 * MiB;
constexpr size_t WS_KC = 310 * MiB;
constexpr size_t WS_END = 312 * MiB;
constexpr int LDS_BYTES = 147456, LDS_MISC = 131072 + 320;

__device__ const unsigned char kBucket[128] = {0, 1, 2, 3, 4, 5, 6, 7, 8, 9, 10, 11, 12, 13, 14, 15, 16, 16, 16, 17, 17, 18, 18, 18, 19, 19, 19, 20, 20, 20, 20, 21, 21, 21, 21, 22, 22, 22, 22, 22, 23, 23, 23, 23, 23, 23, 24, 24, 24, 24, 24, 24,
    25, 25, 25, 25, 25, 25, 25, 26, 26, 26, 26, 26, 26, 26, 26, 27, 27, 27, 27, 27, 27, 27, 27, 27, 27, 28, 28, 28, 28, 28, 28, 28, 28, 28, 28, 29, 29, 29, 29, 29, 29, 29, 29, 29, 29, 29, 29, 30, 30, 30, 30, 30, 30, 30, 30, 30, 30, 30, 30, 30, 30,
    31, 31, 31, 31, 31, 31, 31, 31, 31, 31, 31, 31, 31, 31, 31};

struct Args { const float* in[20]; float* out; unsigned char* ws; int ph_lo, ph_hi; };
enum { IN_X = 0, IN_P, IN_REL, IN_NG, IN_W1, IN_W2, IN_PLEW, IN_GATEW, IN_DAIN, IN_DALAM, IN_DASUB, IN_DAOUT, IN_NSAIN, IN_NSAPE, IN_NSAW1, IN_NSAW2, IN_NSAOUT, IN_FOXIN, IN_FOXB, IN_FOXOUT };

__device__ __forceinline__ float wave_sum(float v) {
#pragma unroll
    for (int o = 1; o < 64; o <<= 1) v += __shfl_xor(v, o);
    return v;
}
__device__ __forceinline__ unsigned pk2(float lo, float hi) { return pg8::cvt_pk_bf16(lo, hi); }

__device__ __forceinline__ void tr_item(const float* W, int ldn, int cbeg, int nvalid, bf16_t* dst, int ldd, int row0, int kofs, int lo, LAS float* scr, int kb, int nb, int lane) {
    const int k0 = 64 * kb, n0 = 32 * nb;
    float ld_[32]; const int nn = n0 + (lane & 31); const float* wp = W + (size_t)(k0 + (lane >> 5)) * ldn + cbeg + nn;
#pragma unroll
    for (int i = 0; i < 32; ++i) ld_[i] = (nn < nvalid) ? wp[(size_t)(2 * i) * ldn] : 0.f;
#pragma unroll
    for (int i = 0; i < 32; ++i) scr[(2 * i + (lane >> 5)) * 33 + (lane & 31)] = ld_[i];
    asm volatile("s_waitcnt lgkmcnt(0)" ::: "memory");
    const int c = lane & 7;
#pragma unroll
    for (int j = 0; j < 4; ++j) { const int n = (lane >> 3) + 8 * j; const LAS float* s = scr + (8 * c) * 33 + n; float v[8];
#pragma unroll
        for (int i = 0; i < 8; ++i) { v[i] = s[i * 33]; if (lo) v[i] = v[i] - pg8::bf2f(pg8::f2bf_rne(v[i])); }
        u32x4 o; o.x = pk2(v[0], v[1]); o.y = pk2(v[2], v[3]); o.z = pk2(v[4], v[5]); o.w = pk2(v[6], v[7]);
        *(u32x4*)(dst + (size_t)(row0 + n0 + n) * ldd + kofs + k0 + 8 * c) = o; }
    asm volatile("s_waitcnt lgkmcnt(0)" ::: "memory");
}
__device__ __forceinline__ void tr_job(const float* W, int K, int ldn, int cbeg, int nvalid, int npad, bf16_t* dst, int ldd, int row0, int kofs, int lo, LAS float* scr, int gw, int ngw, int lane) {
    const int nnb = npad / 32, nitems = (K / 64) * nnb;
    for (int it = gw; it < nitems; it += ngw) tr_item(W, ldn, cbeg, nvalid, dst, ldd, row0, kofs, lo, scr, it / nnb, it % nnb, lane);
}

template <int MODE  >
__device__ __forceinline__ void norm_rows(const float* xsrc, float* X, const bf16_t* Y, const float* ga, const float* gb, bf16_t* XH, bf16_t* H3, int gw, int ngw, int lane) {
    constexpr int R = 2;
    for (int m0 = gw * R; m0 < MTOK; m0 += ngw * R) {
        f32x4 v[R][4], y[R][4];
#pragma unroll
        for (int q = 0; q < R; ++q) { const f32x4* xr = (const f32x4*)(xsrc + (size_t)(m0 + q) * DM) + lane;
#pragma unroll
            for (int j = 0; j < 4; ++j) v[q][j] = xr[64 * j];
            if (MODE != 0) { const u32x2* yr = (const u32x2*)(Y + (size_t)(m0 + q) * DM) + lane;
#pragma unroll
                for (int j = 0; j < 4; ++j) { const u32x2 w = yr[64 * j]; y[q][j][0] = __uint_as_float(w.x << 16); y[q][j][1] = __uint_as_float(w.x & 0xffff0000u); y[q][j][2] = __uint_as_float(w.y << 16); y[q][j][3] = __uint_as_float(w.y & 0xffff0000u); } } }
#pragma unroll
        for (int q = 0; q < R; ++q) { const int m = m0 + q;
            if (MODE != 0) { float s = 0.f;
#pragma unroll
                for (int j = 0; j < 4; ++j) s += (y[q][j][0] * y[q][j][0] + y[q][j][1] * y[q][j][1]) + (y[q][j][2] * y[q][j][2] + y[q][j][3] * y[q][j][3]);
                const float ry = rsqrtf(wave_sum(s) * (1.f / DM) + NORM_EPS);
#pragma unroll
                for (int j = 0; j < 4; ++j) { const f32x4 g = ((const f32x4*)ga)[lane + 64 * j]; v[q][j] = v[q][j] + y[q][j] * ry * g; } }
            if (MODE != 0 || xsrc != X) { f32x4* xo = (f32x4*)(X + (size_t)m * DM) + lane;
#pragma unroll
                for (int j = 0; j < 4; ++j) xo[64 * j] = v[q][j]; }
            if (MODE != 2) { float s = 0.f;
#pragma unroll
                for (int j = 0; j < 4; ++j) s += (v[q][j][0] * v[q][j][0] + v[q][j][1] * v[q][j][1]) + (v[q][j][2] * v[q][j][2] + v[q][j][3] * v[q][j][3]);
                const float rx = rsqrtf(wave_sum(s) * (1.f / DM) + NORM_EPS);
#pragma unroll
                for (int j = 0; j < 4; ++j) { const f32x4 g = ((const f32x4*)gb)[lane + 64 * j]; v[q][j] = v[q][j] * rx * g; } }
            u32x2* ho = (u32x2*)(XH + (size_t)m * DM) + lane;
#pragma unroll
            for (int j = 0; j < 4; ++j) { u32x2 h; h.x = pk2(v[q][j][0], v[q][j][1]); h.y = pk2(v[q][j][2], v[q][j][3]); ho[64 * j] = h;
                if (MODE == 0) { if (H3) { u32x2 l; l.x = pk2(v[q][j][0] - __uint_as_float(h.x << 16), v[q][j][1] - __uint_as_float(h.x & 0xffff0000u)); l.y = pk2(v[q][j][2] - __uint_as_float(h.y << 16), v[q][j][3] - __uint_as_float(h.y & 0xffff0000u));
                    u32x2* h3 = (u32x2*)(H3 + (size_t)m * 3072) + lane; h3[64 * j] = h; h3[256 + 64 * j] = h; h3[512 + 64 * j] = l; } } } }
    }
}

template <class Epi> __device__ __forceinline__ void run_gemm(LAS unsigned char* lds, const bf16_t* A, const bf16_t* Bt, int M, int N, int K, const Epi& E, int rot = 0) {
    pg8::Gemm g{A, Bt, M, N, oqi(K)}; pg8::StaticOrder S; const int G_ = oqi((int)gridDim.x); S.init(M, N, G_, (oqi((int)blockIdx.x) + rot) % G_);
    pg8::gemm_phase<Epi, pg8::StaticOrder, true, true>((PG8_LAS unsigned char*)lds, g, S, E);
}

#ifndef FLASH_DA
#define FLASH_DA fa::flash_unit_reg
#endif
#ifndef FLASH_FOX
#define FLASH_FOX fa::flash_unit_reg
#endif
#ifndef FLASH_NSA
#define FLASH_NSA fa::flash_unit_reg
#endif
#ifndef ONLY_PK
#define ONLY_PK -1
#endif
#ifndef ONLY_KIND
#define ONLY_KIND -1
#endif
#define PH_ON(k) (ONLY_PK < 0 || ONLY_PK == (k))
#define KIND_IS(kk) ((ONLY_KIND < 0 || ONLY_KIND == (kk)) && kind == (kk))
__device__ __forceinline__ int layer_kind(int layer) { return layer % 3; }
__device__ __forceinline__ int layer_nph(int layer) { return layer_kind(layer) == 1 ? 11 : 10; }
constexpr int N_PHASES = 10 + 11 + 10 + 10;
enum { PK_PRO = 0, PK_INPROJ, PK_MIX1, PK_MIX2, PK_MIX3, PK_OUTPROJ, PK_NORMB, PK_UP, PK_DOWN, PK_NORMC, PK_GATE };

__global__ void __launch_bounds__(NTHREADS, 2) trunk_fwd(Args args) {
    extern __shared__ __attribute__((aligned(16))) unsigned char lds_raw[];
    LAS unsigned char* lds = (LAS unsigned char*)lds_raw;
#define X (args.out)
#define TAB ((float*)(ws + WS_TAB))
#define C1P ((float*)(ws + WS_C1P))
#define W1T ((bf16_t*)(ws + WS_W1T))
#define W2T ((bf16_t*)(ws + WS_W2T))
#define WGT ((bf16_t*)(ws + WS_WGT))
#define WPT ((bf16_t*)(ws + WS_WPT))
#define WOT ((bf16_t*)(ws + WS_WOT))
#define WIN ((bf16_t*)(ws + WS_WIN))
#define WVT ((bf16_t*)(ws + WS_WVT))
#define WB ((bf16_t*)(ws + WS_WB))
#define CW1 ((bf16_t*)(ws + WS_CW1))
#define CW2 ((bf16_t*)(ws + WS_CW2))
#define XH ((bf16_t*)(ws + WS_XH))
#define BIG ((bf16_t*)(ws + WS_BIG))
#define Y ((bf16_t*)(ws + WS_Y))
#define PB ((bf16_t*)(ws + WS_PB))
#define AUX ((bf16_t*)(ws + WS_AUX))
#define LF ((float*)(ws + WS_LF))
#define KBIAS ((float*)(ws + WS_KBIAS))
#define SEL (ws + WS_SEL)
#define GATE ((float*)(ws + WS_GATE))
#define KCH ((bf16_t*)(ws + WS_KC))
#define KCL (KCH + 262144)
#define VCT (KCH + 524288)
#define QK BIG
#define VT (BIG + 32 * MiB)
#define O_DF (BIG + 48 * MiB)
#define OD ((bf16_t*)(ws + WS_Y))
#define H3 BIG
#define KSb (BIG + 48 * MiB)
#define KWb (BIG + 52 * MiB)
#define VTn (BIG + 56 * MiB)
#define OC BIG
#define OW (BIG + 16 * MiB)
#define O_N (BIG + 32 * MiB)
#define QH ((bf16_t*)(ws + WS_Y))
#define QL (QH + 16 * MiB)
#define KIH AUX
#define KIL (AUX + (9 * MiB) / 2)
#define VCI (AUX + 9 * MiB)
#define PW AUX
#define U BIG
    cg::grid_group grid = cg::this_grid();
    { volatile LAS unsigned* misc = (volatile LAS unsigned*)(lds + LDS_MISC); if (threadIdx.x < 32) misc[threadIdx.x] = 0u; }
    __syncthreads();
    XcdBarrier xbar = xcd_barrier_post((unsigned*)(args.ws + WS_CTL), (volatile LAS unsigned*)(lds + LDS_MISC + 32));
    bool first_seam = true;

    int layer = 0, base = 0;
#if REP_PK >= 0
    int rep_done = 0;
#endif
    for (int ph = args.ph_lo; ph < args.ph_hi; ++ph) {
        const int wave = __builtin_amdgcn_readfirstlane(otid() >> 6);
#define TIDL const int tid = otid(), lane = tid & 63; (void)tid; (void)lane;
        const int G = oqi((int)gridDim.x), bx = oqi((int)blockIdx.x); const int vcu = (G % 8 == 0) ? (bx % 8) * (G / 8) + bx / 8 : bx;
        const int gw = vcu * NWAVES + wave, ngw = G * NWAVES;
        unsigned char* ws = oq(args.ws);
        while (ph - base >= layer_nph(layer)) { base += layer_nph(layer); ++layer; }
        const int kind = layer_kind(layer); int pk = ph - base; if (kind != 1 && pk >= PK_MIX3) pk += 1;
        const int mi = layer / 3;
        const float* ng = args.in[IN_NG] + (size_t)layer * 4 * DM;
        bf16_t* Omix = (kind == 1) ? O_N : O_DF;
        LAS float* scr = (LAS float*)(lds + wave * 16384);
        switch (pk) {
        case PK_PRO: if (PH_ON(PK_PRO)) { TIDL
            if (layer == 0 && bx == 0) { const float* rel = args.in[IN_REL]; for (int i = tid; i < 2048; i += NTHREADS) { const int head = i >> 7, d = i & 127; TAB[i] = (rel[kBucket[d] * 16 + head] - rel[31 * 16 + head]) * LOG2E; } }
            tr_job(args.in[IN_W1] + (size_t)layer * DM * DFF, DM, DFF, 0, DFF, DFF, W1T, DM, 0, 0, 0, scr, gw, ngw, lane);
            tr_job(args.in[IN_W2] + (size_t)layer * DFF * DM, DFF, DM, 0, DM, DM, W2T, DFF, 0, 0, 0, scr, gw, ngw, lane);
            tr_job(args.in[IN_GATEW] + (size_t)layer * DM * DM, DM, DM, 0, DM, DM, WGT, DM, 0, 0, 0, scr, gw, ngw, lane);
            tr_job(args.in[IN_PLEW] + (size_t)layer * 256 * DM, 256, DM, 0, DM, DM, WPT, 256, 0, 0, 0, scr, gw, ngw, lane);
            if (kind == 0) { const float* wi = args.in[IN_DAIN] + (size_t)mi * DM * 3072;
                tr_job(args.in[IN_DAOUT] + (size_t)mi * DM * DM, DM, DM, 0, DM, DM, WOT, DM, 0, 0, 0, scr, gw, ngw, lane);
                tr_job(wi, DM, 3072, 0, 2048, 2048, WIN, DM, 0, 0, 0, scr, gw, ngw, lane);
                tr_job(wi, DM, 3072, 2048, 1024, 1024, WVT, DM, 0, 0, 0, scr, gw, ngw, lane);
            } else if (kind == 2) { const float* wi = args.in[IN_FOXIN] + (size_t)mi * DM * 3088;
                tr_job(args.in[IN_FOXOUT] + (size_t)mi * DM * DM, DM, DM, 0, DM, DM, WOT, DM, 0, 0, 0, scr, gw, ngw, lane);
                tr_job(wi, DM, 3088, 0, 2048, 2048, WIN, DM, 0, 0, 0, scr, gw, ngw, lane);
                tr_job(wi, DM, 3088, 3072, 16, 256, WIN, DM, 2048, 0, 0, scr, gw, ngw, lane);
                tr_job(wi, DM, 3088, 2048, 1024, 1024, WVT, DM, 0, 0, 0, scr, gw, ngw, lane);
            } else { const float* wi = args.in[IN_NSAIN] + (size_t)mi * DM * 2608;
                tr_job(args.in[IN_NSAOUT] + (size_t)mi * DM * DM, DM, DM, 0, DM, DM, WOT, DM, 0, 0, 0, scr, gw, ngw, lane);
                tr_job(wi, DM, 2608, 0, 1280, 1280, WIN, 3072, 0, 0, 0, scr, gw, ngw, lane);
                tr_job(wi, DM, 2608, 0, 1280, 1280, WIN, 3072, 0, 1024, 1, scr, gw, ngw, lane);
                tr_job(wi, DM, 2608, 0, 1280, 1280, WIN, 3072, 0, 2048, 0, scr, gw, ngw, lane);
                tr_job(wi, DM, 2608, 1280, 256, 256, WB, DM, 0, 0, 0, scr, gw, ngw, lane);
                tr_job(wi, DM, 2608, 1536, 256, 256, WB, DM, 256, 0, 0, scr, gw, ngw, lane);
                tr_job(wi, DM, 2608, 2048, 256, 256, WB, DM, 512, 0, 0, scr, gw, ngw, lane);
                tr_job(wi, DM, 2608, 2560, 48, 256, WB, DM, 768, 0, 0, scr, gw, ngw, lane);
                tr_job(wi, DM, 2608, 1792, 256, 256, WVT, DM, 0, 0, 0, scr, gw, ngw, lane);
                tr_job(wi, DM, 2608, 2304, 256, 256, WVT, DM, 256, 0, 0, scr, gw, ngw, lane);
                const float* cw1 = args.in[IN_NSAW1] + (size_t)mi * 2 * 2048 * 256; const float* cw2 = args.in[IN_NSAW2] + (size_t)mi * 2 * 256 * 64;
                tr_job(cw1, 2048, 256, 0, 256, 256, CW1, 2048, 0, 0, 0, scr, gw, ngw, lane);
                tr_job(cw1, 2048, 256, 0, 256, 256, CW1 + 524288, 2048, 0, 0, 1, scr, gw, ngw, lane);
                tr_job(cw1 + 2048 * 256, 2048, 256, 0, 256, 256, CW1 + 2 * 524288, 2048, 0, 0, 0, scr, gw, ngw, lane);
                tr_job(cw2, 256, 64, 0, 64, 64, CW2, 256, 0, 0, 0, scr, gw, ngw, lane);
                tr_job(cw2, 256, 64, 0, 64, 64, CW2 + 16384, 256, 0, 0, 1, scr, gw, ngw, lane);
                tr_job(cw2 + 256 * 64, 256, 64, 0, 64, 64, CW2 + 2 * 16384, 256, 0, 0, 0, scr, gw, ngw, lane);
                const float* pe = args.in[IN_NSAPE] + (size_t)mi * 2 * 2048;
                for (int task = gw; task < 256; task += ngw) { const int which = task >> 7, kc = (task >> 2) & 31, cc = task & 3; const float* w = cw1 + (size_t)which * 2048 * 256 + (size_t)(64 * kc) * 256 + 64 * cc + lane;
                    const float* pp = pe + which * 2048 + 64 * kc; float s = 0.f;
                    for (int k = 0; k < 64; ++k) s += pp[k] * w[(size_t)k * 256];
                    C1P[(which * 32 + kc) * 256 + 64 * cc + lane] = s; }
            }
            { const f32x4* src = (const f32x4*)(args.in[IN_P] + (size_t)layer * MTOK * 256); u32x4* dstp = (u32x4*)PB;
              for (int i = bx * NTHREADS + tid; i < MTOK * 256 / 8; i += G * NTHREADS) { const f32x4 a = src[2 * i], b = src[2 * i + 1]; dstp[i] = pg8::pack8(a, b); } }
            norm_rows<0>(layer == 0 ? args.in[IN_X] : (const float*)X, X, (const bf16_t*)nullptr, nullptr, ng, XH, kind == 1 ? H3 : (bf16_t*)nullptr, gw, ngw, lane);
        } break;
        case PK_INPROJ: if (PH_ON(PK_INPROJ)) {
            if (kind == 1) {
                pg8::EpiNsaA EA{QH, QL, KIH, KIL, QSCALE}; run_gemm(lds, H3, WIN, MTOK, 1280, 3072, EA);
                pg8::EpiNsaB EB{VCI, KSb, KWb, GATE}; run_gemm(lds, XH, WB, MTOK, 1024, DM, EB);
                pg8::EpiVt EV{VTn, MTOK, 256}; run_gemm(lds, WVT, XH, 512, MTOK, DM, EV, 128);
            } else {
                pg8::EpiQK EQ{QK, LF, args.in[IN_FOXB] + (size_t)mi * 16, QSCALE}; run_gemm(lds, XH, WIN, MTOK, kind == 2 ? 2304 : 2048, DM, EQ);
                pg8::EpiVt EV{VT, MTOK, 0}; run_gemm(lds, WVT, XH, 1024, MTOK, DM, EV);
            }
        } break;
        case PK_MIX1: if (PH_ON(PK_MIX1)) { TIDL
            if (kind == 0) {
                const float* lamp = args.in[IN_DALAM] + (size_t)mi * 256; const float lam_init = 0.8f - 0.6f * expf(-0.3f * (float)layer);
                const float lam = expf(wave_sum(lamp[lane] * lamp[64 + lane])) - expf(wave_sum(lamp[128 + lane] * lamp[192 + lane])) + lam_init;
                for (int i = 0; i < 2 || G != 256; ++i) { int bh8, qb;
                    if (G == 256) { const int s_ = vcu & 15; bh8 = vcu >> 4; qb = (i == 0) ? 31 - s_ : s_; } else { const int u = vcu + i * G; if (u >= 512) break; bh8 = u >> 5; qb = 31 - (u & 31); }
                    const int b = bh8 >> 3, h = bh8 & 7;
                    for (int c = 0; c < 2; ++c) { const int sh = 2 * h + c; fa::FlashArgs a;
                        a.Q = QK + ((size_t)b * SEQ + 256 * qb) * 2048 + sh * 64; a.ldq = 2048; a.K = QK + (size_t)b * SEQ * 2048 + 1024 + sh * 64; a.ldk = 2048;
                        a.Vt = VT + (size_t)(h * 128) * MTOK + (size_t)b * SEQ; a.ldv = MTOK; a.q0 = 256 * qb; a.t_lo = 0; a.t_hi = 4 * qb + 3; a.pa = 1; a.pb = 0; a.window = 1 << 30;
                        a.kbias = nullptr; a.tab = TAB + sh * 128; a.O = O_DF + ((size_t)b * SEQ + 256 * qb) * DM + h * 128; a.ldo = DM; a.gate = nullptr; a.ldg = 0;
                        a.lam = lam; a.oscale = 1.f - lam_init; a.sg = args.in[IN_DASUB] + (size_t)mi * 128;
                        if (c == 0) fa::flash_unit_reg<128, 2, 2>(lds, a); else fa::flash_unit_reg<128, 2, 3>(lds, a); } }
            } else if (kind == 2) {
                if (vcu < 32) { const int b = vcu >> 4, h = vcu & 15; const float* src = LF + ((size_t)b * SEQ + 16 * tid) * 16 + h; float v[16];
#pragma unroll
                    for (int i = 0; i < 16; ++i) v[i] = src[(size_t)i * 16];
#pragma unroll
                    for (int i = 1; i < 16; ++i) v[i] += v[i - 1];
                    float incl = v[15];
#pragma unroll
                    for (int o = 1; o < 64; o <<= 1) { const float tmp = __shfl_up(incl, o); if (lane >= o) incl += tmp; }
                    LAS float* wt = (LAS float*)lds;
                    if (lane == 63) wt[wave] = incl;
                    __syncthreads();
                    float off = incl - v[15];
                    for (int w = 0; w < wave; ++w) off += wt[w];
                    f32x4* dst = (f32x4*)(KBIAS + (size_t)(b * 16 + h) * SEQ + 16 * tid);
#pragma unroll
                    for (int q = 0; q < 4; ++q) { f32x4 ov; ov[0] = -(off + v[4 * q]) * LOG2E; ov[1] = -(off + v[4 * q + 1]) * LOG2E; ov[2] = -(off + v[4 * q + 2]) * LOG2E; ov[3] = -(off + v[4 * q + 3]) * LOG2E; dst[q] = ov; }
                    __syncthreads(); }
            } else {
                for (int u = vcu; u < 256; u += G) { const int which = u >> 7, bg = (u >> 4) & 7, n0 = 32 * (u & 15);
                    if (which == 0) fa::nsa_compress_unit<true>(lds, bg, n0, KIH, KIL, CW1, CW1 + 524288, CW2, CW2 + 16384, C1P, KCH, KCL, VCT);
                    else fa::nsa_compress_unit<false>(lds, bg, n0, VCI, nullptr, CW1 + 2 * 524288, nullptr, CW2 + 2 * 16384, nullptr, C1P + 32 * 256, KCH, KCL, VCT); }
            }
        } break;
        case PK_MIX2: if (PH_ON(PK_MIX2)) { TIDL
            if (kind == 0) {
            } else if (kind == 2) {
                fa::AttnOrder ord{vcu, G}; int bh, qb;
                for (int i = 0; ord.next(i, bh, qb); ++i) { const int b = bh >> 4, h = bh & 15; fa::FlashArgs a;
                    a.Q = QK + ((size_t)b * SEQ + 256 * qb) * 2048 + h * 64; a.ldq = 2048; a.K = QK + (size_t)b * SEQ * 2048 + 1024 + h * 64; a.ldk = 2048;
                    a.Vt = VT + (size_t)(h * 64) * MTOK + (size_t)b * SEQ; a.ldv = MTOK; a.q0 = 256 * qb; a.t_lo = 0; a.t_hi = 4 * qb + 3; a.pa = 1; a.pb = 0; a.window = 1 << 30;
                    a.kbias = KBIAS + (size_t)(b * 16 + h) * SEQ; a.tab = nullptr; a.O = O_DF + ((size_t)b * SEQ + 256 * qb) * DM + h * 64; a.ldo = DM; a.gate = nullptr; a.ldg = 0;
                    FLASH_FOX<64, 1, 0, -1>(lds, a); }
            } else {
                fa::AttnOrder ord{vcu, G}; int bh, qb;
                for (int br = 0; br < 2; ++br)
                    for (int i = 0; ord.next(i, bh, qb); ++i) { const int b = bh >> 4, h = bh & 15, g = h >> 2, q0 = 256 * qb; fa::FlashArgs a; const size_t tok0 = (size_t)b * SEQ + q0;
                        a.Q = QH + tok0 * DM + h * 64; a.ldq = DM; a.q0 = q0; a.tab = TAB + h * 128; a.kbias = nullptr; a.ldo = DM; a.ldg = 48;
                        if (br == 0) { a.K = KCH + (size_t)(b * 4 + g) * 512 * 64; a.ldk = 64; a.Vt = VCT + (size_t)(b * 4 + g) * 64 * 512; a.ldv = 512; a.t_lo = 0; a.t_hi = min(7, (q0 + 224) >> 10); a.pa = 16; a.pb = 31; a.window = 1 << 30;
                            a.O = OC + tok0 * DM + h * 64; a.gate = GATE + tok0 * 48 + h * 3 + 0; }
                        else { a.K = KWb + (size_t)b * SEQ * 256 + g * 64; a.ldk = 256; a.Vt = VTn + (size_t)(256 + g * 64) * MTOK + (size_t)b * SEQ; a.ldv = MTOK; a.t_lo = max(0, q0 - 511) >> 6; a.t_hi = (q0 + 255) >> 6; a.pa = 1; a.pb = 0; a.window = 512;
                            a.O = OW + tok0 * DM + h * 64; a.gate = GATE + tok0 * 48 + h * 3 + 2; }
                        FLASH_NSA<64, 2, 1>(lds, a); }
                for (int u = vcu; u < 2048; u += G) { const int b = u >> 10, g = (u >> 8) & 3, qblk = u & 255; fa::nsa_importance_unit(lds, b, g, qblk, QH, QL, KCH, KCL, TAB, SEL); }
            }
        } break;
        case PK_MIX3: if (PH_ON(PK_MIX3)) { fa::nsa_selected_phase(lds, gw, ngw, QH, KSb, VTn, SEL, TAB, GATE, OC, OW, O_N); } break;
        case PK_OUTPROJ: if (PH_ON(PK_OUTPROJ)) { pg8::EpiAct<0> E{Y, DM}; run_gemm(lds, Omix, WOT, MTOK, DM, DM, E); } break;
        case PK_NORMB: if (PH_ON(PK_NORMB)) { TIDL norm_rows<1>(X, X, Y, ng + DM, ng + 2 * DM, XH, nullptr, gw, ngw, lane); } break;
        case PK_UP: if (PH_ON(PK_UP)) { pg8::EpiAct<1> E{U, DFF}; run_gemm(lds, XH, W1T, MTOK, DFF, DM, E); } break;
        case PK_DOWN: if (PH_ON(PK_DOWN)) { pg8::EpiAct<0> E{Y, DM}; run_gemm(lds, U, W2T, MTOK, DM, DFF, E); } break;
        case PK_NORMC: if (PH_ON(PK_NORMC)) { TIDL norm_rows<2>(X, X, Y, ng + 3 * DM, nullptr, XH, nullptr, gw, ngw, lane);
                        pg8::EpiAct<0> E2{PW, DM}; run_gemm(lds, PB, WPT, MTOK, DM, 256, E2); } break;
        case PK_GATE: if (PH_ON(PK_GATE)) { pg8::EpiGate E{X, PW}; run_gemm(lds, XH, WGT, MTOK, DM, DM, E); } break;
        default: break;
        }
#if REP_PK >= 0
        if (pk == REP_PK && (REP_LAYER < 0 || layer == REP_LAYER) && rep_done == 0) { rep_done = 1; xcd_barrier(xbar); --ph; continue; }
        rep_done = 0;
#endif
        if (ph + 1 < args.ph_hi) {
            if (first_seam) { first_seam = false; __syncthreads(); grid.sync(); }
            else xcd_barrier(xbar);
#if EXTRA_SYNC > 0
            for (int es = 0; es < EXTRA_SYNC; ++es) xcd_barrier(xbar);
#endif
        }
    }
}

extern "C" void kernel_launch(void* const* d_in, const int* in_sizes, int n_in, void* d_out, int out_size, void* d_ws, size_t ws_size, hipStream_t stream) {
    static int grid = 0;
    if (grid == 0) {
        if (n_in != 20 || out_size != MTOK * DM || ws_size < WS_END) { fprintf(stderr, "kernel_launch: unexpected shapes (n_in %d, out %d, ws %zu)\n", n_in, out_size, ws_size); grid = -1; return; }
        int dev = 0, cus = 0, per_cu = 0;
        hipGetDevice(&dev); hipDeviceGetAttribute(&cus, hipDeviceAttributeMultiprocessorCount, dev);
        if (hipFuncSetAttribute((const void*)trunk_fwd, hipFuncAttributeMaxDynamicSharedMemorySize, LDS_BYTES) != hipSuccess) { fprintf(stderr, "kernel_launch: hipFuncSetAttribute failed\n"); grid = -1; return; }
        hipOccupancyMaxActiveBlocksPerMultiprocessor(&per_cu, (const void*)trunk_fwd, NTHREADS, LDS_BYTES);
        (void)hipGetLastError();
        if (per_cu < 1) { fprintf(stderr, "kernel_launch: occupancy query says %d blocks/CU\n", per_cu); per_cu = 1; }
        grid = cus;
    }
    if (grid < 0) return;
    if (hipMemsetAsync((char*)d_ws + WS_CTL, 0, CTL_BYTES, stream) != hipSuccess) { fprintf(stderr, "kernel_launch: memset of the barrier words failed\n"); return; }
    Args a{};
    for (int i = 0; i < 20; ++i) a.in[i] = (const float*)d_in[i];
    a.out = (float*)d_out; a.ws = (unsigned char*)d_ws;
#if ONE_LAUNCH
    a.ph_lo = 0; a.ph_hi = N_PHASES;
    void* kargs[] = {&a};
    hipError_t e = hipLaunchCooperativeKernel((const void*)trunk_fwd, dim3(grid), dim3(NTHREADS), kargs, LDS_BYTES, stream);
    if (e != hipSuccess) fprintf(stderr, "kernel_launch: cooperative launch failed: %s (grid %d)\n", hipGetErrorString(e), grid);
#else
    for (int ph = 0; ph < N_PHASES; ++ph) { a.ph_lo = ph; a.ph_hi = ph + 1; hipLaunchKernelGGL(trunk_fwd, dim3(grid), dim3(NTHREADS), LDS_BYTES, stream, a); }
#endif
}
```

```cpp
#include <hip/hip_runtime.h>
#include <hip/hip_cooperative_groups.h>
#include <cstdio>
#include <cstdint>
namespace cg = cooperative_groups;
#ifndef REP_PK
#define REP_PK -1
#endif
#ifndef REP_LAYER
#define REP_LAYER -1
#endif
#ifndef EXTRA_SYNC
#define EXTRA_SYNC 0
#endif
#ifndef ONE_LAUNCH
#define ONE_LAUNCH 1
#endif
__device__ __forceinline__ int otid() { int t = (int)threadIdx.x; asm volatile("" : "+v"(t)); return t; }
template <class T> __device__ __forceinline__ T* oq(T* p) { asm volatile("" : "+s"(p)); return p; }
__device__ __forceinline__ int oqi(int v) { asm volatile("" : "+s"(v)); return v; }
namespace pg8 {
#define PG8_LAS __attribute__((address_space(3)))
typedef unsigned short bf16_t;
typedef short bf16x8 __attribute__((ext_vector_type(8)));
typedef float f32x4 __attribute__((ext_vector_type(4)));
typedef unsigned u32x4 __attribute__((ext_vector_type(4)));
constexpr int BM = 256, BK = 64, HALF = 128, HTB = HALF * BK * 2  , STAGE_BYTES = 8 * HTB, NXCD = 8, WGM = 8;

__host__ __device__ __forceinline__ int lds_byte(int r, int c) { const int st = (r >> 4) * 2 + (c >> 5), rr = r & 15, cc = c & 31, ob = rr * 64 + cc * 2; return st * 1024 + (ob ^ (((ob >> 9) & 1) << 5)); }
__host__ __device__ __forceinline__ void stage_rc(int b, int& R, int& C) { const int st = b / 1024, sb = b % 1024, swz = sb ^ (((sb >> 9) & 1) << 5); R = (st >> 1) * 16 + swz / 64; C = (st & 1) * 32 + (swz % 64) / 2; }
__host__ __device__ __forceinline__ int perm32(int rho) { const int n = rho >> 4, i = rho & 15; return 8 * (i >> 2) + 4 * n + (i & 3); }

struct Unit { int pm, pn; };
struct Gemm { const bf16_t* A; const bf16_t* Bt; int M, N, K; };

struct StaticOrder {
    int nM, nN, nwg, G, c;
    __host__ __device__ void init(int M, int N, int G_, int c_) { nM = M / BM; nN = N / BM; nwg = nM * nN; G = G_; c = c_; }
    __host__ __device__ bool next(int i, Unit& u) const {
        const long L = (long)i * G + c; if (L >= nwg) return false;
        int wgid = (int)L; { const int q = nwg / NXCD, r = nwg % NXCD, xcd = wgid % NXCD, off = wgid / NXCD; wgid = (xcd < r ? xcd * (q + 1) : r * (q + 1) + (xcd - r) * q) + off; }
        const int nig = WGM * nN, gid = wgid / nig, fm = gid * WGM, gsz = (nM - fm) < WGM ? (nM - fm) : WGM;
        u.pm = fm + ((wgid % nig) % gsz); u.pn = (wgid % nig) / gsz; return true;
    }
    __device__ __forceinline__ void a_ready(const Unit&) const {}
    __device__ __forceinline__ void done(const Unit&) const {}
};

__device__ __forceinline__ unsigned cvt_pk_bf16(float lo, float hi) { unsigned r; asm volatile("v_cvt_pk_bf16_f32 %0, %1, %2" : "=v"(r) : "v"(lo), "v"(hi)); return r; }
typedef float f32x2 __attribute__((ext_vector_type(2)));
template <class Epi, class Sched, bool ALIGN_EPI = false, bool SP2 = false>
__device__ __forceinline__ void gemm_phase(PG8_LAS unsigned char* lds, const Gemm g, const Sched& S, const Epi& E) {
    const int tid = otid(), wid = __builtin_amdgcn_readfirstlane(tid >> 6), lane = tid & 63, wr = wid >> 2, wc = wid & 3, fr = lane & 15, fq = lane >> 4;
    const int K = g.K, nt = K / BK;
    unsigned voffA[2], voffB[2];
#pragma unroll
    for (int i = 0; i < 2; ++i) { int R, C; stage_rc(tid * 16 + i * 8192, R, C); const int Rb = Epi::PERM ? ((R & ~31) + perm32(R & 31)) : R;
        voffA[i] = (unsigned)(R * K + C) * 2u; voffB[i] = (unsigned)(Rb * K + C) * 2u; }
    const size_t kstep = (size_t)(BK * 2);
    const size_t hstep = (size_t)HALF * K * 2;
    const size_t tstep = 2 * hstep;
    const unsigned ldsw = (unsigned)wid * 1024u;
    const int aoff = lds_byte(wr * 64 + fr, fq * 8), boff = lds_byte(wc * 32 + fr, fq * 8);
#define PG8_SA(b, h) (((b) * 2 + (h)) * HTB)
#define PG8_SB(b, h) ((4 + (b) * 2 + (h)) * HTB)
#define PG8_STAGE(bufoff, gbase, voff) do { _Pragma("unroll") for (int _i = 0; _i < 2; ++_i) \
        __builtin_amdgcn_global_load_lds((const unsigned*)((const char*)(gbase) + (voff)[_i]), (PG8_LAS unsigned*)(lds + (bufoff) + ldsw + _i * 8192), 16, 0, 0); } while (0)
#define PG8_LDA(dst, b, h) do { _Pragma("unroll") for (int m = 0; m < 4; ++m) _Pragma("unroll") for (int k = 0; k < 2; ++k) dst[m][k] = *(const PG8_LAS bf16x8*)(lds + PG8_SA(b, h) + aoff + m * 2048 + k * 1024); } while (0)
#define PG8_LDB(dst, b, h) do { _Pragma("unroll") for (int n = 0; n < 2; ++n) _Pragma("unroll") for (int k = 0; k < 2; ++k) dst[n][k] = *(const PG8_LAS bf16x8*)(lds + PG8_SB(b, h) + boff + n * 2048 + k * 1024); } while (0)
#define PG8_MMA(ai, bj, At, Bt) do { __builtin_amdgcn_s_setprio(1); _Pragma("unroll") for (int m = 0; m < 4; ++m) _Pragma("unroll") for (int n = 0; n < 2; ++n) _Pragma("unroll") for (int k = 0; k < 2; ++k) \
        acc[ai][bj][m][n] = __builtin_amdgcn_mfma_f32_16x16x32_bf16(Bt[n][k], At[m][k], acc[ai][bj][m][n], 0, 0, 0); __builtin_amdgcn_s_setprio(0); } while (0)
#define PG8_WAIT_V(n) asm volatile("s_waitcnt vmcnt(" #n ")" ::: "memory")
#define PG8_WAIT_L(n) asm volatile("s_waitcnt lgkmcnt(" #n ")" ::: "memory")
#define PG8_BAR __builtin_amdgcn_s_barrier()
#define PG8_SCHED __builtin_amdgcn_sched_barrier(0)
    Unit cur, nxt; int ui = 0;
    if (!S.next(0, cur)) return;
    f32x4 acc[2][2][4][2];
#pragma unroll
    for (int a = 0; a < 2; ++a)
#pragma unroll
        for (int b = 0; b < 2; ++b)
#pragma unroll
            for (int m = 0; m < 4; ++m)
#pragma unroll
                for (int n = 0; n < 2; ++n) acc[a][b][m][n] = (f32x4){0.f, 0.f, 0.f, 0.f};
    bf16x8 At[4][2], B0[2][2], B1[2][2];
    const char* cA = (const char*)g.A + (size_t)cur.pm * tstep; const char* cB = (const char*)g.Bt + (size_t)cur.pn * tstep;
    S.a_ready(cur);
    if constexpr (SP2) {
        PG8_STAGE(PG8_SB(0, 0), cB, voffB); PG8_STAGE(PG8_SB(0, 1), cB + hstep, voffB); PG8_STAGE(PG8_SA(0, 0), cA, voffA); PG8_STAGE(PG8_SA(0, 1), cA + hstep, voffA);
        if (wr == 1) PG8_BAR;
        PG8_WAIT_V(2); PG8_BAR;
        PG8_STAGE(PG8_SB(1, 0), cB + kstep, voffB); PG8_STAGE(PG8_SA(1, 0), cA + kstep, voffA); PG8_STAGE(PG8_SB(1, 1), cB + hstep + kstep, voffB);
        PG8_WAIT_V(6); PG8_BAR;
    } else {
        PG8_STAGE(PG8_SB(0, 0), cB, voffB); PG8_STAGE(PG8_SA(0, 0), cA, voffA); PG8_STAGE(PG8_SB(0, 1), cB + hstep, voffB); PG8_STAGE(PG8_SA(0, 1), cA + hstep, voffA);
        if (wr == 1) PG8_BAR;
        PG8_WAIT_V(4); PG8_BAR;
        PG8_STAGE(PG8_SB(1, 0), cB + kstep, voffB); PG8_STAGE(PG8_SA(1, 0), cA + kstep, voffA); PG8_STAGE(PG8_SB(1, 1), cB + hstep + kstep, voffB);
        PG8_WAIT_V(6); PG8_BAR;
    }
    for (;;) {
        const bool has_next = S.next(ui + 1, nxt);
        const char* nA = has_next ? (const char*)g.A + (size_t)nxt.pm * tstep : cA; const char* nB = has_next ? (const char*)g.Bt + (size_t)nxt.pn * tstep : cB;
        for (int t = 0; t < nt; t += 2) {
            const bool last = (t == nt - 2);
            const char* a1 = cA + (size_t)(t + 1) * kstep;
            const char* a2 = last ? nA : cA + (size_t)(t + 2) * kstep; const char* b2 = last ? nB : cB + (size_t)(t + 2) * kstep;
            const char* a3 = a2 + kstep; const char* b3 = b2 + kstep;
            if (last && has_next) S.a_ready(nxt);
            if constexpr (SP2) {
            PG8_LDB(B0, 0, 0); PG8_LDB(B1, 0, 1); PG8_SCHED; PG8_LDA(At, 0, 0); PG8_STAGE(PG8_SA(1, 1), a1 + hstep, voffA);
            PG8_WAIT_V(8); PG8_WAIT_L(0); PG8_BAR; PG8_MMA(0, 0, At, B0); PG8_MMA(0, 1, At, B1); PG8_BAR; PG8_SCHED;
            PG8_LDA(At, 0, 1); PG8_STAGE(PG8_SB(0, 0), b2, voffB); PG8_STAGE(PG8_SB(0, 1), b2 + hstep, voffB); PG8_STAGE(PG8_SA(0, 0), a2, voffA);
            PG8_WAIT_V(8); PG8_WAIT_L(0); PG8_BAR; PG8_MMA(1, 0, At, B0); PG8_MMA(1, 1, At, B1); PG8_BAR; PG8_SCHED;
            PG8_LDB(B0, 1, 0); PG8_LDB(B1, 1, 1); PG8_SCHED; PG8_LDA(At, 1, 0); PG8_STAGE(PG8_SA(0, 1), a2 + hstep, voffA);
            PG8_WAIT_V(8); PG8_WAIT_L(0); PG8_BAR; PG8_MMA(0, 0, At, B0); PG8_MMA(0, 1, At, B1); PG8_BAR; PG8_SCHED;
            PG8_LDA(At, 1, 1); PG8_STAGE(PG8_SB(1, 0), b3, voffB); PG8_STAGE(PG8_SB(1, 1), b3 + hstep, voffB); PG8_STAGE(PG8_SA(1, 0), a3, voffA);
            PG8_WAIT_V(8); PG8_WAIT_L(0); PG8_BAR; PG8_MMA(1, 0, At, B0); PG8_MMA(1, 1, At, B1); PG8_BAR; PG8_SCHED;
            } else {
            PG8_LDB(B0, 0, 0); PG8_SCHED; PG8_LDA(At, 0, 0); PG8_STAGE(PG8_SA(1, 1), a1 + hstep, voffA);
            PG8_WAIT_L(8); PG8_BAR; PG8_WAIT_L(0); PG8_MMA(0, 0, At, B0); PG8_BAR; PG8_SCHED;
            PG8_LDB(B1, 0, 1); PG8_STAGE(PG8_SB(0, 0), b2, voffB);
            PG8_BAR; PG8_WAIT_L(0); PG8_MMA(0, 1, At, B1); PG8_BAR;
            PG8_LDA(At, 0, 1); PG8_STAGE(PG8_SA(0, 0), a2, voffA);
            PG8_BAR; PG8_WAIT_L(0); PG8_MMA(1, 0, At, B0); PG8_BAR; PG8_SCHED;
            PG8_STAGE(PG8_SB(0, 1), b2 + hstep, voffB);
            PG8_WAIT_V(6); PG8_BAR; PG8_MMA(1, 1, At, B1); PG8_BAR;
            PG8_LDB(B0, 1, 0); PG8_SCHED; PG8_LDA(At, 1, 0); PG8_STAGE(PG8_SA(0, 1), a2 + hstep, voffA);
            PG8_WAIT_L(8); PG8_BAR; PG8_WAIT_L(0); PG8_MMA(0, 0, At, B0); PG8_BAR; PG8_SCHED;
            PG8_LDB(B1, 1, 1); PG8_STAGE(PG8_SB(1, 0), b3, voffB);
            PG8_BAR; PG8_WAIT_L(0); PG8_MMA(0, 1, At, B1); PG8_BAR;
            PG8_LDA(At, 1, 1); PG8_STAGE(PG8_SA(1, 0), a3, voffA);
            PG8_BAR; PG8_WAIT_L(0); PG8_MMA(1, 0, At, B0); PG8_BAR; PG8_SCHED;
            PG8_STAGE(PG8_SB(1, 1), b3 + hstep, voffB);
            PG8_WAIT_V(6); PG8_BAR; PG8_MMA(1, 1, At, B1); PG8_BAR;
            }
        }
        if constexpr (ALIGN_EPI) { if (wr == 0) PG8_BAR; }
        if constexpr (!Epi::AFTER_DRAIN) { E(acc, cur, wr, wc, fr, fq); S.done(cur); }
        if (!has_next) break;
#pragma unroll
        for (int a = 0; a < 2; ++a)
#pragma unroll
            for (int b = 0; b < 2; ++b)
#pragma unroll
                for (int m = 0; m < 4; ++m)
#pragma unroll
                    for (int n = 0; n < 2; ++n) acc[a][b][m][n] = (f32x4){0.f, 0.f, 0.f, 0.f};
        cur = nxt; cA = nA; cB = nB; ++ui;
        if constexpr (ALIGN_EPI) { if (wr == 1) PG8_BAR; }
    }
    PG8_WAIT_V(0);
    if constexpr (!ALIGN_EPI) { if (wr == 0) PG8_BAR; }
    PG8_BAR;
    if constexpr (Epi::AFTER_DRAIN) { E.fused(acc, cur, wr, wc, fr, fq, lds, wid, lane); S.done(cur); }
#undef PG8_SA
#undef PG8_SB
#undef PG8_STAGE
#undef PG8_LDA
#undef PG8_LDB
#undef PG8_MMA
#undef PG8_WAIT_V
#undef PG8_WAIT_L
#undef PG8_BAR
#undef PG8_SCHED
}
}
namespace pg8 {
typedef unsigned u32x2 __attribute__((ext_vector_type(2)));
__device__ __forceinline__ float bf2f(unsigned short h) { return __uint_as_float(((unsigned)h) << 16); }
__device__ __forceinline__ unsigned short f2bf_rne(float f) { unsigned u = __float_as_uint(f); return (unsigned short)((u + 0x7fffu + ((u >> 16) & 1u)) >> 16); }
__device__ __forceinline__ float sigmoidf_(float v) { return 1.0f / (1.0f + __expf(-v)); }
__device__ __forceinline__ float logsigf_(float z) { return fminf(z, 0.f) - log1pf(__expf(-fabsf(z))); }
__device__ __forceinline__ u32x4 pack8(const f32x4 a, const f32x4 b) { u32x4 w; w.x = cvt_pk_bf16(a[0], a[1]); w.y = cvt_pk_bf16(a[2], a[3]); w.z = cvt_pk_bf16(b[0], b[1]); w.w = cvt_pk_bf16(b[2], b[3]); return w; }
__device__ __forceinline__ void split8(const f32x4 a, const f32x4 b, u32x4& hi, u32x4& lo) {
    hi = pack8(a, b);
    f32x4 ra, rb;
    ra[0] = a[0] - __uint_as_float(hi.x << 16); ra[1] = a[1] - __uint_as_float(hi.x & 0xffff0000u);
    ra[2] = a[2] - __uint_as_float(hi.y << 16); ra[3] = a[3] - __uint_as_float(hi.y & 0xffff0000u);
    rb[0] = b[0] - __uint_as_float(hi.z << 16); rb[1] = b[1] - __uint_as_float(hi.z & 0xffff0000u);
    rb[2] = b[2] - __uint_as_float(hi.w << 16); rb[3] = b[3] - __uint_as_float(hi.w & 0xffff0000u);
    lo = pack8(ra, rb);
}
#define PG8_FOR8(...) \
  _Pragma("unroll") for (int ai = 0; ai < 2; ++ai) _Pragma("unroll") for (int m = 0; m < 4; ++m) { const int lrow = ai * HALF + wr * 64 + m * 16 + fr; \
    _Pragma("unroll") for (int bj = 0; bj < 2; ++bj) { const int lcol = bj * HALF + wc * 32 + 8 * fq; f32x4 v0 = acc[ai][bj][m][0], v1 = acc[ai][bj][m][1]; __VA_ARGS__ } asm volatile("" ::: "memory"); }

struct EpiQK {
    static constexpr bool PERM = true, AFTER_DRAIN = false;
    bf16_t* QK; float* LF; const float* bf; float qscale;
    __device__ __forceinline__ void operator()(const f32x4 (&acc)[2][2][4][2], const Unit& u, int wr, int wc, int fr, int fq) const {
        const int pn = u.pn;
        if (pn < 8) { const float sc = pn < 4 ? qscale : 1.f;
            PG8_FOR8({ const unsigned row = (unsigned)u.pm * BM + lrow; *(u32x4*)(QK + row * 2048 + pn * 256 + lcol) = pack8(v0 * sc, v1 * sc); })
        } else {
            PG8_FOR8({ if (lcol < 16) { const unsigned row = (unsigned)u.pm * BM + lrow; f32x4 o0, o1;
                _Pragma("unroll") for (int i = 0; i < 4; ++i) { o0[i] = logsigf_(v0[i] + bf[lcol + i]); o1[i] = logsigf_(v1[i] + bf[lcol + 4 + i]); }
                *(f32x4*)(LF + row * 16 + lcol) = o0; *(f32x4*)(LF + row * 16 + lcol + 4) = o1; } })
        }
    }
};
struct EpiVt {
    static constexpr bool PERM = false, AFTER_DRAIN = false;
    bf16_t* VT; int ld; int vf_rows;
    __device__ __forceinline__ void operator()(const f32x4 (&acc)[2][2][4][2], const Unit& u, int wr, int wc, int fr, int fq) const {
#pragma unroll
        for (int ai = 0; ai < 2; ++ai)
#pragma unroll
            for (int m = 0; m < 4; ++m) { const unsigned row = (unsigned)u.pm * BM + ai * HALF + wr * 64 + m * 16 + fr;
#pragma unroll
                for (int bj = 0; bj < 2; ++bj)
#pragma unroll
                    for (int n = 0; n < 2; ++n) { const unsigned tok0 = u.pn * BM + bj * HALF + wc * 32 + 16 * n; const f32x4 v = acc[ai][bj][m][n];
                        u32x2 w; w.x = cvt_pk_bf16(v[0], v[1]); w.y = cvt_pk_bf16(v[2], v[3]);
                        if ((int)row < vf_rows) { const unsigned g = row >> 6, d = row & 63, db = d >> 5, r = d & 31, b = tok0 >> 13, s0 = tok0 & 8191, blk = s0 >> 6, ks = (s0 >> 4) & 3;
                            *(u32x2*)(VT + (((((b * 4 + g) * 128 + blk) * 2 + db) * 4 + ks) * 512 + ((fq & 1) * 32 + r) * 8 + 4 * (fq >> 1))) = w; }
                        else *(u32x2*)(VT + row * ld + tok0 + 8 * (fq & 1) + 4 * (fq >> 1)) = w; } }
    }
};
struct EpiF32 {
    static constexpr bool PERM = true, AFTER_DRAIN = false;
    float* Y; int ld;
    __device__ __forceinline__ void operator()(const f32x4 (&acc)[2][2][4][2], const Unit& u, int wr, int wc, int fr, int fq) const {
        PG8_FOR8({ float* p = Y + (unsigned)(((unsigned)u.pm * BM + lrow) * ld + u.pn * BM + lcol); *(f32x4*)p = v0; *(f32x4*)(p + 4) = v1; })
    }
};
template <int ACT  > struct EpiAct {
    static constexpr bool PERM = true, AFTER_DRAIN = false;
    bf16_t* O; int ld;
    __device__ __forceinline__ void operator()(const f32x4 (&acc)[2][2][4][2], const Unit& u, int wr, int wc, int fr, int fq) const {
        PG8_FOR8({ if (ACT == 1) { _Pragma("unroll") for (int i = 0; i < 4; ++i) { const float a = fmaxf(v0[i], 0.f), b = fmaxf(v1[i], 0.f); v0[i] = a * a; v1[i] = b * b; } }
            *(u32x4*)(O + (unsigned)(((unsigned)u.pm * BM + lrow) * ld + u.pn * BM + lcol)) = pack8(v0, v1); })
    }
};
struct EpiGate {
    static constexpr bool PERM = true, AFTER_DRAIN = false;
    float* X; const bf16_t* PW;
    __device__ __forceinline__ void operator()(const f32x4 (&acc)[2][2][4][2], const Unit& u, int wr, int wc, int fr, int fq) const {
        PG8_FOR8({ const unsigned off = ((unsigned)u.pm * BM + lrow) * 1024 + u.pn * BM + lcol; float* xp = X + off;
            const u32x4 pw = *(const u32x4*)(PW + off); f32x4 x0 = *(const f32x4*)xp, x1 = *(const f32x4*)(xp + 4);
            x0[0] += sigmoidf_(v0[0]) * __uint_as_float(pw.x << 16); x0[1] += sigmoidf_(v0[1]) * __uint_as_float(pw.x & 0xffff0000u);
            x0[2] += sigmoidf_(v0[2]) * __uint_as_float(pw.y << 16); x0[3] += sigmoidf_(v0[3]) * __uint_as_float(pw.y & 0xffff0000u);
            x1[0] += sigmoidf_(v1[0]) * __uint_as_float(pw.z << 16); x1[1] += sigmoidf_(v1[1]) * __uint_as_float(pw.z & 0xffff0000u);
            x1[2] += sigmoidf_(v1[2]) * __uint_as_float(pw.w << 16); x1[3] += sigmoidf_(v1[3]) * __uint_as_float(pw.w & 0xffff0000u);
            *(f32x4*)xp = x0; *(f32x4*)(xp + 4) = x1; })
    }
};
struct EpiNsaA {
    static constexpr bool PERM = true, AFTER_DRAIN = false;
    bf16_t *QH, *QL, *KH, *KL; float qscale;
    __device__ __forceinline__ void operator()(const f32x4 (&acc)[2][2][4][2], const Unit& u, int wr, int wc, int fr, int fq) const {
        const int pn = u.pn;
        PG8_FOR8({ const unsigned row = (unsigned)u.pm * BM + lrow; u32x4 h, l;
            if (pn < 4) { split8(v0 * qscale, v1 * qscale, h, l); const unsigned off = row * 1024 + pn * 256 + lcol; *(u32x4*)(QH + off) = h; *(u32x4*)(QL + off) = l; }
            else { split8(v0, v1, h, l); const unsigned b = row >> 13, s = row & 8191; const int g = lcol >> 6, d = lcol & 63;
                const unsigned off = ((b * 4 + g) * 8192 + s) * 64 + d; *(u32x4*)(KH + off) = h; *(u32x4*)(KL + off) = l; } })
    }
};
struct EpiNsaB {
    static constexpr bool PERM = true, AFTER_DRAIN = false;
    bf16_t *VC, *KS, *KW; float* GATE;
    __device__ __forceinline__ void operator()(const f32x4 (&acc)[2][2][4][2], const Unit& u, int wr, int wc, int fr, int fq) const {
        const int pn = u.pn;
        PG8_FOR8({ const unsigned row = (unsigned)u.pm * BM + lrow;
            if (pn == 0) { const unsigned b = row >> 13, s = row & 8191; const int g = lcol >> 6, d = lcol & 63; *(u32x4*)(VC + ((b * 4 + g) * 8192 + s) * 64 + d) = pack8(v0, v1); }
            else if (pn == 1) { const unsigned b = row >> 13, s = row & 8191; const unsigned g = lcol >> 6, d = lcol & 63;
                *(u32x4*)(KS + (((((b * 4 + g) * 128 + (s >> 6)) * 2 + ((s >> 5) & 1)) * 4 + (d >> 4)) * 512 + ((((d >> 3) & 1) * 32 + (s & 31)) * 8))) = pack8(v0, v1); }
            else if (pn == 2) { *(u32x4*)(KW + row * 256 + lcol) = pack8(v0, v1); }
            else if (lcol < 48) { f32x4 o0, o1; _Pragma("unroll") for (int i = 0; i < 4; ++i) { o0[i] = sigmoidf_(v0[i]); o1[i] = sigmoidf_(v1[i]); }
                *(f32x4*)(GATE + row * 48 + lcol) = o0; *(f32x4*)(GATE + row * 48 + lcol + 4) = o1; } })
    }
};
}
namespace fa {
using pg8::bf16_t; using pg8::bf16x8; using pg8::f32x4; using pg8::u32x4; using pg8::u32x2;
typedef float f32x16 __attribute__((ext_vector_type(16)));
#define LAS __attribute__((address_space(3)))
constexpr int ROWB = 144;
constexpr int L_STASH = 57344;
constexpr int L_K0 = 0, L_K1 = 9216, L_V0 = 18432, L_V1 = 36864, L_B0 = 55296, L_B1 = 55552, L_TAB = 55808, L_END = 56320;
constexpr float NEGV = -1e30f;
__device__ __forceinline__ int crow(int r, int hi) { return (r & 3) + 8 * (r >> 2) + 4 * hi; }
__device__ __forceinline__ float ex2(float v) { return __builtin_amdgcn_exp2f(v); }
__device__ __forceinline__ bf16x8 packp(const f32x16& p, int s) {
    u32x4 w; w.x = pg8::cvt_pk_bf16(p[8 * s + 0], p[8 * s + 1]); w.y = pg8::cvt_pk_bf16(p[8 * s + 2], p[8 * s + 3]);
    w.z = pg8::cvt_pk_bf16(p[8 * s + 4], p[8 * s + 5]); w.w = pg8::cvt_pk_bf16(p[8 * s + 6], p[8 * s + 7]); return __builtin_bit_cast(bf16x8, w);
}
struct FlashArgs {
    const bf16_t* Q; int ldq;
    const bf16_t* K; int ldk;
    const bf16_t* Vt; int ldv;
    int q0, t_lo, t_hi, pa, pb, window;
    const float* kbias;
    const float* tab;
    bf16_t* O; int ldo;
    const float* gate; int ldg;
    float lam, oscale; const float* sg;
};
__device__ __forceinline__ float xhalf_max(float m) { auto rr = __builtin_amdgcn_permlane32_swap(__float_as_uint(m), __float_as_uint(m), false, false); return fmaxf(__uint_as_float(rr[0]), __uint_as_float(rr[1])); }
#define FA_GK(t) do { kreg = *(const u32x4*)(a.K + (size_t)(64 * (t) + srow) * a.ldk + sch * 8); } while (0)
#define FA_GV(t) do { _Pragma("unroll") for (int i_ = 0; i_ < NVB; ++i_) vreg[i_] = *(const u32x4*)(a.Vt + (size_t)(srow + 64 * i_) * a.ldv + 64 * (t) + sch * 8); \
    if (BIAS == 1) { if (tid < 16) breg = *(const f32x4*)(a.kbias + 64 * (t) + 4 * tid); } } while (0)
#define FA_SK(b_) do { *(LAS u32x4*)(lds + ((b_) ? L_K1 : L_K0) + srow * ROWB + sch * 16) = kreg; } while (0)
#define FA_SV(b_) do { _Pragma("unroll") for (int i_ = 0; i_ < NVB; ++i_) *(LAS u32x4*)(lds + ((b_) ? L_V1 : L_V0) + (srow + 64 * i_) * ROWB + sch * 16) = vreg[i_]; \
    if (BIAS == 1) { if (tid < 16) *(LAS f32x4*)(lds + ((b_) ? L_B1 : L_B0) + 16 * tid) = breg; } } while (0)
template <int DV, int BIAS, bool MAIN, int DIR>
__device__ __forceinline__ void fa_iter(LAS unsigned char* lds, const FlashArgs& a, const int t, const int tid, const int srow, const int sch, const int r32, const int hi, const int qw0, const int qpos,
                                        const bf16x8 (&qf)[4], f32x16 (&o)[DV / 32], f32x16& c0, f32x16& c1, float& m_run, float& l_run, bool& cur_needed, u32x4& kreg, u32x4 (&vreg)[DV / 64], f32x4& breg) {
    constexpr int NVB = DV / 64, NDB = DV / 32;
    const LAS float* tabL = (const LAS float*)(lds + L_TAB);
    const int t1 = t + DIR, t2 = t + 2 * DIR;
    const bool hk = MAIN || (t2 >= a.t_lo && t2 <= a.t_hi), hv = MAIN || (t1 >= a.t_lo && t1 <= a.t_hi);
    if (hk) FA_GK(t2);
    if (hv) FA_GV(t1);
    bool nn = MAIN;
    if (!MAIN) { if (hv) { const int minp = a.pa * (64 * t1) + a.pb, maxp = minp + a.pa * 63; nn = (minp <= qw0 + 31) && (maxp > qw0 - a.window); } }
    const bool cn = MAIN || cur_needed;
    bool skip_b2 = false;
    if (cn) {
        if (BIAS == 1) {
            const LAS unsigned char* bb = lds + ((t & 1) ? L_B1 : L_B0);
#pragma unroll
            for (int g = 0; g < 4; ++g) { const f32x4 b0 = *(const LAS f32x4*)(bb + (8 * g + 4 * hi) * 4), b1 = *(const LAS f32x4*)(bb + (32 + 8 * g + 4 * hi) * 4);
#pragma unroll
                for (int i = 0; i < 4; ++i) { c0[4 * g + i] += b0[i]; c1[4 * g + i] += b1[i]; } }
        }
        if (!MAIN) {
            const int minpos = a.pa * (64 * t) + a.pb, maxpos = minpos + a.pa * 63;
            const bool full = (maxpos <= qw0) && (minpos > qw0 + 31 - a.window);
            const bool nearb = (BIAS == 2) && (maxpos >= qw0 - 127);
            if (!full || nearb) {
#pragma unroll
                for (int r = 0; r < 16; ++r) { const int kv = crow(r, hi); const int d0_ = qpos - (minpos + a.pa * kv), d1_ = d0_ - 32 * a.pa;
                    if (BIAS == 2) { c0[r] += tabL[min(max(d0_, 0), 127)]; c1[r] += tabL[min(max(d1_, 0), 127)]; }
                    if (d0_ < 0 || d0_ >= a.window) c0[r] = NEGV;
                    if (d1_ < 0 || d1_ >= a.window) c1[r] = NEGV; }
            }
        }
        float mx = fmaxf(c0[0], c1[0]);
#pragma unroll
        for (int r = 1; r < 16; ++r) mx = fmaxf(mx, fmaxf(c0[r], c1[r]));
        mx = xhalf_max(mx);
        const bool real = m_run > -1e29f, seen = mx > -1e29f;
        if (DIR < 0) skip_b2 = !__any(!real || mx > -150.f);
        if (__any(real ? (mx > 8.f) : seen)) {
            const float dl = real ? fmaxf(mx, 0.f) : (seen ? mx : 0.f);
            const float al = real ? ex2(-dl) : 0.f;
            m_run = real ? (m_run + dl) : (seen ? mx : m_run);
            l_run *= al;
#pragma unroll
            for (int r = 0; r < 16; ++r) { c0[r] -= dl; c1[r] -= dl; }
#pragma unroll
            for (int i = 0; i < NDB; ++i)
#pragma unroll
                for (int r = 0; r < 16; ++r) o[i][r] *= al;
        }
    }
    f32x16 n0, n1;
    if (nn) {
        const float refn = (m_run > -1e29f) ? m_run : 0.f;
        const LAS unsigned char* kb = lds + (((t + 1) & 1) ? L_K1 : L_K0);
#pragma unroll
        for (int r = 0; r < 16; ++r) { n0[r] = -refn; n1[r] = -refn; }
        bf16x8 kf0[4], kf1[4];
#pragma unroll
        for (int d0 = 0; d0 < 4; ++d0) { kf0[d0] = *(const LAS bf16x8*)(kb + r32 * ROWB + (2 * d0 + hi) * 16); kf1[d0] = *(const LAS bf16x8*)(kb + (32 + r32) * ROWB + (2 * d0 + hi) * 16); }
        __builtin_amdgcn_sched_barrier(0);
#pragma unroll
        for (int d0 = 0; d0 < 4; ++d0) {
            n0 = __builtin_amdgcn_mfma_f32_32x32x16_bf16(kf0[d0], qf[d0], n0, 0, 0, 0);
            n1 = __builtin_amdgcn_mfma_f32_32x32x16_bf16(kf1[d0], qf[d0], n1, 0, 0, 0);
        }
    }
    if (cn && !skip_b2) {
        const LAS unsigned char* vb = lds + ((t & 1) ? L_V1 : L_V0);
        float rs = 0.f;
#pragma unroll
        for (int r = 0; r < 16; ++r) { c0[r] = ex2(c0[r]); c1[r] = ex2(c1[r]); rs += c0[r] + c1[r]; }
        l_run += rs;
        bf16x8 pf[4]; pf[0] = packp(c0, 0); pf[1] = packp(c0, 1); pf[2] = packp(c1, 0); pf[3] = packp(c1, 1);
#pragma unroll
        for (int dh = 0; dh < NDB / 2; ++dh) {
            bf16x8 vf[8];
#pragma unroll
            for (int i = 0; i < 8; ++i) vf[i] = *(const LAS bf16x8*)(vb + (32 * (2 * dh + (i >> 2)) + r32) * ROWB + (2 * (i & 3) + hi) * 16);
            __builtin_amdgcn_sched_barrier(0);
    #pragma unroll
            for (int i = 0; i < 8; ++i) o[2 * dh + (i >> 2)] = __builtin_amdgcn_mfma_f32_32x32x16_bf16(vf[i], pf[i & 3], o[2 * dh + (i >> 2)], 0, 0, 0);
                __builtin_amdgcn_sched_barrier(0);
        }
    }
    if (hk) FA_SK(t & 1);
    if (hv) FA_SV((t + 1) & 1);
    __syncthreads();
    if (nn) { c0 = n0; c1 = n1; }
    cur_needed = nn;
}
template <int DV, int BIAS, int OUT, int DIR = 1>
__device__ __forceinline__ void flash_unit_reg(LAS unsigned char* lds, const FlashArgs& a) {
    const int tid = otid(), lane = tid & 63, wid = __builtin_amdgcn_readfirstlane(tid >> 6), r32 = lane & 31, hi = lane >> 5;
    const int srow = tid >> 3, sch = tid & 7;
    constexpr int NVB = DV / 64, NDB = DV / 32;
    u32x4 kreg, vreg[NVB]; f32x4 breg = (f32x4){0.f, 0.f, 0.f, 0.f};
    const int tfirst = (DIR > 0) ? a.t_lo : a.t_hi;
    FA_GK(tfirst);
    if (BIAS == 2) { if (tid < 128) *(LAS float*)(lds + L_TAB + 4 * tid) = a.tab[tid]; }
    bf16x8 qf[4];
#pragma unroll
    for (int d0 = 0; d0 < 4; ++d0) qf[d0] = *(const bf16x8*)(a.Q + (size_t)(32 * wid + r32) * a.ldq + 16 * d0 + 8 * hi);
    FA_SK(tfirst & 1);
    __syncthreads();
    const int qw0 = a.q0 + 32 * wid, qpos = qw0 + r32;
    float m_run = NEGV, l_run = 0.f;
    f32x16 o[NDB], c0, c1;
#pragma unroll
    for (int i = 0; i < NDB; ++i)
#pragma unroll
        for (int r = 0; r < 16; ++r) o[i][r] = 0.f;
#pragma unroll
    for (int r = 0; r < 16; ++r) { c0[r] = 0.f; c1[r] = 0.f; }
    bool cur_needed = false;
    int tm0, tm1;
    { const int lim = (BIAS == 2) ? (a.q0 - 128) : a.q0;
      const int num = lim - a.pb - 63 * a.pa;
      int tl = (num >= 0) ? (num / (64 * a.pa)) - 1 : -1;
      tl = min(tl, a.t_hi - 2);
      int tf = a.t_lo;
      if (a.window < (1 << 29)) { const int x = a.q0 + 255 - a.window - a.pb; if (x >= 0) tf = max(tf, x / (64 * a.pa) + 1); }
      tm0 = tf + 1; tm1 = tl + 1;
      if (tm1 < tm0) { tm0 = a.t_hi + 1; tm1 = tm0; } }
    if (DIR > 0) {
        int t = a.t_lo - 1;
        for (; t < tm0 && t <= a.t_hi; ++t) fa_iter<DV, BIAS, false, 1>(lds, a, t, tid, srow, sch, r32, hi, qw0, qpos, qf, o, c0, c1, m_run, l_run, cur_needed, kreg, vreg, breg);
        for (; t < tm1; ++t) fa_iter<DV, BIAS, true, 1>(lds, a, t, tid, srow, sch, r32, hi, qw0, qpos, qf, o, c0, c1, m_run, l_run, cur_needed, kreg, vreg, breg);
        for (; t <= a.t_hi; ++t) fa_iter<DV, BIAS, false, 1>(lds, a, t, tid, srow, sch, r32, hi, qw0, qpos, qf, o, c0, c1, m_run, l_run, cur_needed, kreg, vreg, breg);
    } else {
        const int tfull = (a.q0 - a.pb - 63 * a.pa >= 0) ? (a.q0 - a.pb - 63 * a.pa) / (64 * a.pa) : -1;
        int t = a.t_hi + 1;
        for (; t > tfull && t >= a.t_lo; --t) fa_iter<DV, BIAS, false, -1>(lds, a, t, tid, srow, sch, r32, hi, qw0, qpos, qf, o, c0, c1, m_run, l_run, cur_needed, kreg, vreg, breg);
        for (; t >= a.t_lo + 2; --t) fa_iter<DV, BIAS, true, -1>(lds, a, t, tid, srow, sch, r32, hi, qw0, qpos, qf, o, c0, c1, m_run, l_run, cur_needed, kreg, vreg, breg);
        for (; t >= a.t_lo; --t) fa_iter<DV, BIAS, false, -1>(lds, a, t, tid, srow, sch, r32, hi, qw0, qpos, qf, o, c0, c1, m_run, l_run, cur_needed, kreg, vreg, breg);
    }
    const float l_tot = l_run + __shfl_xor(l_run, 32);
    float inv = (m_run > -1e29f) ? 1.0f / l_tot : 0.f;
    if (OUT == 1) inv *= a.gate[(size_t)(32 * wid + r32) * a.ldg];
    if (OUT == 2) {
        LAS unsigned char* st = lds + L_STASH + (32 * wid + r32) * (DV * 2);
#pragma unroll
        for (int db = 0; db < NDB; ++db)
#pragma unroll
            for (int g = 0; g < 4; ++g) { u32x2 w; w.x = pg8::cvt_pk_bf16(o[db][4 * g] * inv, o[db][4 * g + 1] * inv); w.y = pg8::cvt_pk_bf16(o[db][4 * g + 2] * inv, o[db][4 * g + 3] * inv);
                *(LAS u32x2*)(st + (32 * db + 8 * g + 4 * hi) * 2) = w; }
    } else if (OUT == 3) {
        const LAS unsigned char* st = lds + L_STASH + (32 * wid + r32) * (DV * 2);
        float ss = 0.f;
#pragma unroll
        for (int db = 0; db < NDB; ++db)
#pragma unroll
            for (int g = 0; g < 4; ++g) { const u32x2 s0 = *(const LAS u32x2*)(st + (32 * db + 8 * g + 4 * hi) * 2);
                const float a0 = __uint_as_float(s0.x << 16), a1 = __uint_as_float(s0.x & 0xffff0000u), a2 = __uint_as_float(s0.y << 16), a3 = __uint_as_float(s0.y & 0xffff0000u);
                o[db][4 * g] = a0 - a.lam * (o[db][4 * g] * inv); o[db][4 * g + 1] = a1 - a.lam * (o[db][4 * g + 1] * inv); o[db][4 * g + 2] = a2 - a.lam * (o[db][4 * g + 2] * inv); o[db][4 * g + 3] = a3 - a.lam * (o[db][4 * g + 3] * inv);
                ss += (o[db][4 * g] * o[db][4 * g] + o[db][4 * g + 1] * o[db][4 * g + 1]) + (o[db][4 * g + 2] * o[db][4 * g + 2] + o[db][4 * g + 3] * o[db][4 * g + 3]); }
        { auto rr = __builtin_amdgcn_permlane32_swap(__float_as_uint(ss), __float_as_uint(ss), false, false); ss = __uint_as_float(rr[0]) + __uint_as_float(rr[1]); }
        const float rn = rsqrtf(ss * (1.0f / DV) + 1e-6f) * a.oscale;
        bf16_t* orow = a.O + (size_t)(32 * wid + r32) * a.ldo;
#pragma unroll
        for (int db = 0; db < NDB; ++db)
#pragma unroll
            for (int g = 0; g < 4; ++g) { const f32x4 gg = *(const f32x4*)(a.sg + 32 * db + 8 * g + 4 * hi);
                u32x2 w; w.x = pg8::cvt_pk_bf16(o[db][4 * g] * rn * gg[0], o[db][4 * g + 1] * rn * gg[1]); w.y = pg8::cvt_pk_bf16(o[db][4 * g + 2] * rn * gg[2], o[db][4 * g + 3] * rn * gg[3]);
                *(u32x2*)(orow + 32 * db + 8 * g + 4 * hi) = w; }
    } else {
        bf16_t* orow = a.O + (size_t)(32 * wid + r32) * a.ldo;
#pragma unroll
        for (int db = 0; db < NDB; ++db)
#pragma unroll
            for (int g = 0; g < 4; ++g) { u32x2 w; w.x = pg8::cvt_pk_bf16(o[db][4 * g] * inv, o[db][4 * g + 1] * inv); w.y = pg8::cvt_pk_bf16(o[db][4 * g + 2] * inv, o[db][4 * g + 3] * inv);
                *(u32x2*)(orow + 32 * db + 8 * g + 4 * hi) = w; }
    }
}
#undef FA_GK
#undef FA_GV
#undef FA_SK
#undef FA_SV
__device__ __forceinline__ void glds16(const void* gsrc, unsigned lds_dst) { unsigned keep;
    asm volatile("s_mov_b32 %0, m0\n\ts_mov_b32 m0, %2\n\ts_nop 0\n\tglobal_load_lds_dwordx4 %1, off\n\ts_mov_b32 m0, %0" : "=&s"(keep) : "v"(gsrc), "s"(lds_dst) : "memory"); }
__device__ __forceinline__ void glds4(const void* gsrc, unsigned lds_dst) { unsigned keep;
    asm volatile("s_mov_b32 %0, m0\n\ts_mov_b32 m0, %2\n\ts_nop 0\n\tglobal_load_lds_dword %1, off\n\ts_mov_b32 m0, %0" : "=&s"(keep) : "v"(gsrc), "s"(lds_dst) : "memory"); }
constexpr int D_K = 0, D_V = 32768, D_B = 32768 + 4 * 16384, D_TAB = D_B + 4 * 256, D_END = D_TAB + 512;
template <int DV, int BIAS, int OUT>
__device__ __forceinline__ void flash_unit(LAS unsigned char* lds, const FlashArgs& a) {
    const int tid = otid(), lane = tid & 63, wid = __builtin_amdgcn_readfirstlane(tid >> 6), r32 = lane & 31, hi = lane >> 5;
    constexpr int NVB = DV / 64, NDB = DV / 32, VSLOT = DV * 128, NP = 1 + NVB + (BIAS == 1 ? 1 : 0);
    static_assert(NP == 2 || NP == 3, "counted waits are written for 2 or 3 DMA pieces per wave and tile");
    const int drow = lane >> 3, dchunk = (lane & 7) ^ (((8 * wid + drow) >> 1) & 7);
    const bf16_t* ksrc = a.K + (size_t)(8 * wid + drow) * a.ldk + dchunk * 8;
    const bf16_t* vsrc = a.Vt + (size_t)(8 * wid + drow) * a.ldv + dchunk * 8;
    const unsigned lds0 = (unsigned)(__UINTPTR_TYPE__)lds;
#define FA_ISSUE(t_, s_) do { const unsigned so_ = (unsigned)__builtin_amdgcn_readfirstlane(s_); \
        glds16(ksrc + (size_t)(64 * (t_)) * a.ldk, (unsigned)__builtin_amdgcn_readfirstlane((int)(lds0 + D_K + so_ * 8192 + wid * 1024))); \
        _Pragma("unroll") for (int i_ = 0; i_ < NVB; ++i_) glds16(vsrc + (size_t)(64 * i_) * a.ldv + 64 * (t_), (unsigned)__builtin_amdgcn_readfirstlane((int)(lds0 + D_V + so_ * VSLOT + (wid + 8 * i_) * 1024))); \
        if (BIAS == 1) glds4(a.kbias + 64 * (t_) + lane, (unsigned)__builtin_amdgcn_readfirstlane((int)(lds0 + D_B + so_ * 256))); } while (0)
    int s_cur = 0;
    FA_ISSUE(a.t_lo, 0);
    if (a.t_lo + 1 <= a.t_hi) FA_ISSUE(a.t_lo + 1, 1);
    if (a.t_lo + 2 <= a.t_hi) FA_ISSUE(a.t_lo + 2, 2);
    if (BIAS == 2) { if (tid < 128) *(LAS float*)(lds + D_TAB + 4 * tid) = a.tab[tid]; }
    bf16x8 qf[4];
#pragma unroll
    for (int d0 = 0; d0 < 4; ++d0) qf[d0] = *(const bf16x8*)(a.Q + (size_t)(32 * wid + r32) * a.ldq + 16 * d0 + 8 * hi);
    asm volatile("" : "+v"(qf[0]), "+v"(qf[1]), "+v"(qf[2]), "+v"(qf[3]));
    asm volatile("s_waitcnt vmcnt(0) lgkmcnt(0)" ::: "memory");
    __builtin_amdgcn_s_barrier();
    asm volatile("" ::: "memory");
    const int qw0 = a.q0 + 32 * wid, qpos = qw0 + r32;
    float m_run = NEGV, l_run = 0.f;
    f32x16 o[NDB];
#pragma unroll
    for (int i = 0; i < NDB; ++i)
#pragma unroll
        for (int r = 0; r < 16; ++r) o[i][r] = 0.f;
    const LAS float* tabL = (const LAS float*)(lds + D_TAB);
    const int sw0 = ((r32 >> 1) & 7), sw1 = (((32 + r32) >> 1) & 7);
    for (int t = a.t_lo; t <= a.t_hi; ++t) {
        if (t + 2 <= a.t_hi) { if (NP == 3) asm volatile("s_waitcnt vmcnt(3)" ::: "memory"); else asm volatile("s_waitcnt vmcnt(2)" ::: "memory"); }
        else asm volatile("s_waitcnt vmcnt(0)" ::: "memory");
        asm volatile("s_waitcnt lgkmcnt(0)" ::: "memory");
        __builtin_amdgcn_s_barrier();
        asm volatile("" ::: "memory");
        const int s_nn = (s_cur + 3) & 3;
        if (t + 3 <= a.t_hi) FA_ISSUE(t + 3, s_nn);
        const int minpos = a.pa * (64 * t) + a.pb, maxpos = minpos + a.pa * 63;
        const bool needed = (minpos <= qw0 + 31) && (maxpos > qw0 - a.window);
        if (needed) {
            const LAS unsigned char* kb = lds + D_K + s_cur * 8192; const LAS unsigned char* vb = lds + D_V + s_cur * VSLOT;
            f32x16 p0, p1;
#pragma unroll
            for (int r = 0; r < 16; ++r) { p0[r] = 0.f; p1[r] = 0.f; }
#pragma unroll
            for (int d0 = 0; d0 < 4; ++d0) {
                const bf16x8 k0 = *(const LAS bf16x8*)(kb + r32 * 128 + (((2 * d0 + hi) ^ sw0) * 16));
                const bf16x8 k1 = *(const LAS bf16x8*)(kb + (32 + r32) * 128 + (((2 * d0 + hi) ^ sw1) * 16));
                p0 = __builtin_amdgcn_mfma_f32_32x32x16_bf16(k0, qf[d0], p0, 0, 0, 0);
                p1 = __builtin_amdgcn_mfma_f32_32x32x16_bf16(k1, qf[d0], p1, 0, 0, 0);
            }
            if (BIAS == 1) {
                const LAS unsigned char* bb = lds + D_B + s_cur * 256;
#pragma unroll
                for (int g = 0; g < 4; ++g) { const f32x4 b0 = *(const LAS f32x4*)(bb + (8 * g + 4 * hi) * 4), b1 = *(const LAS f32x4*)(bb + (32 + 8 * g + 4 * hi) * 4);
#pragma unroll
                    for (int i = 0; i < 4; ++i) { p0[4 * g + i] += b0[i]; p1[4 * g + i] += b1[i]; } }
            }
            const bool full = (maxpos <= qw0) && (minpos > qw0 + 31 - a.window);
            const bool nearb = (BIAS == 2) && (maxpos >= qw0 - 127);
            if (!full || nearb) {
#pragma unroll
                for (int r = 0; r < 16; ++r) { const int kv = crow(r, hi); const int d0_ = qpos - (minpos + a.pa * kv), d1_ = d0_ - 32 * a.pa;
                    if (BIAS == 2) { p0[r] += tabL[min(max(d0_, 0), 127)]; p1[r] += tabL[min(max(d1_, 0), 127)]; }
                    if (d0_ < 0 || d0_ >= a.window) p0[r] = NEGV;
                    if (d1_ < 0 || d1_ >= a.window) p1[r] = NEGV; }
            }
            float mx = fmaxf(p0[0], p1[0]);
#pragma unroll
            for (int r = 1; r < 16; ++r) mx = fmaxf(mx, fmaxf(p0[r], p1[r]));
            mx = xhalf_max(mx);
            if (__any(mx > m_run + 8.f)) {
                const float mn = fmaxf(m_run, mx), al = ex2(m_run - mn); l_run *= al; m_run = mn;
#pragma unroll
                for (int i = 0; i < NDB; ++i)
#pragma unroll
                    for (int r = 0; r < 16; ++r) o[i][r] *= al;
            }
            float rs = 0.f;
#pragma unroll
            for (int r = 0; r < 16; ++r) { p0[r] = ex2(p0[r] - m_run); p1[r] = ex2(p1[r] - m_run); rs += p0[r] + p1[r]; }
            l_run += rs;
            bf16x8 pf[4]; pf[0] = packp(p0, 0); pf[1] = packp(p0, 1); pf[2] = packp(p1, 0); pf[3] = packp(p1, 1);
#pragma unroll
            for (int db = 0; db < NDB; ++db)
#pragma unroll
                for (int ks = 0; ks < 4; ++ks) { const bf16x8 vf = *(const LAS bf16x8*)(vb + (32 * db + r32) * 128 + (((2 * ks + hi) ^ sw0) * 16));
                    o[db] = __builtin_amdgcn_mfma_f32_32x32x16_bf16(vf, pf[ks], o[db], 0, 0, 0); }
        }
        s_cur = (s_cur + 1) & 3;
    }
    const float l_tot = l_run + __shfl_xor(l_run, 32);
    float inv = (m_run > -1e29f) ? 1.0f / l_tot : 0.f;
    if (OUT == 1) inv *= a.gate[(size_t)(32 * wid + r32) * a.ldg];
    bf16_t* orow = a.O + (size_t)(32 * wid + r32) * a.ldo;
#pragma unroll
    for (int db = 0; db < NDB; ++db)
#pragma unroll
        for (int g = 0; g < 4; ++g) { u32x2 w; w.x = pg8::cvt_pk_bf16(o[db][4 * g] * inv, o[db][4 * g + 1] * inv); w.y = pg8::cvt_pk_bf16(o[db][4 * g + 2] * inv, o[db][4 * g + 3] * inv);
            *(u32x2*)(orow + 32 * db + 8 * g + 4 * hi) = w; }
    asm volatile("s_waitcnt lgkmcnt(0)" ::: "memory");
    __builtin_amdgcn_s_barrier();
    asm volatile("" ::: "memory");
#undef FA_ISSUE
}
struct AttnOrder {
    int vcu, G;
    __device__ __forceinline__ bool next(int i, int& bh, int& qb) const {
        if (G == 256) { if (i >= 4) return false; const int s = vcu & 7; bh = vcu >> 3; qb = (i == 0) ? 31 - s : (i == 1) ? 16 + s : (i == 2) ? 15 - s : s; return true; }
        const int u = vcu + i * G; if (u >= 1024) return false; bh = u >> 5; qb = 31 - (u & 31); return true;
    }
};

__device__ __forceinline__ float gelu_tanh(float x) { const float u = 0.7978845608028654f * (x + 0.044715f * x * x * x); const float e = __expf(2.f * u); return 0.5f * x * (2.f - 2.f / (e + 1.f)); }
template <bool SPLIT>
__device__ __forceinline__ void nsa_compress_unit(LAS unsigned char* lds, int bg, int n0, const bf16_t* AH, const bf16_t* AL, const bf16_t* W1H, const bf16_t* W1L,
                                                  const bf16_t* W2H, const bf16_t* W2L, const float* C1P, bf16_t* KCH, bf16_t* KCL, bf16_t* VCT) {
    const int tid = otid(), lane = tid & 63, wid = __builtin_amdgcn_readfirstlane(tid >> 6), r32 = lane & 31, hi = lane >> 5;
    const size_t aoff = ((size_t)bg * 8192 + 16 * (size_t)(n0 + r32)) * 64 + 8 * hi;
    const bf16_t* ah = AH + aoff; const bf16_t* al = SPLIT ? AL + aoff : nullptr;
    const size_t boff = (size_t)(32 * wid + r32) * 2048 + 8 * hi;
    const bf16_t* bh = W1H + boff; const bf16_t* bl = SPLIT ? W1L + boff : nullptr;
    f32x16 acc;
#pragma unroll
    for (int r = 0; r < 16; ++r) acc[r] = 0.f;
#pragma unroll 1
    for (int k8 = 0; k8 < 16; ++k8) {
        bf16x8 fa_h[8], fb_h[8], fa_l[8], fb_l[8];
#pragma unroll
        for (int u = 0; u < 8; ++u) { const int kk = 8 * k8 + u; fa_h[u] = *(const bf16x8*)(ah + 16 * kk); fb_h[u] = *(const bf16x8*)(bh + 16 * kk);
            if (SPLIT) { fa_l[u] = *(const bf16x8*)(al + 16 * kk); fb_l[u] = *(const bf16x8*)(bl + 16 * kk); } }
#pragma unroll
        for (int u = 0; u < 8; ++u) { acc = __builtin_amdgcn_mfma_f32_32x32x16_bf16(fa_h[u], fb_h[u], acc, 0, 0, 0);
            if (SPLIT) { acc = __builtin_amdgcn_mfma_f32_32x32x16_bf16(fa_h[u], fb_l[u], acc, 0, 0, 0); acc = __builtin_amdgcn_mfma_f32_32x32x16_bf16(fa_l[u], fb_h[u], acc, 0, 0, 0); } }
    }
    const int col = 32 * wid + r32;
    float c1 = 0.f;
#pragma unroll 8
    for (int kc = 0; kc < 32; ++kc) c1 += C1P[kc * 256 + col];
    constexpr int GP = 528;
#pragma unroll
    for (int r = 0; r < 16; ++r) { const float gv = gelu_tanh(acc[r] + c1); const unsigned short h = pg8::f2bf_rne(gv); const int row = crow(r, hi);
        *(LAS unsigned short*)(lds + row * GP + col * 2) = h;
        if (SPLIT) *(LAS unsigned short*)(lds + 32 * GP + row * GP + col * 2) = pg8::f2bf_rne(gv - pg8::bf2f(h)); }
    __syncthreads();
    if (wid < 2) {
        f32x16 a2;
#pragma unroll
        for (int r = 0; r < 16; ++r) a2[r] = 0.f;
        const size_t woff = (size_t)(32 * wid + r32) * 256 + 8 * hi;
#pragma unroll
        for (int kk = 0; kk < 16; ++kk) {
            const bf16x8 g_h = *(const LAS bf16x8*)(lds + r32 * GP + (16 * kk + 8 * hi) * 2);
            const bf16x8 w_h = *(const bf16x8*)(W2H + woff + 16 * kk);
            a2 = __builtin_amdgcn_mfma_f32_32x32x16_bf16(g_h, w_h, a2, 0, 0, 0);
            if (SPLIT) { const bf16x8 g_l = *(const LAS bf16x8*)(lds + 32 * GP + r32 * GP + (16 * kk + 8 * hi) * 2); const bf16x8 w_l = *(const bf16x8*)(W2L + woff + 16 * kk);
                a2 = __builtin_amdgcn_mfma_f32_32x32x16_bf16(g_h, w_l, a2, 0, 0, 0);
                a2 = __builtin_amdgcn_mfma_f32_32x32x16_bf16(g_l, w_h, a2, 0, 0, 0); }
        }
        const int e = 32 * wid + r32;
#pragma unroll
        for (int r = 0; r < 16; ++r) { const int n = n0 + crow(r, hi); const float v = (n < 511) ? a2[r] : 0.f;
            if (SPLIT) { const unsigned short h = pg8::f2bf_rne(v); KCH[((size_t)bg * 512 + n) * 64 + e] = h; KCL[((size_t)bg * 512 + n) * 64 + e] = pg8::f2bf_rne(v - pg8::bf2f(h)); }
            else { const int pos = (n & ~12) | ((n & 4) << 1) | ((n & 8) >> 1); VCT[((size_t)bg * 64 + e) * 512 + pos] = pg8::f2bf_rne(v); } }
    }
    __syncthreads();
}

constexpr int IM_P = 0, IM_PPITCH = 516, IM_VAL = 66048, IM_RED = 82432, IM_RED2 = 86528, IM_TAB = 90624, IM_END = 92672;
__device__ __forceinline__ void nsa_importance_unit(LAS unsigned char* lds, int b, int g, int qblk, const bf16_t* QH, const bf16_t* QL, const bf16_t* KCH, const bf16_t* KCL,
                                                    const float* TAB, unsigned char* SEL) {
    const int tid = otid(), lane = tid & 63, wid = __builtin_amdgcn_readfirstlane(tid >> 6), r32 = lane & 31, hi = lane >> 5;
    const int t0 = 32 * qblk, qpos = t0 + r32; const size_t tok = (size_t)b * 8192 + qpos;
    LAS float* P = (LAS float*)(lds + IM_P); LAS float* VAL = (LAS float*)(lds + IM_VAL); LAS float* RED = (LAS float*)(lds + IM_RED); LAS float* RED2 = (LAS float*)(lds + IM_RED2); LAS float* TABL = (LAS float*)(lds + IM_TAB);
    TABL[tid] = TAB[(g * 4) * 128 + tid];
    __syncthreads();
    const int nmax = 2 * qblk;
    const bool act0 = 32 * wid <= nmax, act1 = 32 * (wid + 8) <= nmax;
    f32x16 sc[4][2];
#pragma unroll
    for (int r = 0; r < 4; ++r)
#pragma unroll
        for (int nt = 0; nt < 2; ++nt)
#pragma unroll
            for (int i = 0; i < 16; ++i) sc[r][nt][i] = 0.f;
    if (act0) {
        const size_t qoff = tok * 1024 + (size_t)(g * 4) * 64 + 8 * hi;
#pragma unroll
        for (int d0 = 0; d0 < 4; ++d0) {
            bf16x8 kh[2], kl[2];
#pragma unroll
            for (int nt = 0; nt < 2; ++nt) { const size_t koff = ((size_t)(b * 4 + g) * 512 + 32 * (wid + 8 * nt) + r32) * 64 + 8 * hi + 16 * d0; kh[nt] = *(const bf16x8*)(KCH + koff); kl[nt] = *(const bf16x8*)(KCL + koff); }
#pragma unroll
            for (int r = 0; r < 4; ++r) { const bf16x8 qh = *(const bf16x8*)(QH + qoff + r * 64 + 16 * d0), ql = *(const bf16x8*)(QL + qoff + r * 64 + 16 * d0);
                sc[r][0] = __builtin_amdgcn_mfma_f32_32x32x16_bf16(kh[0], qh, sc[r][0], 0, 0, 0);
                sc[r][0] = __builtin_amdgcn_mfma_f32_32x32x16_bf16(kh[0], ql, sc[r][0], 0, 0, 0);
                sc[r][0] = __builtin_amdgcn_mfma_f32_32x32x16_bf16(kl[0], qh, sc[r][0], 0, 0, 0);
                if (act1) { sc[r][1] = __builtin_amdgcn_mfma_f32_32x32x16_bf16(kh[1], qh, sc[r][1], 0, 0, 0);
                    sc[r][1] = __builtin_amdgcn_mfma_f32_32x32x16_bf16(kh[1], ql, sc[r][1], 0, 0, 0);
                    sc[r][1] = __builtin_amdgcn_mfma_f32_32x32x16_bf16(kl[1], qh, sc[r][1], 0, 0, 0); } }
        }
    }
#pragma unroll
    for (int nt = 0; nt < 2; ++nt)
#pragma unroll
        for (int i = 0; i < 16; ++i) { const int n = 32 * (wid + 8 * nt) + crow(i, hi); const int dist = qpos - (16 * n + 31); const int idx = min(max(dist, 0), 127);
#pragma unroll
            for (int r = 0; r < 4; ++r) sc[r][nt][i] = (dist >= 0) ? sc[r][nt][i] + TABL[r * 128 + idx] : NEGV; }
    float mrow[4];
#pragma unroll
    for (int r = 0; r < 4; ++r) { float mx = NEGV;
#pragma unroll
        for (int nt = 0; nt < 2; ++nt)
#pragma unroll
            for (int i = 0; i < 16; ++i) mx = fmaxf(mx, sc[r][nt][i]);
        mx = fmaxf(mx, __shfl_xor(mx, 32));
        if (hi == 0) RED[(wid * 4 + r) * 32 + r32] = mx; }
    __syncthreads();
#pragma unroll
    for (int r = 0; r < 4; ++r) { float mx = NEGV;
#pragma unroll
        for (int w = 0; w < 8; ++w) mx = fmaxf(mx, RED[(w * 4 + r) * 32 + r32]);
        mrow[r] = mx; }
#pragma unroll
    for (int r = 0; r < 4; ++r) { float sm = 0.f; const bool any = mrow[r] > -1e29f;
#pragma unroll
        for (int nt = 0; nt < 2; ++nt)
#pragma unroll
            for (int i = 0; i < 16; ++i) { const float p = any ? ex2(sc[r][nt][i] - mrow[r]) : 0.f; sc[r][nt][i] = p; sm += p; }
        sm += __shfl_xor(sm, 32);
        if (hi == 0) RED2[(wid * 4 + r) * 32 + r32] = sm; }
    __syncthreads();
    float inv[4];
#pragma unroll
    for (int r = 0; r < 4; ++r) { float sm = 0.f;
#pragma unroll
        for (int w = 0; w < 8; ++w) sm += RED2[(w * 4 + r) * 32 + r32];
        inv[r] = sm > 0.f ? 1.0f / sm : 0.f; }
#pragma unroll
    for (int nt = 0; nt < 2; ++nt)
#pragma unroll
        for (int gq = 0; gq < 4; ++gq) { f32x4 v;
#pragma unroll
            for (int i = 0; i < 4; ++i) v[i] = sc[0][nt][4 * gq + i] * inv[0] + sc[1][nt][4 * gq + i] * inv[1] + sc[2][nt][4 * gq + i] * inv[2] + sc[3][nt][4 * gq + i] * inv[3];
            *(LAS f32x4*)(P + r32 * IM_PPITCH + 32 * (wid + 8 * nt) + 8 * gq + 4 * hi) = v; }
    __syncthreads();
    const int q = tid >> 4, jc = tid & 15; const int tq = t0 + q, cur = tq >> 6;
    unsigned key[8];
#pragma unroll
    for (int jj = 0; jj < 8; ++jj) { const int j = 8 * jc + jj; const f32x4 v = *(const LAS f32x4*)(P + q * IM_PPITCH + 4 * j);
        float s = (v[0] + v[1]) + (v[2] + v[3]); if (j > 0) s += P[q * IM_PPITCH + 4 * j - 1];
        const bool valid = j <= cur, forced = (j == 0) || (j == cur) || (j == cur - 1);
        key[jj] = valid ? (__float_as_uint(forced ? 1e4f : s) + 1u) : 0u; }
#define ROW16_SUM(v_) do { v_ += __builtin_amdgcn_update_dpp(0, v_, 0xB1, 0xf, 0xf, false); v_ += __builtin_amdgcn_update_dpp(0, v_, 0x4E, 0xf, 0xf, false); \
        v_ += __builtin_amdgcn_update_dpp(0, v_, 0x141, 0xf, 0xf, false); v_ += __builtin_amdgcn_update_dpp(0, v_, 0x140, 0xf, 0xf, false); } while (0)
#define ROW16_SCAN(v_) do { v_ += __builtin_amdgcn_update_dpp(0, v_, 0x111, 0xf, 0xf, false); v_ += __builtin_amdgcn_update_dpp(0, v_, 0x112, 0xf, 0xf, false); \
        v_ += __builtin_amdgcn_update_dpp(0, v_, 0x114, 0xf, 0xf, false); v_ += __builtin_amdgcn_update_dpp(0, v_, 0x118, 0xf, 0xf, false); } while (0)
    unsigned T = 0u;
#pragma unroll
    for (int bit = 31; bit >= 0; --bit) { const unsigned cand = T | (1u << bit); int c = 0;
#pragma unroll
        for (int jj = 0; jj < 8; ++jj) c += (key[jj] >= cand) ? 1 : 0;
        ROW16_SUM(c);
        if (c >= 16) T = cand; }
    int gcnt = 0, ecnt = 0;
#pragma unroll
    for (int jj = 0; jj < 8; ++jj) { gcnt += (key[jj] > T) ? 1 : 0; ecnt += (key[jj] == T) ? 1 : 0; }
    int gtot = gcnt; ROW16_SUM(gtot);
    const int need = 16 - gtot;
    int eincl = ecnt; ROW16_SCAN(eincl);
    int erun = eincl - ecnt, scnt = 0; bool sel[8];
#pragma unroll
    for (int jj = 0; jj < 8; ++jj) { const bool eq = key[jj] == T; sel[jj] = (key[jj] > T) || (eq && erun < need); erun += eq ? 1 : 0; scnt += sel[jj] ? 1 : 0; }
    int sincl = scnt; ROW16_SCAN(sincl);
    int slot = sincl - scnt;
    unsigned char* selrow = SEL + (((size_t)b * 8192 + tq) * 4 + g) * 16;
#pragma unroll
    for (int jj = 0; jj < 8; ++jj) if (sel[jj]) { selrow[slot] = (unsigned char)(8 * jc + jj); ++slot; }
#undef ROW16_SUM
#undef ROW16_SCAN
    __syncthreads();
}

struct SelFr { bf16x8 k[8], v[8]; };
__device__ __forceinline__ float wave_max64(float v) {
#pragma unroll
    for (int o = 1; o < 64; o <<= 1) v = fmaxf(v, __shfl_xor(v, o));
    return v;
}
__device__ __forceinline__ float wave_sum64(float v) {
#pragma unroll
    for (int o = 1; o < 64; o <<= 1) v += __shfl_xor(v, o);
    return v;
}
__device__ __forceinline__ void nsa_selected_phase(LAS unsigned char* lds, int gw, int ngw, const bf16_t* QH, const bf16_t* KF, const bf16_t* VF, const unsigned char* SEL, const float* TAB, const float* GATE,
                                                   const bf16_t* OC, const bf16_t* OW, bf16_t* O) {
    const int tid = otid(), lane = tid & 63, wid = __builtin_amdgcn_readfirstlane(tid >> 6), r32 = lane & 31, hi = lane >> 5;
    LAS float* TABL = (LAS float*)lds;
    for (int i = tid; i < 2048; i += 512) TABL[i] = TAB[i];
    __syncthreads();
    LAS unsigned char* pt = lds + 8192 + wid * 1024;
    const int ppos = (lane & ~12) | ((lane & 4) << 1) | ((lane & 8) >> 1);
#define SEL_LOAD(S, j_) do { const bf16_t* kb_ = KF + ((size_t)(bg * 128 + (j_)) * 8) * 512 + lane * 8; const bf16_t* vb_ = VF + ((size_t)(bg * 128 + (j_)) * 8) * 512 + lane * 8; \
        _Pragma("unroll") for (int f_ = 0; f_ < 8; ++f_) { S.k[f_] = *(const bf16x8*)(kb_ + f_ * 512); S.v[f_] = *(const bf16x8*)(vb_ + f_ * 512); } } while (0)
#define SEL_COMPUTE(S, j_) do { f32x16 p0, p1; \
        _Pragma("unroll") for (int r_ = 0; r_ < 16; ++r_) { p0[r_] = 0.f; p1[r_] = 0.f; } \
        _Pragma("unroll") for (int d0 = 0; d0 < 4; ++d0) { p0 = __builtin_amdgcn_mfma_f32_32x32x16_bf16(qa[d0], S.k[d0], p0, 0, 0, 0); p1 = __builtin_amdgcn_mfma_f32_32x32x16_bf16(qa[d0], S.k[4 + d0], p1, 0, 0, 0); } \
        float s_[4]; _Pragma("unroll") for (int h = 0; h < 4; ++h) s_[h] = hi ? p1[h] : p0[h]; \
        if (64 * (j_) + 63 >= t - 127) { const int dist = t - (64 * (j_) + lane); const int idx = min(max(dist, 0), 127); \
            _Pragma("unroll") for (int h = 0; h < 4; ++h) s_[h] = (dist >= 0) ? s_[h] + TABL[(g * 4 + h) * 128 + idx] : NEGV; } \
        const bool ex_ = (s_[0] > m_run[0] + 8.f) || (s_[1] > m_run[1] + 8.f) || (s_[2] > m_run[2] + 8.f) || (s_[3] > m_run[3] + 8.f); \
        if (__any(ex_)) { float asel = 1.f; \
            _Pragma("unroll") for (int h = 0; h < 4; ++h) { const float mn = fmaxf(m_run[h], wave_max64(s_[h])); const float al = ex2(m_run[h] - mn); ll[h] *= al; m_run[h] = mn; if ((r32 & 3) == h) asel = al; } \
            _Pragma("unroll") for (int r_ = 0; r_ < 16; ++r_) { o[0][r_] *= asel; o[1][r_] *= asel; } } \
        _Pragma("unroll") for (int h = 0; h < 4; ++h) { const float p_ = ex2(s_[h] - m_run[h]); ll[h] += p_; *(LAS unsigned short*)(pt + h * 144 + ppos * 2) = (unsigned short)(pg8::cvt_pk_bf16(p_, 0.f) & 0xffffu); } \
        bf16x8 pf[4]; _Pragma("unroll") for (int ks = 0; ks < 4; ++ks) pf[ks] = *(const LAS bf16x8*)(pt + (r32 & 3) * 144 + (16 * ks + 8 * hi) * 2); \
        _Pragma("unroll") for (int db = 0; db < 2; ++db) _Pragma("unroll") for (int ks = 0; ks < 4; ++ks) o[db] = __builtin_amdgcn_mfma_f32_32x32x16_bf16(S.v[db * 4 + ks], pf[ks], o[db], 0, 0, 0); } while (0)
#define SEL_BYTE(i_) __builtin_amdgcn_readfirstlane((int)(((((i_) < 4) ? selw.x : ((i_) < 8) ? selw.y : ((i_) < 12) ? selw.z : selw.w) >> (8 * ((i_) & 3))) & 255u))
    const int nper = ngw >> 3;
    for (int it = gw % nper; it < 8192; it += nper) {
        const int bg = gw / nper, b = bg >> 2, g = bg & 3, t = it, tokI = b * 8192 + t; const size_t tok = (size_t)tokI;
        const int head = g * 4 + (r32 & 3);
        bf16x8 qa[4];
#pragma unroll
        for (int d0 = 0; d0 < 4; ++d0) qa[d0] = *(const bf16x8*)(QH + tok * 1024 + head * 64 + 16 * d0 + 8 * hi);
        const u32x4 selw = *(const u32x4*)(SEL + (tok * 4 + g) * 16);
        float m_run[4], ll[4]; f32x16 o[2];
#pragma unroll
        for (int h = 0; h < 4; ++h) { m_run[h] = NEGV; ll[h] = 0.f; }
#pragma unroll
        for (int r = 0; r < 16; ++r) { o[0][r] = 0.f; o[1][r] = 0.f; }
        SelFr A, B;
        int jn = SEL_BYTE(0); SEL_LOAD(A, jn);
#pragma unroll 1
        for (int i = 0; i < 16; i += 2) {
            const int j0 = jn; jn = SEL_BYTE(i + 1); SEL_LOAD(B, jn);
            if (64 * j0 <= t) SEL_COMPUTE(A, j0);
            const int j1 = jn; if (i + 2 < 16) { jn = SEL_BYTE(i + 2); SEL_LOAD(A, jn); }
            if (64 * j1 <= t) SEL_COMPUTE(B, j1);
        }
        float lsel = 1.f;
#pragma unroll
        for (int h = 0; h < 4; ++h) { const float lt = wave_sum64(ll[h]); if ((r32 & 3) == h) lsel = lt; }
        if (r32 < 4) {
            const float inv = GATE[tok * 48 + head * 3 + 1] / lsel;
#pragma unroll
            for (int db = 0; db < 2; ++db)
#pragma unroll
                for (int gq = 0; gq < 4; ++gq) { const size_t off = tok * 1024 + head * 64 + 32 * db + 8 * gq + 4 * hi;
                    const u32x2 c = *(const u32x2*)(OC + off), w = *(const u32x2*)(OW + off);
                    const float r0 = o[db][4 * gq] * inv + __uint_as_float(c.x << 16) + __uint_as_float(w.x << 16), r1 = o[db][4 * gq + 1] * inv + __uint_as_float(c.x & 0xffff0000u) + __uint_as_float(w.x & 0xffff0000u);
                    const float r2 = o[db][4 * gq + 2] * inv + __uint_as_float(c.y << 16) + __uint_as_float(w.y << 16), r3 = o[db][4 * gq + 3] * inv + __uint_as_float(c.y & 0xffff0000u) + __uint_as_float(w.y & 0xffff0000u);
                    u32x2 ov; ov.x = pg8::cvt_pk_bf16(r0, r1); ov.y = pg8::cvt_pk_bf16(r2, r3); *(u32x2*)(O + off) = ov; }
        }
    }
#undef SEL_LOAD
#undef SEL_COMPUTE
#undef SEL_BYTE
    __syncthreads();
}
}
typedef unsigned v4u __attribute__((ext_vector_type(4)));
#define XB_TMO      128
#define XB_XCNT(j)  (256  + 64 * (j))
#define XB_XSUB(j)  (1280 + 64 * (j))
#define XB_XGEN(j)  (2304 + 64 * (j))
#define XB_TOP      3328
#define XB_TOPGEN   3392
#define XCD_BAR_WORDS 3456
#define XB_SPIN_CAP (1u << 18)

__device__ __forceinline__ unsigned xb_ld(unsigned* p)              { return __hip_atomic_load(p, __ATOMIC_RELAXED, __HIP_MEMORY_SCOPE_AGENT); }
__device__ __forceinline__ unsigned xb_add(unsigned* p, unsigned v) { return __hip_atomic_fetch_add(p, v, __ATOMIC_RELAXED, __HIP_MEMORY_SCOPE_AGENT); }
__device__ __forceinline__ unsigned xb_xcc_id() { return (unsigned)__builtin_amdgcn_s_getreg((3 << 11) | 20) & 0xFu; }
#define XB_SPIN(cond, bar) do { unsigned _sp = 0; while (cond) { __builtin_amdgcn_s_sleep(1); \
    if ((++_sp & 255u) == 0u) { if (xb_ld(&(bar)[XB_TMO])) break; if (_sp > XB_SPIN_CAP) { atomicAdd(&(bar)[XB_TMO], 1u); break; } } } } while (0)

struct XcdBarrier {
    unsigned* bar; unsigned x;
    volatile LAS unsigned* st;
};

__device__ __forceinline__ XcdBarrier xcd_barrier_post(unsigned* bar, volatile LAS unsigned* st) {
    XcdBarrier b; b.bar = bar; b.x = xb_xcc_id(); b.st = st;
    if (threadIdx.x == 0) (void)xb_add(&bar[XB_XCNT(b.x)], 1u);
    return b;
}
__device__ __forceinline__ void xcd_barrier_complete(unsigned* bar, unsigned x, unsigned& nloc, unsigned& nx) {
    const unsigned G = gridDim.x * gridDim.y * gridDim.z;
    unsigned sum, cnt, mine, sp = 0u;
    for (;;) {
        sum = 0u; cnt = 0u; mine = 0u;
#pragma unroll
        for (unsigned j = 0; j < 16; ++j) { const unsigned c = xb_ld(&bar[XB_XCNT(j)]); sum += c; cnt += (c > 0u) ? 1u : 0u; mine = (j == x) ? c : mine; }
        if (sum == G) break;
        __builtin_amdgcn_s_sleep(1);
        if ((++sp & 255u) == 0u) { if (xb_ld(&bar[XB_TMO])) break; if (sp > XB_SPIN_CAP) { atomicAdd(&bar[XB_TMO], 1u); break; } }
    }
    nloc = mine > 0u ? mine : 1u; nx = cnt > 0u ? cnt : 1u;
}

__device__ __forceinline__ void xcd_barrier(const XcdBarrier& b) {
    asm volatile("s_waitcnt vmcnt(0)" ::: "memory");
    __syncthreads();
    if (threadIdx.x == 0) {
        unsigned* bar = b.bar;
        __builtin_amdgcn_s_waitcnt(0);
        unsigned nloc = b.st[0], nx = b.st[1];
        if (nloc == 0u) { xcd_barrier_complete(bar, b.x, nloc, nx); b.st[0] = nloc; b.st[1] = nx; }
        const unsigned old = xb_add(&bar[XB_XSUB(b.x)], 1u);
        const unsigned gen = old / nloc;
        if (old + 1u == (gen + 1u) * nloc) {
            __builtin_amdgcn_fence(__ATOMIC_RELEASE, "agent");
            asm volatile("s_waitcnt vmcnt(0)" ::: "memory");
            const unsigned og = xb_add(&bar[XB_TOP], 1u);
            const unsigned tg = og / nx;
            if (og + 1u == (tg + 1u) * nx) xb_add(&bar[XB_TOPGEN], 1u);
            else XB_SPIN(xb_ld(&bar[XB_TOPGEN]) == tg, bar);
            __builtin_amdgcn_fence(__ATOMIC_ACQUIRE, "agent");
            xb_add(&bar[XB_XGEN(b.x)], 1u);
            asm volatile("s_waitcnt vmcnt(0)" ::: "memory");
        } else {
            XB_SPIN(xb_ld(&bar[XB_XGEN(b.x)]) == gen, bar);
            __builtin_amdgcn_fence(__ATOMIC_ACQUIRE, "agent");
            asm volatile("s_waitcnt vmcnt(0)" ::: "memory");
        }
    }
    __syncthreads();
}
using pg8::bf16_t; using pg8::f32x4; using pg8::u32x4; using pg8::u32x2;
constexpr int NWAVES = 8, NTHREADS = 512;
constexpr int MTOK = 16384, DM = 1024, SEQ = 8192, DFF = 4096;
constexpr float NORM_EPS = 1e-6f, LOG2E = 1.4426950408889634f, QSCALE = 0.125f * 1.4426950408889634f;
constexpr size_t MiB = 1u << 20;
constexpr size_t WS_TAB = 0;
constexpr size_t WS_C1P = 64 * 1024;
constexpr size_t WS_CTL = 512 * 1024, CTL_BYTES = 16 * 1024;
constexpr size_t WS_W1T = 1 * MiB, WS_W2T = 9 * MiB, WS_WGT = 17 * MiB, WS_WPT = 19 * MiB, WS_WOT = 20 * MiB, WS_WIN = 22 * MiB, WS_WVT = 30 * MiB, WS_WB = 32 * MiB;
constexpr size_t WS_CW1 = 34 * MiB;
constexpr size_t WS_CW2 = 38 * MiB;
constexpr size_t WS_XH = 40 * MiB;
constexpr size_t WS_BIG = 72 * MiB;
constexpr size_t WS_Y = 200 * MiB;
constexpr size_t WS_AUX = 264 * MiB;
constexpr size_t WS_PB = 296 * MiB;
constexpr size_t WS_LF = 304 * MiB, WS_KBIAS = 305 * MiB, WS_SEL = 306 * MiB, WS_GATE = 307 * MiB;
constexpr size_t WS_KC = 310 * MiB;
constexpr size_t WS_END = 312 * MiB;
constexpr int LDS_BYTES = 147456, LDS_MISC = 131072 + 320;

__device__ const unsigned char kBucket[128] = {0, 1, 2, 3, 4, 5, 6, 7, 8, 9, 10, 11, 12, 13, 14, 15, 16, 16, 16, 17, 17, 18, 18, 18, 19, 19, 19, 20, 20, 20, 20, 21, 21, 21, 21, 22, 22, 22, 22, 22, 23, 23, 23, 23, 23, 23, 24, 24, 24, 24, 24, 24,
    25, 25, 25, 25, 25, 25, 25, 26, 26, 26, 26, 26, 26, 26, 26, 27, 27, 27, 27, 27, 27, 27, 27, 27, 27, 28, 28, 28, 28, 28, 28, 28, 28, 28, 28, 29, 29, 29, 29, 29, 29, 29, 29, 29, 29, 29, 29, 30, 30, 30, 30, 30, 30, 30, 30, 30, 30, 30, 30, 30, 30,
    31, 31, 31, 31, 31, 31, 31, 31, 31, 31, 31, 31, 31, 31, 31};

struct Args { const float* in[20]; float* out; unsigned char* ws; int ph_lo, ph_hi; };
enum { IN_X = 0, IN_P, IN_REL, IN_NG, IN_W1, IN_W2, IN_PLEW, IN_GATEW, IN_DAIN, IN_DALAM, IN_DASUB, IN_DAOUT, IN_NSAIN, IN_NSAPE, IN_NSAW1, IN_NSAW2, IN_NSAOUT, IN_FOXIN, IN_FOXB, IN_FOXOUT };

__device__ __forceinline__ float wave_sum(float v) {
#pragma unroll
    for (int o = 1; o < 64; o <<= 1) v += __shfl_xor(v, o);
    return v;
}
__device__ __forceinline__ unsigned pk2(float lo, float hi) { return pg8::cvt_pk_bf16(lo, hi); }

__device__ __forceinline__ void tr_item(const float* W, int ldn, int cbeg, int nvalid, bf16_t* dst, int ldd, int row0, int kofs, int lo, LAS float* scr, int kb, int nb, int lane) {
    const int k0 = 64 * kb, n0 = 32 * nb;
    float ld_[32]; const int nn = n0 + (lane & 31); const float* wp = W + (size_t)(k0 + (lane >> 5)) * ldn + cbeg + nn;
#pragma unroll
    for (int i = 0; i < 32; ++i) ld_[i] = (nn < nvalid) ? wp[(size_t)(2 * i) * ldn] : 0.f;
#pragma unroll
    for (int i = 0; i < 32; ++i) scr[(2 * i + (lane >> 5)) * 33 + (lane & 31)] = ld_[i];
    asm volatile("s_waitcnt lgkmcnt(0)" ::: "memory");
    const int c = lane & 7;
#pragma unroll
    for (int j = 0; j < 4; ++j) { const int n = (lane >> 3) + 8 * j; const LAS float* s = scr + (8 * c) * 33 + n; float v[8];
#pragma unroll
        for (int i = 0; i < 8; ++i) { v[i] = s[i * 33]; if (lo) v[i] = v[i] - pg8::bf2f(pg8::f2bf_rne(v[i])); }
        u32x4 o; o.x = pk2(v[0], v[1]); o.y = pk2(v[2], v[3]); o.z = pk2(v[4], v[5]); o.w = pk2(v[6], v[7]);
        *(u32x4*)(dst + (size_t)(row0 + n0 + n) * ldd + kofs + k0 + 8 * c) = o; }
    asm volatile("s_waitcnt lgkmcnt(0)" ::: "memory");
}
__device__ __forceinline__ void tr_job(const float* W, int K, int ldn, int cbeg, int nvalid, int npad, bf16_t* dst, int ldd, int row0, int kofs, int lo, LAS float* scr, int gw, int ngw, int lane) {
    const int nnb = npad / 32, nitems = (K / 64) * nnb;
    for (int it = gw; it < nitems; it += ngw) tr_item(W, ldn, cbeg, nvalid, dst, ldd, row0, kofs, lo, scr, it / nnb, it % nnb, lane);
}

template <int MODE  >
__device__ __forceinline__ void norm_rows(const float* xsrc, float* X, const bf16_t* Y, const float* ga, const float* gb, bf16_t* XH, bf16_t* H3, int gw, int ngw, int lane) {
    constexpr int R = 2;
    for (int m0 = gw * R; m0 < MTOK; m0 += ngw * R) {
        f32x4 v[R][4], y[R][4];
#pragma unroll
        for (int q = 0; q < R; ++q) { const f32x4* xr = (const f32x4*)(xsrc + (size_t)(m0 + q) * DM) + lane;
#pragma unroll
            for (int j = 0; j < 4; ++j) v[q][j] = xr[64 * j];
            if (MODE != 0) { const u32x2* yr = (const u32x2*)(Y + (size_t)(m0 + q) * DM) + lane;
#pragma unroll
                for (int j = 0; j < 4; ++j) { const u32x2 w = yr[64 * j]; y[q][j][0] = __uint_as_float(w.x << 16); y[q][j][1] = __uint_as_float(w.x & 0xffff0000u); y[q][j][2] = __uint_as_float(w.y << 16); y[q][j][3] = __uint_as_float(w.y & 0xffff0000u); } } }
#pragma unroll
        for (int q = 0; q < R; ++q) { const int m = m0 + q;
            if (MODE != 0) { float s = 0.f;
#pragma unroll
                for (int j = 0; j < 4; ++j) s += (y[q][j][0] * y[q][j][0] + y[q][j][1] * y[q][j][1]) + (y[q][j][2] * y[q][j][2] + y[q][j][3] * y[q][j][3]);
                const float ry = rsqrtf(wave_sum(s) * (1.f / DM) + NORM_EPS);
#pragma unroll
                for (int j = 0; j < 4; ++j) { const f32x4 g = ((const f32x4*)ga)[lane + 64 * j]; v[q][j] = v[q][j] + y[q][j] * ry * g; } }
            if (MODE != 0) { f32x4* xo = (f32x4*)(X + (size_t)m * DM) + lane;
#pragma unroll
                for (int j = 0; j < 4; ++j) xo[64 * j] = v[q][j]; }
            if (MODE != 2) { float s = 0.f;
#pragma unroll
                for (int j = 0; j < 4; ++j) s += (v[q][j][0] * v[q][j][0] + v[q][j][1] * v[q][j][1]) + (v[q][j][2] * v[q][j][2] + v[q][j][3] * v[q][j][3]);
                const float rx = rsqrtf(wave_sum(s) * (1.f / DM) + NORM_EPS);
#pragma unroll
                for (int j = 0; j < 4; ++j) { const f32x4 g = ((const f32x4*)gb)[lane + 64 * j]; v[q][j] = v[q][j] * rx * g; } }
            u32x2* ho = (u32x2*)(XH + (size_t)m * DM) + lane;
#pragma unroll
            for (int j = 0; j < 4; ++j) { u32x2 h; h.x = pk2(v[q][j][0], v[q][j][1]); h.y = pk2(v[q][j][2], v[q][j][3]); ho[64 * j] = h;
                if (MODE == 0) { if (H3) { u32x2 l; l.x = pk2(v[q][j][0] - __uint_as_float(h.x << 16), v[q][j][1] - __uint_as_float(h.x & 0xffff0000u)); l.y = pk2(v[q][j][2] - __uint_as_float(h.y << 16), v[q][j][3] - __uint_as_float(h.y & 0xffff0000u));
                    u32x2* h3 = (u32x2*)(H3 + (size_t)m * 3072) + lane; h3[64 * j] = h; h3[256 + 64 * j] = h; h3[512 + 64 * j] = l; } } } }
    }
}

template <class Epi> __device__ __forceinline__ void run_gemm(LAS unsigned char* lds, const bf16_t* A, const bf16_t* Bt, int M, int N, int K, const Epi& E, int rot = 0) {
    pg8::Gemm g{A, Bt, M, N, oqi(K)}; pg8::StaticOrder S; const int G_ = oqi((int)gridDim.x); S.init(M, N, G_, (oqi((int)blockIdx.x) + rot) % G_);
    pg8::gemm_phase<Epi, pg8::StaticOrder, true, true>((PG8_LAS unsigned char*)lds, g, S, E);
}

#ifndef FLASH_DA
#define FLASH_DA fa::flash_unit_reg
#endif
#ifndef FLASH_FOX
#define FLASH_FOX fa::flash_unit_reg
#endif
#ifndef FLASH_NSA
#define FLASH_NSA fa::flash_unit_reg
#endif
#ifndef ONLY_PK
#define ONLY_PK -1
#endif
#ifndef ONLY_KIND
#define ONLY_KIND -1
#endif
#define PH_ON(k) (ONLY_PK < 0 || ONLY_PK == (k))
#define KIND_IS(kk) ((ONLY_KIND < 0 || ONLY_KIND == (kk)) && kind == (kk))
__device__ __forceinline__ int layer_kind(int layer) { return layer % 3; }
__device__ __forceinline__ int layer_nph(int layer) { const int k = layer_kind(layer); return k == 1 ? 11 : (k == 2 ? 10 : 9); }
constexpr int N_PHASES = 9 + 11 + 10 + 9;
enum { PK_PRO = 0, PK_INPROJ, PK_MIX1, PK_MIX2, PK_MIX3, PK_OUTPROJ, PK_NORMB, PK_UP, PK_DOWN, PK_NORMC, PK_GATE };

__global__ void __launch_bounds__(NTHREADS, 2) trunk_fwd(Args args) {
    extern __shared__ __attribute__((aligned(16))) unsigned char lds_raw[];
    LAS unsigned char* lds = (LAS unsigned char*)lds_raw;
#define X (args.out)
#define TAB ((float*)(ws + WS_TAB))
#define C1P ((float*)(ws + WS_C1P))
#define W1T ((bf16_t*)(ws + WS_W1T))
#define W2T ((bf16_t*)(ws + WS_W2T))
#define WGT ((bf16_t*)(ws + WS_WGT))
#define WPT ((bf16_t*)(ws + WS_WPT))
#define WOT ((bf16_t*)(ws + WS_WOT))
#define WIN ((bf16_t*)(ws + WS_WIN))
#define WVT ((bf16_t*)(ws + WS_WVT))
#define WB ((bf16_t*)(ws + WS_WB))
#define CW1 ((bf16_t*)(ws + WS_CW1))
#define CW2 ((bf16_t*)(ws + WS_CW2))
#define XH ((bf16_t*)(ws + WS_XH))
#define BIG ((bf16_t*)(ws + WS_BIG))
#define Y ((bf16_t*)(ws + WS_Y))
#define PB ((bf16_t*)(ws + WS_PB))
#define AUX ((bf16_t*)(ws + WS_AUX))
#define LF ((float*)(ws + WS_LF))
#define KBIAS ((float*)(ws + WS_KBIAS))
#define SEL (ws + WS_SEL)
#define GATE ((float*)(ws + WS_GATE))
#define KCH ((bf16_t*)(ws + WS_KC))
#define KCL (KCH + 262144)
#define VCT (KCH + 524288)
#define QK BIG
#define VT (BIG + 32 * MiB)
#define O_DF (BIG + 48 * MiB)
#define OD ((bf16_t*)(ws + WS_Y))
#define H3 BIG
#define KSb (BIG + 48 * MiB)
#define KWb (BIG + 52 * MiB)
#define VTn (BIG + 56 * MiB)
#define OC BIG
#define OW (BIG + 16 * MiB)
#define O_N (BIG + 32 * MiB)
#define QH ((bf16_t*)(ws + WS_Y))
#define QL (QH + 16 * MiB)
#define KIH AUX
#define KIL (AUX + (9 * MiB) / 2)
#define VCI (AUX + 9 * MiB)
#define PW AUX
#define U BIG
    cg::grid_group grid = cg::this_grid();
    { volatile LAS unsigned* misc = (volatile LAS unsigned*)(lds + LDS_MISC); if (threadIdx.x < 32) misc[threadIdx.x] = 0u; }
    __syncthreads();
    XcdBarrier xbar = xcd_barrier_post((unsigned*)(args.ws + WS_CTL), (volatile LAS unsigned*)(lds + LDS_MISC + 32));
    bool first_seam = true;

    int layer = 0, base = 0;
#if REP_PK >= 0
    int rep_done = 0;
#endif
    for (int ph = args.ph_lo; ph < args.ph_hi; ++ph) {
        const int wave = __builtin_amdgcn_readfirstlane(otid() >> 6);
#define TIDL const int tid = otid(), lane = tid & 63; (void)tid; (void)lane;
        const int G = oqi((int)gridDim.x), bx = oqi((int)blockIdx.x); const int vcu = (G % 8 == 0) ? (bx % 8) * (G / 8) + bx / 8 : bx;
        const int gw = vcu * NWAVES + wave, ngw = G * NWAVES;
        unsigned char* ws = oq(args.ws);
        while (ph - base >= layer_nph(layer)) { base += layer_nph(layer); ++layer; }
        const int kind = layer_kind(layer); int pk = ph - base; if (kind == 2 && pk >= PK_MIX3) pk += 1; if (kind == 0 && pk >= PK_MIX2) pk += 2;
        const int mi = layer / 3;
        const float* ng = args.in[IN_NG] + (size_t)layer * 4 * DM;
        bf16_t* Omix = (kind == 1) ? O_N : O_DF;
        LAS float* scr = (LAS float*)(lds + wave * 16384);
        switch (pk) {
        case PK_PRO: if (PH_ON(PK_PRO)) { TIDL
            if (layer == 0 && bx == 0) { const float* rel = args.in[IN_REL]; for (int i = tid; i < 2048; i += NTHREADS) { const int head = i >> 7, d = i & 127; TAB[i] = (rel[kBucket[d] * 16 + head] - rel[31 * 16 + head]) * LOG2E; } }
            tr_job(args.in[IN_W1] + (size_t)layer * DM * DFF, DM, DFF, 0, DFF, DFF, W1T, DM, 0, 0, 0, scr, gw, ngw, lane);
            tr_job(args.in[IN_W2] + (size_t)layer * DFF * DM, DFF, DM, 0, DM, DM, W2T, DFF, 0, 0, 0, scr, gw, ngw, lane);
            tr_job(args.in[IN_GATEW] + (size_t)layer * DM * DM, DM, DM, 0, DM, DM, WGT, DM, 0, 0, 0, scr, gw, ngw, lane);
            tr_job(args.in[IN_PLEW] + (size_t)layer * 256 * DM, 256, DM, 0, DM, DM, WPT, 256, 0, 0, 0, scr, gw, ngw, lane);
            if (kind == 0) { const float* wi = args.in[IN_DAIN] + (size_t)mi * DM * 3072;
                tr_job(args.in[IN_DAOUT] + (size_t)mi * DM * DM, DM, DM, 0, DM, DM, WOT, DM, 0, 0, 0, scr, gw, ngw, lane);
                tr_job(wi, DM, 3072, 0, 2048, 2048, WIN, DM, 0, 0, 0, scr, gw, ngw, lane);
                tr_job(wi, DM, 3072, 2048, 1024, 1024, WVT, DM, 0, 0, 0, scr, gw, ngw, lane);
            } else if (kind == 2) { const float* wi = args.in[IN_FOXIN] + (size_t)mi * DM * 3088;
                tr_job(args.in[IN_FOXOUT] + (size_t)mi * DM * DM, DM, DM, 0, DM, DM, WOT, DM, 0, 0, 0, scr, gw, ngw, lane);
                tr_job(wi, DM, 3088, 0, 2048, 2048, WIN, DM, 0, 0, 0, scr, gw, ngw, lane);
                tr_job(wi, DM, 3088, 3072, 16, 256, WIN, DM, 2048, 0, 0, scr, gw, ngw, lane);
                tr_job(wi, DM, 3088, 2048, 1024, 1024, WVT, DM, 0, 0, 0, scr, gw, ngw, lane);
            } else { const float* wi = args.in[IN_NSAIN] + (size_t)mi * DM * 2608;
                tr_job(args.in[IN_NSAOUT] + (size_t)mi * DM * DM, DM, DM, 0, DM, DM, WOT, DM, 0, 0, 0, scr, gw, ngw, lane);
                tr_job(wi, DM, 2608, 0, 1280, 1280, WIN, 3072, 0, 0, 0, scr, gw, ngw, lane);
                tr_job(wi, DM, 2608, 0, 1280, 1280, WIN, 3072, 0, 1024, 1, scr, gw, ngw, lane);
                tr_job(wi, DM, 2608, 0, 1280, 1280, WIN, 3072, 0, 2048, 0, scr, gw, ngw, lane);
                tr_job(wi, DM, 2608, 1280, 256, 256, WB, DM, 0, 0, 0, scr, gw, ngw, lane);
                tr_job(wi, DM, 2608, 1536, 256, 256, WB, DM, 256, 0, 0, scr, gw, ngw, lane);
                tr_job(wi, DM, 2608, 2048, 256, 256, WB, DM, 512, 0, 0, scr, gw, ngw, lane);
                tr_job(wi, DM, 2608, 2560, 48, 256, WB, DM, 768, 0, 0, scr, gw, ngw, lane);
                tr_job(wi, DM, 2608, 1792, 256, 256, WVT, DM, 0, 0, 0, scr, gw, ngw, lane);
                tr_job(wi, DM, 2608, 2304, 256, 256, WVT, DM, 256, 0, 0, scr, gw, ngw, lane);
                const float* cw1 = args.in[IN_NSAW1] + (size_t)mi * 2 * 2048 * 256; const float* cw2 = args.in[IN_NSAW2] + (size_t)mi * 2 * 256 * 64;
                tr_job(cw1, 2048, 256, 0, 256, 256, CW1, 2048, 0, 0, 0, scr, gw, ngw, lane);
                tr_job(cw1, 2048, 256, 0, 256, 256, CW1 + 524288, 2048, 0, 0, 1, scr, gw, ngw, lane);
                tr_job(cw1 + 2048 * 256, 2048, 256, 0, 256, 256, CW1 + 2 * 524288, 2048, 0, 0, 0, scr, gw, ngw, lane);
                tr_job(cw2, 256, 64, 0, 64, 64, CW2, 256, 0, 0, 0, scr, gw, ngw, lane);
                tr_job(cw2, 256, 64, 0, 64, 64, CW2 + 16384, 256, 0, 0, 1, scr, gw, ngw, lane);
                tr_job(cw2 + 256 * 64, 256, 64, 0, 64, 64, CW2 + 2 * 16384, 256, 0, 0, 0, scr, gw, ngw, lane);
                const float* pe = args.in[IN_NSAPE] + (size_t)mi * 2 * 2048;
                for (int task = gw; task < 256; task += ngw) { const int which = task >> 7, kc = (task >> 2) & 31, cc = task & 3; const float* w = cw1 + (size_t)which * 2048 * 256 + (size_t)(64 * kc) * 256 + 64 * cc + lane;
                    const float* pp = pe + which * 2048 + 64 * kc; float s = 0.f;
                    for (int k = 0; k < 64; ++k) s += pp[k] * w[(size_t)k * 256];
                    C1P[(which * 32 + kc) * 256 + 64 * cc + lane] = s; }
            }
            { const f32x4* src = (const f32x4*)(args.in[IN_P] + (size_t)layer * MTOK * 256); u32x4* dstp = (u32x4*)PB;
              for (int i = bx * NTHREADS + tid; i < MTOK * 256 / 8; i += G * NTHREADS) { const f32x4 a = src[2 * i], b = src[2 * i + 1]; dstp[i] = pg8::pack8(a, b); } }
            norm_rows<0>(layer == 0 ? args.in[IN_X] : (const float*)X, X, (const bf16_t*)nullptr, nullptr, ng, XH, kind == 1 ? H3 : (bf16_t*)nullptr, gw, ngw, lane);
        } break;
        case PK_INPROJ: if (PH_ON(PK_INPROJ)) {
            if (kind == 1) {
                pg8::EpiNsaA EA{QH, QL, KIH, KIL, QSCALE}; run_gemm(lds, H3, WIN, MTOK, 1280, 3072, EA);
                pg8::EpiNsaB EB{VCI, KSb, KWb, GATE}; run_gemm(lds, XH, WB, MTOK, 1024, DM, EB);
                pg8::EpiVt EV{VTn, MTOK, 256}; run_gemm(lds, WVT, XH, 512, MTOK, DM, EV, 128);
            } else {
                pg8::EpiQK EQ{QK, LF, args.in[IN_FOXB] + (size_t)mi * 16, QSCALE}; run_gemm(lds, XH, WIN, MTOK, kind == 2 ? 2304 : 2048, DM, EQ);
                pg8::EpiVt EV{VT, MTOK, 0}; run_gemm(lds, WVT, XH, 1024, MTOK, DM, EV);
            }
        } break;
        case PK_MIX1: if (PH_ON(PK_MIX1)) { TIDL
            if (kind == 0) {
                const float* lamp = args.in[IN_DALAM] + (size_t)mi * 256; const float lam_init = 0.8f - 0.6f * expf(-0.3f * (float)layer);
                const float lam = expf(wave_sum(lamp[lane] * lamp[64 + lane])) - expf(wave_sum(lamp[128 + lane] * lamp[192 + lane])) + lam_init;
                for (int i = 0; i < 2 || G != 256; ++i) { int bh8, qb;
                    if (G == 256) { const int s_ = vcu & 15; bh8 = vcu >> 4; qb = (i == 0) ? 31 - s_ : s_; } else { const int u = vcu + i * G; if (u >= 512) break; bh8 = u >> 5; qb = 31 - (u & 31); }
                    const int b = bh8 >> 3, h = bh8 & 7;
                    for (int c = 0; c < 2; ++c) { const int sh = 2 * h + c; fa::FlashArgs a;
                        a.Q = QK + ((size_t)b * SEQ + 256 * qb) * 2048 + sh * 64; a.ldq = 2048; a.K = QK + (size_t)b * SEQ * 2048 + 1024 + sh * 64; a.ldk = 2048;
                        a.Vt = VT + (size_t)(h * 128) * MTOK + (size_t)b * SEQ; a.ldv = MTOK; a.q0 = 256 * qb; a.t_lo = 0; a.t_hi = 4 * qb + 3; a.pa = 1; a.pb = 0; a.window = 1 << 30;
                        a.kbias = nullptr; a.tab = TAB + sh * 128; a.O = O_DF + ((size_t)b * SEQ + 256 * qb) * DM + h * 128; a.ldo = DM; a.gate = nullptr; a.ldg = 0;
                        a.lam = lam; a.oscale = 1.f - lam_init; a.sg = args.in[IN_DASUB] + (size_t)mi * 128;
                        if (c == 0) fa::flash_unit_reg<128, 2, 2>(lds, a); else fa::flash_unit_reg<128, 2, 3>(lds, a); } }
            } else if (kind == 2) {
                if (vcu < 32) { const int b = vcu >> 4, h = vcu & 15; const float* src = LF + ((size_t)b * SEQ + 16 * tid) * 16 + h; float v[16];
#pragma unroll
                    for (int i = 0; i < 16; ++i) v[i] = src[(size_t)i * 16];
#pragma unroll
                    for (int i = 1; i < 16; ++i) v[i] += v[i - 1];
                    float incl = v[15];
#pragma unroll
                    for (int o = 1; o < 64; o <<= 1) { const float tmp = __shfl_up(incl, o); if (lane >= o) incl += tmp; }
                    LAS float* wt = (LAS float*)lds;
                    if (lane == 63) wt[wave] = incl;
                    __syncthreads();
                    float off = incl - v[15];
                    for (int w = 0; w < wave; ++w) off += wt[w];
                    f32x4* dst = (f32x4*)(KBIAS + (size_t)(b * 16 + h) * SEQ + 16 * tid);
#pragma unroll
                    for (int q = 0; q < 4; ++q) { f32x4 ov; ov[0] = -(off + v[4 * q]) * LOG2E; ov[1] = -(off + v[4 * q + 1]) * LOG2E; ov[2] = -(off + v[4 * q + 2]) * LOG2E; ov[3] = -(off + v[4 * q + 3]) * LOG2E; dst[q] = ov; }
                    __syncthreads(); }
            } else {
                for (int u = vcu; u < 256; u += G) { const int which = u >> 7, bg = (u >> 4) & 7, n0 = 32 * (u & 15);
                    if (which == 0) fa::nsa_compress_unit<true>(lds, bg, n0, KIH, KIL, CW1, CW1 + 524288, CW2, CW2 + 16384, C1P, KCH, KCL, VCT);
                    else fa::nsa_compress_unit<false>(lds, bg, n0, VCI, nullptr, CW1 + 2 * 524288, nullptr, CW2 + 2 * 16384, nullptr, C1P + 32 * 256, KCH, KCL, VCT); }
            }
        } break;
        case PK_MIX2: if (PH_ON(PK_MIX2)) { TIDL
            if (kind == 0) {
            } else if (kind == 2) {
                fa::AttnOrder ord{vcu, G}; int bh, qb;
                for (int i = 0; ord.next(i, bh, qb); ++i) { const int b = bh >> 4, h = bh & 15; fa::FlashArgs a;
                    a.Q = QK + ((size_t)b * SEQ + 256 * qb) * 2048 + h * 64; a.ldq = 2048; a.K = QK + (size_t)b * SEQ * 2048 + 1024 + h * 64; a.ldk = 2048;
                    a.Vt = VT + (size_t)(h * 64) * MTOK + (size_t)b * SEQ; a.ldv = MTOK; a.q0 = 256 * qb; a.t_lo = 0; a.t_hi = 4 * qb + 3; a.pa = 1; a.pb = 0; a.window = 1 << 30;
                    a.kbias = KBIAS + (size_t)(b * 16 + h) * SEQ; a.tab = nullptr; a.O = O_DF + ((size_t)b * SEQ + 256 * qb) * DM + h * 64; a.ldo = DM; a.gate = nullptr; a.ldg = 0;
                    FLASH_FOX<64, 1, 0, -1>(lds, a); }
            } else {
                fa::AttnOrder ord{vcu, G}; int bh, qb;
                for (int br = 0; br < 2; ++br)
                    for (int i = 0; ord.next(i, bh, qb); ++i) { const int b = bh >> 4, h = bh & 15, g = h >> 2, q0 = 256 * qb; fa::FlashArgs a; const size_t tok0 = (size_t)b * SEQ + q0;
                        a.Q = QH + tok0 * DM + h * 64; a.ldq = DM; a.q0 = q0; a.tab = TAB + h * 128; a.kbias = nullptr; a.ldo = DM; a.ldg = 48;
                        if (br == 0) { a.K = KCH + (size_t)(b * 4 + g) * 512 * 64; a.ldk = 64; a.Vt = VCT + (size_t)(b * 4 + g) * 64 * 512; a.ldv = 512; a.t_lo = 0; a.t_hi = min(7, (q0 + 224) >> 10); a.pa = 16; a.pb = 31; a.window = 1 << 30;
                            a.O = OC + tok0 * DM + h * 64; a.gate = GATE + tok0 * 48 + h * 3 + 0; }
                        else { a.K = KWb + (size_t)b * SEQ * 256 + g * 64; a.ldk = 256; a.Vt = VTn + (size_t)(256 + g * 64) * MTOK + (size_t)b * SEQ; a.ldv = MTOK; a.t_lo = max(0, q0 - 511) >> 6; a.t_hi = (q0 + 255) >> 6; a.pa = 1; a.pb = 0; a.window = 512;
                            a.O = OW + tok0 * DM + h * 64; a.gate = GATE + tok0 * 48 + h * 3 + 2; }
                        FLASH_NSA<64, 2, 1>(lds, a); }
                for (int u = vcu; u < 2048; u += G) { const int b = u >> 10, g = (u >> 8) & 3, qblk = u & 255; fa::nsa_importance_unit(lds, b, g, qblk, QH, QL, KCH, KCL, TAB, SEL); }
            }
        } break;
        case PK_MIX3: if (PH_ON(PK_MIX3)) { fa::nsa_selected_phase(lds, gw, ngw, QH, KSb, VTn, SEL, TAB, GATE, OC, OW, O_N); } break;
        case PK_OUTPROJ: if (PH_ON(PK_OUTPROJ)) { pg8::EpiAct<0> E{Y, DM}; run_gemm(lds, Omix, WOT, MTOK, DM, DM, E); } break;
        case PK_NORMB: if (PH_ON(PK_NORMB)) { TIDL norm_rows<1>(layer == 0 ? args.in[IN_X] : (const float*)X, X, Y, ng + DM, ng + 2 * DM, XH, nullptr, gw, ngw, lane); } break;
        case PK_UP: if (PH_ON(PK_UP)) { pg8::EpiAct<1> E{U, DFF}; run_gemm(lds, XH, W1T, MTOK, DFF, DM, E); } break;
        case PK_DOWN: if (PH_ON(PK_DOWN)) { pg8::EpiAct<0> E{Y, DM}; run_gemm(lds, U, W2T, MTOK, DM, DFF, E); } break;
        case PK_NORMC: if (PH_ON(PK_NORMC)) { TIDL norm_rows<2>(X, X, Y, ng + 3 * DM, nullptr, XH, nullptr, gw, ngw, lane);
                        pg8::EpiAct<0> E2{PW, DM}; run_gemm(lds, PB, WPT, MTOK, DM, 256, E2); } break;
        case PK_GATE: if (PH_ON(PK_GATE)) { pg8::EpiGate E{X, PW}; run_gemm(lds, XH, WGT, MTOK, DM, DM, E); } break;
        default: break;
        }
#if REP_PK >= 0
        if (pk == REP_PK && (REP_LAYER < 0 || layer == REP_LAYER) && rep_done == 0) { rep_done = 1; xcd_barrier(xbar); --ph; continue; }
        rep_done = 0;
#endif
        if (ph + 1 < args.ph_hi) {
            if (first_seam) { first_seam = false; __syncthreads(); grid.sync(); }
            else xcd_barrier(xbar);
#if EXTRA_SYNC > 0
            for (int es = 0; es < EXTRA_SYNC; ++es) xcd_barrier(xbar);
#endif
        }
    }
}

extern "C" void kernel_launch(void* const* d_in, const int* in_sizes, int n_in, void* d_out, int out_size, void* d_ws, size_t ws_size, hipStream_t stream) {
    static int grid = 0;
    if (grid == 0) {
        if (n_in != 20 || out_size != MTOK * DM || ws_size < WS_END) { fprintf(stderr, "kernel_launch: unexpected shapes (n_in %d, out %d, ws %zu)\n", n_in, out_size, ws_size); grid = -1; return; }
        int dev = 0, cus = 0, per_cu = 0;
        hipGetDevice(&dev); hipDeviceGetAttribute(&cus, hipDeviceAttributeMultiprocessorCount, dev);
        if (hipFuncSetAttribute((const void*)trunk_fwd, hipFuncAttributeMaxDynamicSharedMemorySize, LDS_BYTES) != hipSuccess) { fprintf(stderr, "kernel_launch: hipFuncSetAttribute failed\n"); grid = -1; return; }
        hipOccupancyMaxActiveBlocksPerMultiprocessor(&per_cu, (const void*)trunk_fwd, NTHREADS, LDS_BYTES);
        (void)hipGetLastError();
        if (per_cu < 1) { fprintf(stderr, "kernel_launch: occupancy query says %d blocks/CU\n", per_cu); per_cu = 1; }
        grid = cus;
    }
    if (grid < 0) return;
    if (hipMemsetAsync((char*)d_ws + WS_CTL, 0, CTL_BYTES, stream) != hipSuccess) { fprintf(stderr, "kernel_launch: memset of the barrier words failed\n"); return; }
    Args a{};
    for (int i = 0; i < 20; ++i) a.in[i] = (const float*)d_in[i];
    a.out = (float*)d_out; a.ws = (unsigned char*)d_ws;
#if ONE_LAUNCH
    a.ph_lo = 0; a.ph_hi = N_PHASES;
    void* kargs[] = {&a};
    hipError_t e = hipLaunchCooperativeKernel((const void*)trunk_fwd, dim3(grid), dim3(NTHREADS), kargs, LDS_BYTES, stream);
    if (e != hipSuccess) fprintf(stderr, "kernel_launch: cooperative launch failed: %s (grid %d)\n", hipGetErrorString(e), grid);
#else
    for (int ph = 0; ph < N_PHASES; ++ph) { a.ph_lo = ph; a.ph_hi = ph + 1; hipLaunchKernelGGL(trunk_fwd, dim3(grid), dim3(NTHREADS), LDS_BYTES, stream, a); }
#endif
}
```
